# Optimizing an MI355X kernel written in HIP

```python
import numpy as np
import jax
import jax.numpy as jnp
from jax import lax

D_MODEL = 1024
BATCH = 2
SEQ = 8192
DEPTH = 4

PLE_DIM = 256
D_FF = 2816
ROPE_THETA = 500000.0
Q_BLOCK = 128
HEAD_DIM = 64
ROT_DIM = HEAD_DIM // 4
NEG_INF = -1e30
RMS_EPS = 1e-6
A_HEADS = 8
A_KV_RANK = 128
IDX_HEADS = 8
IDX_DIM = 32
IDX_ROT_DIM = IDX_DIM // 4
A_TOPK_MAX = 256
B_HEADS = 8
B_GROUPS = 2
B_HPG = B_HEADS // B_GROUPS
CMP_BLOCK = 32
CMP_STRIDE = 16
CMP_HIDDEN = 256
SEL_BLOCK = 64
SEL_TOPN = 16
WINDOW = 512
FORCED_SCORE = 1e4
N_BRANCH_GATES = 3
A_Q_W = A_HEADS * HEAD_DIM
B_Q_W = B_HEADS * HEAD_DIM
B_KV_W = B_GROUPS * HEAD_DIM
IN_SIZES = (A_Q_W, A_KV_RANK, IDX_HEADS * IDX_DIM, IDX_DIM, IDX_HEADS, B_Q_W, 6 * B_KV_W, B_HEADS * N_BRANCH_GATES, 2 * D_MODEL)
IN_SPLITS = tuple(int(v) for v in np.cumsum(IN_SIZES)[:-1])
D_IN = int(sum(IN_SIZES))

kernel_name = 'hybrid_dsa_nsa_macaron_trunk'


def rms_norm(x, g):
    xf = x.astype(jnp.float32)
    y = xf * lax.rsqrt(jnp.mean(xf * xf, axis=-1, keepdims=True) + RMS_EPS)
    return (y * g.astype(jnp.float32)).astype(x.dtype)


def swiglu(h, w1, w3, w2):
    return (jax.nn.silu(h @ w1) * (h @ w3)) @ w2


def rope_tables(seq, rot_dim):
    pos = jnp.arange(seq, dtype=jnp.float32)
    inv = ROPE_THETA ** (-jnp.arange(0, rot_dim, 2, dtype=jnp.float32) / rot_dim)
    ang = pos[:, None] * inv[None, :]
    return jnp.cos(ang), jnp.sin(ang)


def partial_rope(x, cos, sin):
    half = cos.shape[-1]
    x1, x2, xp = x[..., :half], x[..., half:2 * half], x[..., 2 * half:]
    shape = (1, cos.shape[0]) + (1,) * (x.ndim - 3) + (half,)
    c = cos.reshape(shape).astype(x.dtype)
    s = sin.reshape(shape).astype(x.dtype)
    return jnp.concatenate([x1 * c - x2 * s, x2 * c + x1 * s, xp], axis=-1)


def masked_softmax(scores, mask):
    s = jnp.where(mask, scores.astype(jnp.float32), NEG_INF)
    return jax.nn.softmax(s, axis=-1) * mask


def dsa_attention(q, k, v, q_idx, k_idx, w_idx, top_k):
    B, S = q.shape[0], q.shape[1]
    scale = HEAD_DIM ** -0.5
    bi = jnp.arange(B)[:, None, None]
    key_pos = jnp.arange(S)

    def block(qb):
        q0 = qb * Q_BLOCK
        t = q0 + jnp.arange(Q_BLOCK)
        qi = lax.dynamic_slice_in_dim(q_idx, q0, Q_BLOCK, axis=1)
        wi = lax.dynamic_slice_in_dim(w_idx, q0, Q_BLOCK, axis=1)
        qh = lax.dynamic_slice_in_dim(q, q0, Q_BLOCK, axis=1)
        rel = jax.nn.relu(jnp.einsum('bqhd,bsd->bqhs', qi, k_idx).astype(jnp.float32))
        score = jnp.einsum('bqh,bqhs->bqs', wi.astype(jnp.float32), rel)
        causal = key_pos[None, :] <= t[:, None]
        score = jnp.where(causal[None], score, -jnp.inf)
        _, idx = lax.top_k(score, top_k)
        ks = k[bi, idx]
        vs = v[bi, idx]
        valid = idx <= t[None, :, None]
        s = jnp.einsum('bqhd,bqkd->bqhk', qh, ks) * scale
        pr = masked_softmax(s, valid[:, :, None, :])
        return jnp.einsum('bqhk,bqkd->bqhd', pr.astype(v.dtype), vs)

    out = lax.map(block, jnp.arange(S // Q_BLOCK))
    return out.transpose(1, 0, 2, 3, 4).reshape(B, S, -1)


def nsa_attention(q, k_cmp, v_cmp, k_slc, v_slc, k_win, v_win, gates, cmp_pos, wk1, wk2, wv1, wv2):
    B, S = q.shape[0], q.shape[1]
    scale = HEAD_DIM ** -0.5
    n_cmp = (S - CMP_BLOCK) // CMP_STRIDE + 1
    n_blk = S // SEL_BLOCK
    n_top = min(SEL_TOPN, n_blk)
    tok = jnp.arange(n_cmp)[:, None] * CMP_STRIDE + jnp.arange(CMP_BLOCK)[None, :]

    def compress(t_in, w1, w2):
        blk = t_in[:, tok] + cmp_pos[None, None, :, None, :]
        blk = blk.transpose(0, 1, 3, 2, 4).reshape(B, n_cmp, B_GROUPS, CMP_BLOCK * HEAD_DIM)
        return jax.nn.silu(blk @ w1) @ w2

    kc = compress(k_cmp, wk1, wk2)
    vc = compress(v_cmp, wv1, wv2)
    c_start = jnp.arange(n_cmp) * CMP_STRIDE
    cmp_end = c_start + CMP_BLOCK - 1
    s_start = jnp.arange(n_blk) * SEL_BLOCK
    overlap = ((c_start[:, None] < s_start[None, :] + SEL_BLOCK) &
               (s_start[None, :] < c_start[:, None] + CMP_BLOCK)).astype(jnp.float32)
    kb = k_slc.reshape(B, n_blk, SEL_BLOCK, B_GROUPS, HEAD_DIM)
    vb = v_slc.reshape(B, n_blk, SEL_BLOCK, B_GROUPS, HEAD_DIM)
    pad = jnp.zeros((B, WINDOW, B_GROUPS, HEAD_DIM), k_win.dtype)
    kw = jnp.concatenate([pad, k_win], axis=1)
    vw = jnp.concatenate([pad, v_win], axis=1)
    bi = jnp.arange(B)[:, None, None, None]
    gi = jnp.arange(B_GROUPS)[None, None, :, None]
    blk_ids = jnp.arange(n_blk)

    def block(qb):
        q0 = qb * Q_BLOCK
        t = q0 + jnp.arange(Q_BLOCK)
        qh = lax.dynamic_slice_in_dim(q, q0, Q_BLOCK, axis=1)
        g = lax.dynamic_slice_in_dim(gates, q0, Q_BLOCK, axis=1)
        s = jnp.einsum('bqghd,bcgd->bqghc', qh, kc) * scale
        cmask = cmp_end[None, :] <= t[:, None]
        p_c = masked_softmax(s, cmask[None, :, None, None, :])
        o_c = jnp.einsum('bqghc,bcgd->bqghd', p_c.astype(vc.dtype), vc)
        imp = jnp.einsum('bqghc,cn->bqgn', p_c, overlap)
        forced = (blk_ids[None, :] == (t // SEL_BLOCK)[:, None]) | (blk_ids[None, :] == 0)
        admissible = blk_ids[None, :] * SEL_BLOCK <= t[:, None]
        imp = jnp.where(forced[None, :, None, :], FORCED_SCORE,
                        jnp.where(admissible[None, :, None, :], imp, -1.0))
        _, sel = lax.top_k(imp, n_top)
        ks = kb[bi, sel, :, gi].reshape(B, Q_BLOCK, B_GROUPS, n_top * SEL_BLOCK, HEAD_DIM)
        vs = vb[bi, sel, :, gi].reshape(B, Q_BLOCK, B_GROUPS, n_top * SEL_BLOCK, HEAD_DIM)
        spos = (sel[..., None] * SEL_BLOCK + jnp.arange(SEL_BLOCK)).reshape(B, Q_BLOCK, B_GROUPS, n_top * SEL_BLOCK)
        smask = spos <= t[None, :, None, None]
        s = jnp.einsum('bqghd,bqgkd->bqghk', qh, ks) * scale
        p_s = masked_softmax(s, smask[:, :, :, None, :])
        o_s = jnp.einsum('bqghk,bqgkd->bqghd', p_s.astype(vs.dtype), vs)
        kwb = lax.dynamic_slice_in_dim(kw, q0, Q_BLOCK + WINDOW, axis=1)
        vwb = lax.dynamic_slice_in_dim(vw, q0, Q_BLOCK + WINDOW, axis=1)
        wpos = q0 - WINDOW + jnp.arange(Q_BLOCK + WINDOW)
        wmask = (wpos[None, :] <= t[:, None]) & (wpos[None, :] > t[:, None] - WINDOW) & (wpos[None, :] >= 0)
        s = jnp.einsum('bqghd,bkgd->bqghk', qh, kwb) * scale
        p_w = masked_softmax(s, wmask[None, :, None, None, :])
        o_w = jnp.einsum('bqghk,bkgd->bqghd', p_w.astype(vwb.dtype), vwb)
        return g[..., 0:1] * o_c + g[..., 1:2] * o_s + g[..., 2:3] * o_w

    out = lax.map(block, jnp.arange(S // Q_BLOCK))
    return out.transpose(1, 0, 2, 3, 4, 5).reshape(B, S, -1)


def token_mixer(h, rope, rope_idx, w_in, a_kv_norm, a_w_ukv, cmp_pos, cmp_k_w1, cmp_k_w2,
                cmp_v_w1, cmp_v_w2, w_proj_a, w_proj_b, w_out):
    B, S = h.shape[0], h.shape[1]
    cos, sin = rope
    cos_i, sin_i = rope_idx
    qa, ckv, qi, ki, wi, qb, kvb, gb, gm = jnp.split(h @ w_in, IN_SPLITS, axis=-1)
    qa = partial_rope(qa.reshape(B, S, A_HEADS, HEAD_DIM), cos, sin)
    ka, va = jnp.split(rms_norm(ckv, a_kv_norm) @ a_w_ukv, 2, axis=-1)
    ka = partial_rope(ka, cos, sin)
    qi = partial_rope(qi.reshape(B, S, IDX_HEADS, IDX_DIM), cos_i, sin_i)
    ki = partial_rope(ki, cos_i, sin_i)
    wi = wi * IDX_HEADS ** -0.5
    top_k = min(A_TOPK_MAX, S // 4)
    o_a = dsa_attention(qa, ka, va, qi, ki, wi, top_k)
    qb = partial_rope(qb.reshape(B, S, B_GROUPS, B_HPG, HEAD_DIM), cos, sin)
    kc, vc, ks, vs, kw, vw = [t.reshape(B, S, B_GROUPS, HEAD_DIM) for t in jnp.split(kvb, 6, axis=-1)]
    kc = partial_rope(kc, cos, sin)
    ks = partial_rope(ks, cos, sin)
    kw = partial_rope(kw, cos, sin)
    gates = jax.nn.sigmoid(gb).reshape(B, S, B_GROUPS, B_HPG, N_BRANCH_GATES)
    o_b = nsa_attention(qb, kc, vc, ks, vs, kw, vw, gates, cmp_pos,
                        cmp_k_w1, cmp_k_w2, cmp_v_w1, cmp_v_w2)
    g_a, g_b = jnp.split(jax.nn.sigmoid(gm), 2, axis=-1)
    merged = g_a * (o_a @ w_proj_a) + g_b * (o_b @ w_proj_b)
    return merged @ w_out


def setup_inputs(seed: int = 0) -> dict:
    key = jax.random.key(seed)
    keys = iter(jax.random.split(key, 32))
    L = DEPTH

    def dense(shape, fan_in):
        return jax.random.normal(next(keys), shape, jnp.float32) * fan_in ** -0.5

    def gain(shape):
        return 1.0 + 0.02 * jax.random.normal(next(keys), shape, jnp.float32)

    return {
        'x': jax.random.normal(next(keys), (BATCH, SEQ, D_MODEL), jnp.float32),
        'p': jax.random.normal(next(keys), (DEPTH, BATCH, SEQ, PLE_DIM), jnp.float32),
        'ffa_norm': gain((L, D_MODEL)),
        'ffa_w1': dense((L, D_MODEL, D_FF), D_MODEL),
        'ffa_w3': dense((L, D_MODEL, D_FF), D_MODEL),
        'ffa_w2': dense((L, D_FF, D_MODEL), D_FF),
        'mix_norm': gain((L, D_MODEL)),
        'w_in': dense((L, D_MODEL, D_IN), D_MODEL),
        'a_kv_norm': gain((L, A_KV_RANK)),
        'a_w_ukv': dense((L, A_KV_RANK, 2 * HEAD_DIM), A_KV_RANK),
        'cmp_pos': 0.1 * jax.random.normal(next(keys), (L, CMP_BLOCK, HEAD_DIM), jnp.float32),
        'cmp_k_w1': dense((L, CMP_BLOCK * HEAD_DIM, CMP_HIDDEN), CMP_BLOCK * HEAD_DIM),
        'cmp_k_w2': dense((L, CMP_HIDDEN, HEAD_DIM), CMP_HIDDEN),
        'cmp_v_w1': dense((L, CMP_BLOCK * HEAD_DIM, CMP_HIDDEN), CMP_BLOCK * HEAD_DIM),
        'cmp_v_w2': dense((L, CMP_HIDDEN, HEAD_DIM), CMP_HIDDEN),
        'w_proj_a': dense((L, A_Q_W, D_MODEL), A_Q_W),
        'w_proj_b': dense((L, B_Q_W, D_MODEL), B_Q_W),
        'w_out': dense((L, D_MODEL, D_MODEL), D_MODEL),
        'ffb_norm': gain((L, D_MODEL)),
        'ffb_w1': dense((L, D_MODEL, D_FF), D_MODEL),
        'ffb_w3': dense((L, D_MODEL, D_FF), D_MODEL),
        'ffb_w2': dense((L, D_FF, D_MODEL), D_FF),
        'ple_norm': gain((L, D_MODEL)),
        'ple_w_gate': dense((L, D_MODEL, D_MODEL), D_MODEL),
        'ple_w_proj': dense((L, PLE_DIM, D_MODEL), PLE_DIM),
        'final_norm': gain((D_MODEL,)),
    }


def reference(x, p, ffa_norm, ffa_w1, ffa_w3, ffa_w2, mix_norm, w_in, a_kv_norm, a_w_ukv,
              cmp_pos, cmp_k_w1, cmp_k_w2, cmp_v_w1, cmp_v_w2, w_proj_a, w_proj_b, w_out,
              ffb_norm, ffb_w1, ffb_w3, ffb_w2, ple_norm, ple_w_gate, ple_w_proj, final_norm):
    S = x.shape[1]
    rope = rope_tables(S, ROT_DIM)
    rope_idx = rope_tables(S, IDX_ROT_DIM)
    for i in range(DEPTH):
        x = x + 0.5 * swiglu(rms_norm(x, ffa_norm[i]), ffa_w1[i], ffa_w3[i], ffa_w2[i])
        x = x + token_mixer(rms_norm(x, mix_norm[i]), rope, rope_idx, w_in[i], a_kv_norm[i], a_w_ukv[i],
                            cmp_pos[i], cmp_k_w1[i], cmp_k_w2[i], cmp_v_w1[i], cmp_v_w2[i],
                            w_proj_a[i], w_proj_b[i], w_out[i])
        x = x + 0.5 * swiglu(rms_norm(x, ffb_norm[i]), ffb_w1[i], ffb_w3[i], ffb_w2[i])
        gate = jax.nn.sigmoid(rms_norm(x, ple_norm[i]) @ ple_w_gate[i])
        x = x + gate * (p[i] @ ple_w_proj[i])
    return rms_norm(x, final_norm)
```

```cpp
#include <hip/hip_runtime.h>
#include <hip/hip_cooperative_groups.h>
#include <cstdio>
#include <cstdint>
namespace cg = cooperative_groups;
#ifndef MK_MULTI
#define MK_MULTI 0
#endif
__device__ __forceinline__ int mk_tid(int wv) { int lane; asm volatile("v_mbcnt_lo_u32_b32 %0, -1, 0\n\tv_mbcnt_hi_u32_b32 %0, -1, %0" : "=v"(lane)); return lane + 64 * wv; }
__device__ __forceinline__ int mk_bid() { int b = blockIdx.x; asm volatile("" : "+s"(b)); return b; }
__device__ __forceinline__ int mk_grid() { int g = gridDim.x; asm volatile("" : "+s"(g)); return g; }
namespace pg8 {
#define PG8_LAS __attribute__((address_space(3)))
typedef unsigned short bf16_t;
typedef short bf16x8 __attribute__((ext_vector_type(8)));
typedef float f32x4 __attribute__((ext_vector_type(4)));
typedef unsigned u32x4 __attribute__((ext_vector_type(4)));
constexpr int BM = 256, BK = 64, HALF = 128, HTB = HALF * BK * 2  , STAGE_BYTES = 8 * HTB, NXCD = 8, WGM = 8;

__host__ __device__ __forceinline__ int lds_byte(int r, int c) { const int st = (r >> 4) * 2 + (c >> 5), rr = r & 15, cc = c & 31, ob = rr * 64 + cc * 2; return st * 1024 + (ob ^ (((ob >> 9) & 1) << 5)); }
__host__ __device__ __forceinline__ void stage_rc(int b, int& R, int& C) { const int st = b / 1024, sb = b % 1024, swz = sb ^ (((sb >> 9) & 1) << 5); R = (st >> 1) * 16 + swz / 64; C = (st & 1) * 32 + (swz % 64) / 2; }
__host__ __device__ __forceinline__ int perm32(int rho) { const int n = rho >> 4, i = rho & 15; return 8 * (i >> 2) + 4 * n + (i & 3); }

struct Unit { int pm, pn; };
struct Gemm { const bf16_t* A; const bf16_t* Bt; int M, N, K, lda; };

struct StaticOrder {
    int nM, nN, nwg, G, c;
    __host__ __device__ void init(int M, int N, int G_, int c_) { nM = M / BM; nN = N / BM; nwg = nM * nN; G = G_; c = c_; }
    __host__ __device__ bool next(int i, Unit& u) const {
        const long L = (long)i * G + c; if (L >= nwg) return false;
        int wgid = (int)L; { const int q = nwg / NXCD, r = nwg % NXCD, xcd = wgid % NXCD, off = wgid / NXCD; wgid = (xcd < r ? xcd * (q + 1) : r * (q + 1) + (xcd - r) * q) + off; }
        const int nig = WGM * nN, gid = wgid / nig, fm = gid * WGM, gsz = (nM - fm) < WGM ? (nM - fm) : WGM;
        u.pm = fm + ((wgid % nig) % gsz); u.pn = (wgid % nig) / gsz; return true;
    }
    __device__ __forceinline__ void a_ready(const Unit&) const {}
    __device__ __forceinline__ void done(const Unit&) const {}
};

__device__ __forceinline__ unsigned cvt_pk_bf16(float lo, float hi) { unsigned r; asm volatile("v_cvt_pk_bf16_f32 %0, %1, %2" : "=v"(r) : "v"(lo), "v"(hi)); return r; }
typedef float f32x2 __attribute__((ext_vector_type(2)));
template <class Epi, class Sched, bool ALIGN_EPI = false, bool SP2 = false>
__device__ __forceinline__ void gemm_phase(PG8_LAS unsigned char* lds, const Gemm g, const Sched& S, const Epi& E, int wv) {
    int wv_ = wv; asm volatile("" : "+s"(wv_)); int tid_ = mk_tid(wv_); asm volatile("" : "+v"(tid_)); const int tid = tid_, wid = wv_, lane = tid & 63, wr = wid >> 2, wc = wid & 3, fr = lane & 15, fq = lane >> 4;
    const int K = g.K, nt = K / BK;
    unsigned voffA[2], voffB[2];
#pragma unroll
    for (int i = 0; i < 2; ++i) { int R, C; stage_rc(tid * 16 + i * 8192, R, C); const int Rb = Epi::PERM ? ((R & ~31) + perm32(R & 31)) : R;
        voffA[i] = (unsigned)(R * g.lda + C) * 2u; voffB[i] = (unsigned)(Rb * K + C) * 2u; }
    const size_t kstep = (size_t)(BK * 2);
    const size_t hstepB = (size_t)HALF * K * 2, hstepA = (size_t)HALF * g.lda * 2;
    const size_t tstepA = 2 * hstepA, tstepB = 2 * hstepB;
    const unsigned ldsw = (unsigned)wid * 1024u;
    const int aoff = lds_byte(wr * 64 + fr, fq * 8), boff = lds_byte(wc * 32 + fr, fq * 8);
#define PG8_SA(b, h) (((b) * 2 + (h)) * HTB)
#define PG8_SB(b, h) ((4 + (b) * 2 + (h)) * HTB)
#define PG8_STAGE(bufoff, gbase, voff) do { _Pragma("unroll") for (int _i = 0; _i < 2; ++_i) \
        __builtin_amdgcn_global_load_lds((const unsigned*)((const char*)(gbase) + (voff)[_i]), (PG8_LAS unsigned*)(lds + (bufoff) + ldsw + _i * 8192), 16, 0, 0); } while (0)
#define PG8_LDA(dst, b, h) do { _Pragma("unroll") for (int m = 0; m < 4; ++m) _Pragma("unroll") for (int k = 0; k < 2; ++k) dst[m][k] = *(const PG8_LAS bf16x8*)(lds + PG8_SA(b, h) + aoff + m * 2048 + k * 1024); } while (0)
#define PG8_LDB(dst, b, h) do { _Pragma("unroll") for (int n = 0; n < 2; ++n) _Pragma("unroll") for (int k = 0; k < 2; ++k) dst[n][k] = *(const PG8_LAS bf16x8*)(lds + PG8_SB(b, h) + boff + n * 2048 + k * 1024); } while (0)
#define PG8_MMA(ai, bj, At, Bt) do { __builtin_amdgcn_s_setprio(1); _Pragma("unroll") for (int m = 0; m < 4; ++m) _Pragma("unroll") for (int n = 0; n < 2; ++n) _Pragma("unroll") for (int k = 0; k < 2; ++k) \
        acc[ai][bj][m][n] = __builtin_amdgcn_mfma_f32_16x16x32_bf16(Bt[n][k], At[m][k], acc[ai][bj][m][n], 0, 0, 0); __builtin_amdgcn_s_setprio(0); } while (0)
#define PG8_WAIT_V(n) asm volatile("s_waitcnt vmcnt(" #n ")" ::: "memory")
#define PG8_WAIT_L(n) asm volatile("s_waitcnt lgkmcnt(" #n ")" ::: "memory")
#define PG8_BAR __builtin_amdgcn_s_barrier()
#define PG8_SCHED __builtin_amdgcn_sched_barrier(0)
    Unit cur, nxt; int ui = 0;
    if (!S.next(0, cur)) return;
    f32x4 acc[2][2][4][2];
#pragma unroll
    for (int a = 0; a < 2; ++a)
#pragma unroll
        for (int b = 0; b < 2; ++b)
#pragma unroll
            for (int m = 0; m < 4; ++m)
#pragma unroll
                for (int n = 0; n < 2; ++n) acc[a][b][m][n] = (f32x4){0.f, 0.f, 0.f, 0.f};
    bf16x8 At[4][2], B0[2][2], B1[2][2];
    const char* cA = (const char*)g.A + (size_t)cur.pm * tstepA; const char* cB = (const char*)g.Bt + (size_t)cur.pn * tstepB;
    S.a_ready(cur);
    if constexpr (SP2) {
        PG8_STAGE(PG8_SB(0, 0), cB, voffB); PG8_STAGE(PG8_SB(0, 1), cB + hstepB, voffB); PG8_STAGE(PG8_SA(0, 0), cA, voffA); PG8_STAGE(PG8_SA(0, 1), cA + hstepA, voffA);
        if (wr == 1) PG8_BAR;
        PG8_WAIT_V(2); PG8_BAR;
        PG8_STAGE(PG8_SB(1, 0), cB + kstep, voffB); PG8_STAGE(PG8_SA(1, 0), cA + kstep, voffA); PG8_STAGE(PG8_SB(1, 1), cB + hstepB + kstep, voffB);
        PG8_WAIT_V(6); PG8_BAR;
    } else {
        PG8_STAGE(PG8_SB(0, 0), cB, voffB); PG8_STAGE(PG8_SA(0, 0), cA, voffA); PG8_STAGE(PG8_SB(0, 1), cB + hstepB, voffB); PG8_STAGE(PG8_SA(0, 1), cA + hstepA, voffA);
        if (wr == 1) PG8_BAR;
        PG8_WAIT_V(4); PG8_BAR;
        PG8_STAGE(PG8_SB(1, 0), cB + kstep, voffB); PG8_STAGE(PG8_SA(1, 0), cA + kstep, voffA); PG8_STAGE(PG8_SB(1, 1), cB + hstepB + kstep, voffB);
        PG8_WAIT_V(6); PG8_BAR;
    }
    for (;;) {
        const bool has_next = S.next(ui + 1, nxt);
        const char* nA = has_next ? (const char*)g.A + (size_t)nxt.pm * tstepA : cA; const char* nB = has_next ? (const char*)g.Bt + (size_t)nxt.pn * tstepB : cB;
        for (int t = 0; t < nt; t += 2) {
            const bool last = (t == nt - 2);
            const char* a1 = cA + (size_t)(t + 1) * kstep;
            const char* a2 = last ? nA : cA + (size_t)(t + 2) * kstep; const char* b2 = last ? nB : cB + (size_t)(t + 2) * kstep;
            const char* a3 = a2 + kstep; const char* b3 = b2 + kstep;
            if (last && has_next) S.a_ready(nxt);
            if constexpr (SP2) {
            PG8_LDB(B0, 0, 0); PG8_LDB(B1, 0, 1); PG8_SCHED; PG8_LDA(At, 0, 0); PG8_STAGE(PG8_SA(1, 1), a1 + hstepA, voffA);
            PG8_WAIT_V(8); PG8_WAIT_L(0); PG8_BAR; PG8_MMA(0, 0, At, B0); PG8_MMA(0, 1, At, B1); PG8_BAR; PG8_SCHED;
            PG8_LDA(At, 0, 1); PG8_STAGE(PG8_SB(0, 0), b2, voffB); PG8_STAGE(PG8_SB(0, 1), b2 + hstepB, voffB); PG8_STAGE(PG8_SA(0, 0), a2, voffA);
            PG8_WAIT_V(8); PG8_WAIT_L(0); PG8_BAR; PG8_MMA(1, 0, At, B0); PG8_MMA(1, 1, At, B1); PG8_BAR; PG8_SCHED;
            PG8_LDB(B0, 1, 0); PG8_LDB(B1, 1, 1); PG8_SCHED; PG8_LDA(At, 1, 0); PG8_STAGE(PG8_SA(0, 1), a2 + hstepA, voffA);
            PG8_WAIT_V(8); PG8_WAIT_L(0); PG8_BAR; PG8_MMA(0, 0, At, B0); PG8_MMA(0, 1, At, B1); PG8_BAR; PG8_SCHED;
            PG8_LDA(At, 1, 1); PG8_STAGE(PG8_SB(1, 0), b3, voffB); PG8_STAGE(PG8_SB(1, 1), b3 + hstepB, voffB); PG8_STAGE(PG8_SA(1, 0), a3, voffA);
            PG8_WAIT_V(8); PG8_WAIT_L(0); PG8_BAR; PG8_MMA(1, 0, At, B0); PG8_MMA(1, 1, At, B1); PG8_BAR; PG8_SCHED;
            } else {
            PG8_LDB(B0, 0, 0); PG8_SCHED; PG8_LDA(At, 0, 0); PG8_STAGE(PG8_SA(1, 1), a1 + hstepA, voffA);
            PG8_WAIT_L(8); PG8_BAR; PG8_WAIT_L(0); PG8_MMA(0, 0, At, B0); PG8_BAR; PG8_SCHED;
            PG8_LDB(B1, 0, 1); PG8_STAGE(PG8_SB(0, 0), b2, voffB);
            PG8_BAR; PG8_WAIT_L(0); PG8_MMA(0, 1, At, B1); PG8_BAR;
            PG8_LDA(At, 0, 1); PG8_STAGE(PG8_SA(0, 0), a2, voffA);
            PG8_BAR; PG8_WAIT_L(0); PG8_MMA(1, 0, At, B0); PG8_BAR; PG8_SCHED;
            PG8_STAGE(PG8_SB(0, 1), b2 + hstepB, voffB);
            PG8_WAIT_V(6); PG8_BAR; PG8_MMA(1, 1, At, B1); PG8_BAR;
            PG8_LDB(B0, 1, 0); PG8_SCHED; PG8_LDA(At, 1, 0); PG8_STAGE(PG8_SA(0, 1), a2 + hstepA, voffA);
            PG8_WAIT_L(8); PG8_BAR; PG8_WAIT_L(0); PG8_MMA(0, 0, At, B0); PG8_BAR; PG8_SCHED;
            PG8_LDB(B1, 1, 1); PG8_STAGE(PG8_SB(1, 0), b3, voffB);
            PG8_BAR; PG8_WAIT_L(0); PG8_MMA(0, 1, At, B1); PG8_BAR;
            PG8_LDA(At, 1, 1); PG8_STAGE(PG8_SA(1, 0), a3, voffA);
            PG8_BAR; PG8_WAIT_L(0); PG8_MMA(1, 0, At, B0); PG8_BAR; PG8_SCHED;
            PG8_STAGE(PG8_SB(1, 1), b3 + hstepB, voffB);
            PG8_WAIT_V(6); PG8_BAR; PG8_MMA(1, 1, At, B1); PG8_BAR;
            }
        }
        if constexpr (ALIGN_EPI) { if (wr == 0) PG8_BAR; }
        if constexpr (!Epi::AFTER_DRAIN) { const int l2_ = mk_tid(wv_) & 63; E(acc, cur, wr, wc, l2_ & 15, l2_ >> 4); S.done(cur); }
        if (!has_next) break;
#pragma unroll
        for (int a = 0; a < 2; ++a)
#pragma unroll
            for (int b = 0; b < 2; ++b)
#pragma unroll
                for (int m = 0; m < 4; ++m)
#pragma unroll
                    for (int n = 0; n < 2; ++n) acc[a][b][m][n] = (f32x4){0.f, 0.f, 0.f, 0.f};
        cur = nxt; cA = nA; cB = nB; ++ui;
        if constexpr (ALIGN_EPI) { if (wr == 1) PG8_BAR; }
    }
    PG8_WAIT_V(0);
    if constexpr (!ALIGN_EPI) { if (wr == 0) PG8_BAR; }
    PG8_BAR;
    if constexpr (Epi::AFTER_DRAIN) { E.fused(acc, cur, wr, wc, fr, fq, lds, wid, lane); S.done(cur); }
#undef PG8_SA
#undef PG8_SB
#undef PG8_STAGE
#undef PG8_LDA
#undef PG8_LDB
#undef PG8_MMA
#undef PG8_WAIT_V
#undef PG8_WAIT_L
#undef PG8_BAR
#undef PG8_SCHED
}
}

#define LAS __attribute__((address_space(3)))
typedef unsigned short bf16_t;
typedef short bf16x8 __attribute__((ext_vector_type(8)));
typedef float f32x4 __attribute__((ext_vector_type(4)));
typedef float f32x16 __attribute__((ext_vector_type(16)));
typedef unsigned u32x4 __attribute__((ext_vector_type(4)));
typedef unsigned u32x2 __attribute__((ext_vector_type(2)));

constexpr int T = 16384, S = 8192, D = 1024, FF = 2816, NZ = 4608, DEPTH = 4, PLE = 256;
constexpr float EPS = 1e-6f;
constexpr int LDV = S + 64;
constexpr int Z_QA = 0, Z_CKV = 512, Z_QI = 640, Z_KI = 896, Z_WI = 928, Z_QB = 936, Z_KVB = 1448, Z_GB = 2216, Z_GM = 2240, Z_KV = 4288;
constexpr int NPH = 50;

constexpr size_t MiB = 1u << 20;
constexpr size_t WS_CTL = 0, CTL_BYTES = 2 * MiB, WS_SS = 64 * 1024;
constexpr size_t WS_ROPE = 2 * MiB, WS_BIAS = 3 * MiB;
constexpr size_t WS_BAR = 16 * 1024;
constexpr int LDS_BARST = 147456 - 64;
constexpr size_t WS_X = 4 * MiB, WS_XG = 68 * MiB, WS_WB0 = 100 * MiB, WS_WB1 = 154 * MiB, WS_Z = 208 * MiB;
constexpr size_t WS_QA = 352 * MiB, WS_QB = 368 * MiB, WS_KA = 384 * MiB, WS_VA = 386 * MiB, WS_QI = 388 * MiB, WS_KI = 396 * MiB, WS_WI = 397 * MiB;
constexpr size_t WS_KCMP = 398 * MiB, WS_VCMP = 403 * MiB, WS_KS = 408 * MiB, WS_KW = 413 * MiB, WS_VST = 418 * MiB, WS_VWT = 423 * MiB;
constexpr size_t WS_GATES = 428 * MiB, WS_HIDK = 430 * MiB, WS_HIDV = 431 * MiB, WS_KC = 432 * MiB, WS_VCT = 433 * MiB, WS_IDX = 434 * MiB, WS_CNT = 442 * MiB;
constexpr size_t WS_OA = 443 * MiB, WS_OB = 459 * MiB, WS_PBF = 475 * MiB  , WS_SSP = 491 * MiB  , WS_SEL = 509 * MiB  , WS_END = 511 * MiB;
constexpr size_t WS_U = WS_Z, WS_PP = WS_Z + 96 * MiB, WS_MERGED = WS_QA, WS_XGB = WS_QA;
constexpr size_t WO_13A = 0, WO_2A = WO_13A + (size_t)2 * FF * D, WO_IN = WO_2A + (size_t)D * FF, WO_CK = WO_IN + (size_t)NZ * D, WO_CV = WO_CK + 256 * 2048,
                 WO_PA = WO_CV + 256 * 2048  , WO_WO = WO_PA + 2048 * 1024, WO_13B = WO_WO + 1024 * 1024, WO_2B = WO_13B + (size_t)2 * FF * D,
                 WO_PG = WO_2B + (size_t)D * FF, WO_PP = WO_PG + 1024 * 1024, WO_END = WO_PP + 1024 * 256;
static_assert(WO_END * 2 <= 54 * MiB, "weight buffer");
constexpr int LDS_BYTES = 147456;

__device__ __forceinline__ unsigned f2bf(float f) { unsigned u = __builtin_bit_cast(unsigned, f); return (u + 0x7fffu + ((u >> 16) & 1u)) >> 16; }
__device__ __forceinline__ unsigned pk2(float lo, float hi) { return f2bf(lo) | (f2bf(hi) << 16); }
__device__ __forceinline__ float bf2f(unsigned h) { return __builtin_bit_cast(float, (h & 0xffffu) << 16); }
__device__ __forceinline__ float bflo(unsigned w) { return __builtin_bit_cast(float, w << 16); }
__device__ __forceinline__ float bfhi(unsigned w) { return __builtin_bit_cast(float, w & 0xffff0000u); }
__device__ __forceinline__ float row_rs(const float* ssp, int r) {
    const f32x4 a = *(const f32x4*)(ssp + (size_t)r * 16), b = *(const f32x4*)(ssp + (size_t)r * 16 + 4), c = *(const f32x4*)(ssp + (size_t)r * 16 + 8), d = *(const f32x4*)(ssp + (size_t)r * 16 + 12);
    const float t = (((a[0] + a[1]) + (a[2] + a[3])) + ((b[0] + b[1]) + (b[2] + b[3]))) + (((c[0] + c[1]) + (c[2] + c[3])) + ((d[0] + d[1]) + (d[2] + d[3])));
    return rsqrtf(t * (1.f / 1024.f) + 1e-6f);
}
__device__ __forceinline__ float sigmoidf_(float v) { return __builtin_amdgcn_rcpf(1.f + __expf(-v)); }
__device__ __forceinline__ float wave_sum(float v) {
#pragma unroll
    for (int o = 1; o < 64; o <<= 1) v += __shfl_xor(v, o);
    return v;
}
#define LDS_WAIT() asm volatile("s_waitcnt lgkmcnt(0)" ::: "memory")

using pg8::Unit;
struct EpiSwiglu {
    static constexpr bool PERM = true, AFTER_DRAIN = false;
    bf16_t* U; const float* ss;
    __device__ __forceinline__ void operator()(const f32x4 (&acc)[2][2][4][2], const Unit& u, int wr, int wc, int fr_, int fq_) const {
        int fr = fr_, fq = fq_; asm volatile("" : "+v"(fr), "+v"(fq));
#pragma unroll
        for (int ai = 0; ai < 2; ++ai)
#pragma unroll
            for (int m = 0; m < 4; ++m) {
                const int r = u.pm * 256 + ai * 128 + wr * 64 + m * 16 + fr;
                const float rs = row_rs(ss, r);
#pragma unroll
                for (int bj = 0; bj < 2; ++bj) {
                    const f32x4 a = acc[ai][bj][m][0] * rs, b = acc[ai][bj][m][1] * rs;
                    float o[4];
#pragma unroll
                    for (int i = 0; i < 4; ++i) o[i] = a[i] * __builtin_amdgcn_rcpf(1.f + __expf(-a[i])) * b[i];
                    u32x2 w; w.x = pk2(o[0], o[1]); w.y = pk2(o[2], o[3]);
                    *(u32x2*)(U + (size_t)r * FF + u.pn * 128 + bj * 64 + wc * 16 + fq * 4) = w;
                }
            }
    }
};
template <int MODE> struct EpiResid {
    static constexpr bool PERM = false, AFTER_DRAIN = false;
    const float* xin; float* xout; bf16_t* xg; const float* gnext; float* ssnext; float alpha; const float* sscur; const bf16_t* pp;
    __device__ __forceinline__ void operator()(const f32x4 (&acc)[2][2][4][2], const Unit& u, int wr, int wc, int fr_, int fq_) const {
        int fr = fr_, fq = fq_; asm volatile("" : "+v"(fr), "+v"(fq));
#pragma unroll
        for (int ai = 0; ai < 2; ++ai)
#pragma unroll
            for (int m = 0; m < 4; ++m) {
                const int r = u.pm * 256 + ai * 128 + wr * 64 + m * 16 + fr;
                float rs = 1.f; if (MODE == 1) rs = row_rs(sscur, r);
                float sq = 0.f;
#pragma unroll
                for (int bj = 0; bj < 2; ++bj)
#pragma unroll
                    for (int n = 0; n < 2; ++n) {
                        const int c = u.pn * 256 + bj * 128 + wc * 32 + n * 16 + fq * 4;
                        const size_t off = (size_t)r * D + c;
                        const f32x4 xi = *(const f32x4*)(xin + off), v = acc[ai][bj][m][n];
                        f32x4 xn;
                        if (MODE == 0) xn = xi + v * alpha;
                        else { const u32x2 pw = *(const u32x2*)(pp + off);
                            xn[0] = xi[0] + sigmoidf_(v[0] * rs) * bflo(pw.x); xn[1] = xi[1] + sigmoidf_(v[1] * rs) * bfhi(pw.x);
                            xn[2] = xi[2] + sigmoidf_(v[2] * rs) * bflo(pw.y); xn[3] = xi[3] + sigmoidf_(v[3] * rs) * bfhi(pw.y); }
                        *(f32x4*)(xout + off) = xn;
                        const f32x4 g = *(const f32x4*)(gnext + c);
                        u32x2 w; w.x = pk2(xn[0] * g[0], xn[1] * g[1]); w.y = pk2(xn[2] * g[2], xn[3] * g[3]);
                        *(u32x2*)(xg + off) = w;
                        sq += (xn[0] * xn[0] + xn[1] * xn[1]) + (xn[2] * xn[2] + xn[3] * xn[3]);
                    }
                sq += __shfl_xor(sq, 16); sq += __shfl_xor(sq, 32);
                if (fq == 0) ssnext[(size_t)r * 16 + u.pn * 4 + wc] = sq;
            }
    }
};
template <int MODE> struct EpiRow {
    static constexpr bool PERM = true, AFTER_DRAIN = false;
    bf16_t* O; int ldc; const float* ss; const float* bias; const bf16_t* gate; int ldg;
    __device__ __forceinline__ void operator()(const f32x4 (&acc)[2][2][4][2], const Unit& u, int wr, int wc, int fr_, int fq_) const {
        int fr = fr_, fq = fq_; asm volatile("" : "+v"(fr), "+v"(fq));
#pragma unroll
        for (int ai = 0; ai < 2; ++ai)
#pragma unroll
            for (int m = 0; m < 4; ++m) {
                const int r = u.pm * 256 + ai * 128 + wr * 64 + m * 16 + fr;
                float rs = 1.f; if (MODE == 0) rs = row_rs(ss, r);
#pragma unroll
                for (int bj = 0; bj < 2; ++bj) {
                    const int c = u.pn * 256 + bj * 128 + wc * 32 + fq * 8;
                    float v[8];
#pragma unroll
                    for (int i = 0; i < 4; ++i) { v[i] = acc[ai][bj][m][0][i]; v[4 + i] = acc[ai][bj][m][1][i]; }
                    if (MODE == 0) {
#pragma unroll
                        for (int i = 0; i < 8; ++i) v[i] *= rs;
                    }
                    if (MODE == 1) {
#pragma unroll
                        for (int i = 0; i < 8; ++i) { const float a = v[i] + bias[c + i]; v[i] = a * __builtin_amdgcn_rcpf(1.f + __expf(-a)); }
                    }
                    if (MODE == 3 || MODE == 4) {
                        const u32x4 gw = *(const u32x4*)(gate + (size_t)r * ldg + c);
                        const unsigned gwa[4] = {gw.x, gw.y, gw.z, gw.w};
#pragma unroll
                        for (int i = 0; i < 4; ++i) { v[2 * i] *= sigmoidf_(bflo(gwa[i])); v[2 * i + 1] *= sigmoidf_(bfhi(gwa[i])); }
                    }
                    bf16_t* op = O + (size_t)r * ldc + c;
                    if (MODE == 4) {
                        const u32x4 ow = *(const u32x4*)op; const unsigned owa[4] = {ow.x, ow.y, ow.z, ow.w};
#pragma unroll
                        for (int i = 0; i < 4; ++i) { v[2 * i] += bflo(owa[i]); v[2 * i + 1] += bfhi(owa[i]); }
                    }
                    u32x4 w; w.x = pk2(v[0], v[1]); w.y = pk2(v[2], v[3]); w.z = pk2(v[4], v[5]); w.w = pk2(v[6], v[7]);
                    *(u32x4*)op = w;
                }
            }
    }
};

struct EpiMerge {
    static constexpr bool PERM = true, AFTER_DRAIN = false;
    bf16_t* O; const bf16_t* z;
    __device__ __forceinline__ void operator()(const f32x4 (&acc)[2][2][4][2], const Unit& u, int wr, int wc, int fr_, int fq_) const {
        int fr = fr_, fq = fq_; asm volatile("" : "+v"(fr), "+v"(fq));
#pragma unroll
        for (int ai = 0; ai < 2; ++ai)
#pragma unroll
            for (int m = 0; m < 4; ++m) {
                const int r = u.pm * 256 + ai * 128 + wr * 64 + m * 16 + fr;
#pragma unroll
                for (int bj = 0; bj < 2; ++bj) {
                    const int c = u.pn * 128 + bj * 64 + wc * 16 + fq * 4;
                    const u32x2 ga = *(const u32x2*)(z + (size_t)r * NZ + Z_GM + c), gb = *(const u32x2*)(z + (size_t)r * NZ + Z_GM + 1024 + c);
                    const f32x4 a = acc[ai][bj][m][0], b = acc[ai][bj][m][1];
                    u32x2 w;
                    w.x = pk2(sigmoidf_(bflo(ga.x)) * a[0] + sigmoidf_(bflo(gb.x)) * b[0], sigmoidf_(bfhi(ga.x)) * a[1] + sigmoidf_(bfhi(gb.x)) * b[1]);
                    w.y = pk2(sigmoidf_(bflo(ga.y)) * a[2] + sigmoidf_(bflo(gb.y)) * b[2], sigmoidf_(bfhi(ga.y)) * a[3] + sigmoidf_(bfhi(gb.y)) * b[3]);
                    *(u32x2*)(O + (size_t)r * D + c) = w;
                }
            }
    }
};
template <class Epi> __device__ __forceinline__ void run_gemm(LAS unsigned char* lds, const bf16_t* A, int lda, const bf16_t* Bt, int M, int N, int K, int cshift, const Epi& E, int wv) {
    pg8::Gemm g{A, Bt, M, N, K, lda};
    pg8::StaticOrder So; So.init(M, N, mk_grid(), (int)((mk_bid() + mk_grid() - cshift) % mk_grid()));
    pg8::gemm_phase<Epi, pg8::StaticOrder, true, true>(lds, g, So, E, wv);
}

__device__ __forceinline__ void transpose_item(const float* W, int K, int N, bf16_t* WT, int row_off, int mode, LAS float* scr, int item, int lane, int ldw = 0, int koff = 0) {
    if (ldw == 0) ldw = K;
    const int nblk = N / 32, kb = item / nblk, nb = item % nblk, k0 = 64 * kb, n0 = 32 * nb;
    const int kr = lane >> 3, n4 = (lane & 7) * 4;
#pragma unroll
    for (int i = 0; i < 8; ++i) { const int kk = 8 * i + kr; const f32x4 v = *(const f32x4*)(W + (size_t)(k0 + kk) * N + n0 + n4);
        LAS float* d = scr + kk * 33 + n4; d[0] = v[0]; d[1] = v[1]; d[2] = v[2]; d[3] = v[3]; }
    LDS_WAIT();
    const int c = lane & 7;
#pragma unroll
    for (int j = 0; j < 4; ++j) { const int nl = (lane >> 3) + 8 * j; const LAS float* s = scr + (8 * c) * 33 + nl;
        u32x4 o; o.x = pk2(s[0 * 33], s[1 * 33]); o.y = pk2(s[2 * 33], s[3 * 33]); o.z = pk2(s[4 * 33], s[5 * 33]); o.w = pk2(s[6 * 33], s[7 * 33]);
        const int n = n0 + nl; const int dr = mode == 0 ? row_off + n : (8 * (n >> 2) + (n & 3) + (mode == 2 ? 4 : 0));
        *(u32x4*)(WT + (size_t)dr * ldw + koff + k0 + 8 * c) = o; }
    LDS_WAIT();
}

struct P {
    const float* in[26];
    float* out; unsigned char* ws;
    int ph_lo, ph_hi;
};
typedef const __attribute__((address_space(4))) P* KP;

__device__ __forceinline__ void convert_layer(KP p, int L, bf16_t* WB, LAS unsigned char* lds, int wv) {
    int tid_ = mk_tid(wv); asm volatile("" : "+v"(tid_)); const int tid = tid_, lane = tid & 63; int wave = wv; asm volatile("" : "+s"(wave));
    LAS float* scr = (LAS float*)(lds + wave * 16384);
    const int gw = mk_bid() * 8 + wave, NGW = mk_grid() * 8;
    constexpr int I_13 = 16 * 88, I_2 = 44 * 32, I_IN = 16 * 134, I_C = 32 * 8, I_PR = 8 * 32, I_SQ = 16 * 32, I_PP = 4 * 32;
    constexpr int NIT = 4 * I_13 + 2 * I_2 + I_IN + 2 * I_C + 2 * I_PR + 2 * I_SQ + I_PP;
    const size_t l13 = (size_t)L * D * FF, lsq = (size_t)L * D * D;
    for (int it = gw; it < NIT; it += NGW) {
        int r = it;
        if (r < I_13) { transpose_item(p->in[3] + l13, D, FF, WB + WO_13A, 0, 1, scr, r, lane); continue; } r -= I_13;
        if (r < I_13) { transpose_item(p->in[4] + l13, D, FF, WB + WO_13A, 0, 2, scr, r, lane); continue; } r -= I_13;
        if (r < I_2) { transpose_item(p->in[5] + l13, FF, D, WB + WO_2A, 0, 0, scr, r, lane); continue; } r -= I_2;
        if (r < I_IN) { transpose_item(p->in[7] + (size_t)L * D * 4288, D, 4288, WB + WO_IN, 0, 0, scr, r, lane); continue; } r -= I_IN;
        if (r < I_C) { transpose_item(p->in[11] + (size_t)L * 2048 * 256, 2048, 256, WB + WO_CK, 0, 0, scr, r, lane); continue; } r -= I_C;
        if (r < I_C) { transpose_item(p->in[13] + (size_t)L * 2048 * 256, 2048, 256, WB + WO_CV, 0, 0, scr, r, lane); continue; } r -= I_C;
        if (r < I_PR) { transpose_item(p->in[15] + (size_t)L * 512 * D, 512, D, WB + WO_PA, 0, 1, scr, r, lane, 1024, 0); continue; } r -= I_PR;
        if (r < I_PR) { transpose_item(p->in[16] + (size_t)L * 512 * D, 512, D, WB + WO_PA, 0, 2, scr, r, lane, 1024, 512); continue; } r -= I_PR;
        if (r < I_SQ) { transpose_item(p->in[17] + lsq, D, D, WB + WO_WO, 0, 0, scr, r, lane); continue; } r -= I_SQ;
        if (r < I_13) { transpose_item(p->in[19] + l13, D, FF, WB + WO_13B, 0, 1, scr, r, lane); continue; } r -= I_13;
        if (r < I_13) { transpose_item(p->in[20] + l13, D, FF, WB + WO_13B, 0, 2, scr, r, lane); continue; } r -= I_13;
        if (r < I_2) { transpose_item(p->in[21] + l13, FF, D, WB + WO_2B, 0, 0, scr, r, lane); continue; } r -= I_2;
        if (r < I_SQ) { transpose_item(p->in[23] + lsq, D, D, WB + WO_PG, 0, 0, scr, r, lane); continue; } r -= I_SQ;
        transpose_item(p->in[24] + (size_t)L * PLE * D, PLE, D, WB + WO_PP, 0, 0, scr, r, lane);
    }
    const int gt = mk_bid() * 512 + tid, NGT = mk_grid() * 512;
    const float* win = p->in[7] + (size_t)L * D * 4288; const float* gkv = p->in[8] + L * 128; const float* ukv = p->in[9] + (size_t)L * 128 * 128;
    for (int o = gt; o < 128 * 1024; o += NGT) {
        const int n = o & 127, k = o >> 7; float a = 0.f;
        for (int j = 0; j < 128; ++j) a += win[(size_t)k * 4288 + 512 + j] * gkv[j] * ukv[j * 128 + n];
        WB[WO_IN + (size_t)(4288 + n) * D + k] = (bf16_t)f2bf(a);
    }
    for (int o = gt; o < 2048 * 64; o += NGT) { const int row = o >> 6, ch = o & 63; unsigned zz; asm volatile("v_mov_b32 %0, 0" : "=v"(zz));
        *(u32x4*)(WB + WO_PA + (size_t)row * 1024 + ((row & 4) ? 0 : 512) + ch * 8) = (u32x4){zz, zz, zz, zz}; }
    for (int o = gt; o < 192 * 1024 / 8; o += NGT) { unsigned zz; asm volatile("v_mov_b32 %0, 0" : "=v"(zz)); *(u32x4*)(WB + WO_IN + (size_t)4416 * D + (size_t)o * 8) = (u32x4){zz, zz, zz, zz}; }
    float* bias = (float*)(p->ws + WS_BIAS);
    for (int o = gw; o < 512; o += NGW) {
        const int n = o & 255, kv = o >> 8; const float* w1 = p->in[kv ? 13 : 11] + (size_t)L * 2048 * 256; const float* pos = p->in[10] + L * 2048; float a = 0.f;
#pragma unroll 8
        for (int k = lane; k < 2048; k += 64) a += pos[k] * w1[(size_t)k * 256 + n];
        a = wave_sum(a);
        if (lane == 0) bias[o] = a;
    }
    const float* pl = p->in[1] + (size_t)L * T * PLE; bf16_t* pb = (bf16_t*)(p->ws + WS_PBF) + (size_t)(L & 1) * T * PLE;
    for (int o = gt; o < T * PLE / 8; o += NGT) { const f32x4 a = *(const f32x4*)(pl + (size_t)o * 8), b = *(const f32x4*)(pl + (size_t)o * 8 + 4);
        u32x4 w; w.x = pk2(a[0], a[1]); w.y = pk2(a[2], a[3]); w.z = pk2(b[0], b[1]); w.w = pk2(b[2], b[3]); *(u32x4*)(pb + (size_t)o * 8) = w; }
}

__device__ __forceinline__ void prologue_phase(KP p, LAS unsigned char* lds, int wv) {
    int tid_ = mk_tid(wv); asm volatile("" : "+v"(tid_)); const int tid = tid_, lane = tid & 63; int wave = wv; asm volatile("" : "+s"(wave));
    const int gt = mk_bid() * 512 + tid, NGT = mk_grid() * 512;
    float* rope = (float*)(p->ws + WS_ROPE);
    for (int o = gt; o < S * 12; o += NGT) {
        int pos, j; float inv;
        if (o < S * 8) { pos = o >> 3; j = o & 7;
            inv = j == 0 ? 1.0f : j == 1 ? 0.19392274f : j == 2 ? 0.037606031f : j == 3 ? 0.0072926646f : j == 4 ? 0.0014142136f : j == 5 ? 0.00027424819f : j == 6 ? 5.3182957e-05f : 1.0313385e-05f; }
        else { const int o2 = o - S * 8; pos = o2 >> 2; j = o2 & 3;
            inv = j == 0 ? 1.0f : j == 1 ? 0.037606031f : j == 2 ? 0.0014142136f : 5.3182957e-05f; }
        const float ang = (float)pos * inv;
        const double rev = (double)ang * 0.15915494309189533577;
        const float fr = (float)(rev - __builtin_floor(rev));
        const float c = __builtin_amdgcn_cosf(fr), s = __builtin_amdgcn_sinf(fr);
        if (o < S * 8) { rope[o] = c; rope[S * 8 + o] = s; } else { rope[S * 16 + (o - S * 8)] = c; rope[S * 20 + (o - S * 8)] = s; }
    }
    convert_layer(p, 0, (bf16_t*)(p->ws + WS_WB0), lds, wv);
    const float* x = p->in[0]; const float* g = p->in[2]; bf16_t* xg = (bf16_t*)(p->ws + WS_XG); float* ss = (float*)(p->ws + WS_SSP);
    const int gw = mk_bid() * 8 + wave, NGW = mk_grid() * 8;
    for (int r = gw; r < T; r += NGW) {
        float sq = 0.f;
#pragma unroll
        for (int j = 0; j < 4; ++j) { const int c = (j * 64 + lane) * 4; const f32x4 v = *(const f32x4*)(x + (size_t)r * D + c), gg = *(const f32x4*)(g + c);
            sq += (v[0] * v[0] + v[1] * v[1]) + (v[2] * v[2] + v[3] * v[3]);
            u32x2 w; w.x = pk2(v[0] * gg[0], v[1] * gg[1]); w.y = pk2(v[2] * gg[2], v[3] * gg[3]); *(u32x2*)(xg + (size_t)r * D + c) = w; }
        sq = wave_sum(sq);
        if (lane < 16) ss[(size_t)r * 16 + lane] = lane == 0 ? sq : 0.f;
    }
}

__device__ __forceinline__ float rope_at(const LAS bf16_t* base, int d, int half, const float* cs, const float* sn) {
    const int j = d < half ? d : d - half;
    const float x1 = bf2f(base[j]), x2 = bf2f(base[j + half]);
    return d < half ? x1 * cs[j] - x2 * sn[j] : x2 * cs[j] + x1 * sn[j];
}
__device__ __forceinline__ void post_phase(KP p, LAS unsigned char* lds, int wv) {
    int tid_ = mk_tid(wv); asm volatile("" : "+v"(tid_)); const int tid = tid_, lane = tid & 63; int wave = wv; asm volatile("" : "+s"(wave));
    LAS bf16_t* zr = (LAS bf16_t*)(lds + wave * 16384);
    LAS bf16_t* vt = (LAS bf16_t*)(lds + wave * 16384 + 9216);
    const bf16_t* Z = (const bf16_t*)(p->ws + WS_Z);
    const float* rope = (const float*)(p->ws + WS_ROPE);
    bf16_t* QA = (bf16_t*)(p->ws + WS_QA); bf16_t* QB = (bf16_t*)(p->ws + WS_QB); bf16_t* KA = (bf16_t*)(p->ws + WS_KA); bf16_t* VA = (bf16_t*)(p->ws + WS_VA);
    bf16_t* QI = (bf16_t*)(p->ws + WS_QI); bf16_t* KI = (bf16_t*)(p->ws + WS_KI); float* WI = (float*)(p->ws + WS_WI); float* GATES = (float*)(p->ws + WS_GATES);
    bf16_t* KCMP = (bf16_t*)(p->ws + WS_KCMP); bf16_t* VCMP = (bf16_t*)(p->ws + WS_VCMP); bf16_t* KS = (bf16_t*)(p->ws + WS_KS); bf16_t* KW = (bf16_t*)(p->ws + WS_KW);
    bf16_t* VST = (bf16_t*)(p->ws + WS_VST); bf16_t* VWT = (bf16_t*)(p->ws + WS_VWT);
    const int gw = mk_bid() * 8 + wave, NGW = mk_grid() * 8;
    for (int grp = gw; grp < T / 8; grp += NGW) {
        const int tg0 = grp * 8, b = tg0 >> 13, s0 = tg0 & (S - 1);
        for (int tt = 0; tt < 8; ++tt) {
            const int tg = tg0 + tt, s = s0 + tt;
            LDS_WAIT();
#pragma unroll
            for (int i = 0; i < 9; ++i) *(LAS u32x4*)(zr + (i * 64 + lane) * 8) = *(const u32x4*)(Z + (size_t)tg * NZ + (i * 64 + lane) * 8);
            LDS_WAIT();
            const float* c16 = rope + s * 8; const float* s16 = rope + S * 8 + s * 8; const float* c8 = rope + S * 16 + s * 4; const float* s8 = rope + S * 20 + s * 4;
#pragma unroll
            for (int i = 0; i < 8; ++i) { const int e = lane + 64 * i, d = e & 63;
                float va = d < 16 ? rope_at(zr + Z_QA + (e & ~63), d, 8, c16, s16) : bf2f(zr[Z_QA + e]);
                float vb = d < 16 ? rope_at(zr + Z_QB + (e & ~63), d, 8, c16, s16) : bf2f(zr[Z_QB + e]);
                QA[(size_t)tg * 512 + e] = (bf16_t)f2bf(va * 0.18033688011112042f); QB[(size_t)tg * 512 + e] = (bf16_t)f2bf(vb * 0.18033688011112042f); }
#pragma unroll
            for (int i = 0; i < 4; ++i) { const int e = lane + 64 * i, d = e & 31;
                float v = d < 8 ? rope_at(zr + Z_QI + (e & ~31), d, 4, c8, s8) : bf2f(zr[Z_QI + e]);
                QI[(size_t)tg * 256 + e] = (bf16_t)f2bf(v); }
            if (lane < 32) { const int d = lane; float v = d < 8 ? rope_at(zr + Z_KI, d, 4, c8, s8) : bf2f(zr[Z_KI + d]); KI[(size_t)tg * 32 + d] = (bf16_t)f2bf(v); }
            if (lane < 8) WI[(size_t)tg * 8 + lane] = bf2f(zr[Z_WI + lane]) * 0.35355339059327373f;
            if (lane < 24) GATES[(size_t)tg * 24 + lane] = sigmoidf_(bf2f(zr[Z_GB + lane]));
            { const float a = bf2f(zr[Z_CKV + lane]), c = bf2f(zr[Z_CKV + 64 + lane]);
              const float rs = rsqrtf(wave_sum(a * a + c * c) * (1.f / 128.f) + EPS);
              const int d = lane;
              float kv = d < 16 ? rope_at(zr + Z_KV, d, 8, c16, s16) : bf2f(zr[Z_KV + d]);
              KA[(size_t)tg * 64 + d] = (bf16_t)f2bf(kv * rs);
              VA[(size_t)tg * 64 + d] = (bf16_t)f2bf(bf2f(zr[Z_KV + 64 + d]) * rs); }
#pragma unroll
            for (int i = 0; i < 2; ++i) { const int e = lane + 64 * i, g = i, d = lane;
                const size_t dst = ((size_t)(b * 2 + g) * S + s) * 64 + d;
                float kc = d < 16 ? rope_at(zr + Z_KVB + 0 + g * 64, d, 8, c16, s16) : bf2f(zr[Z_KVB + 0 + e]);
                float ks = d < 16 ? rope_at(zr + Z_KVB + 256 + g * 64, d, 8, c16, s16) : bf2f(zr[Z_KVB + 256 + e]);
                float kw = d < 16 ? rope_at(zr + Z_KVB + 512 + g * 64, d, 8, c16, s16) : bf2f(zr[Z_KVB + 512 + e]);
                KCMP[dst] = (bf16_t)f2bf(kc); KS[dst] = (bf16_t)f2bf(ks); KW[dst] = (bf16_t)f2bf(kw);
                VCMP[dst] = zr[Z_KVB + 128 + e];
                vt[(e) * 8 + tt] = zr[Z_KVB + 384 + e];
                vt[(128 + e) * 8 + tt] = zr[Z_KVB + 640 + e]; }
        }
        LDS_WAIT();
#pragma unroll
        for (int i = 0; i < 4; ++i) { const int rr = lane + 64 * i, e = rr & 127, g = e >> 6, d = e & 63;
            bf16_t* dst = (rr >> 7 ? VWT : VST) + ((size_t)(b * 2 + g) * 64 + d) * LDV + s0;
            *(u32x4*)dst = *(const LAS u32x4*)(vt + rr * 8); }
        LDS_WAIT();
    }
}

__device__ __forceinline__ void cmp2_phase(KP p, int L, int wv) {
    int tid_ = mk_tid(wv); asm volatile("" : "+v"(tid_)); const int gt = mk_bid() * 512 + tid_, NGT = mk_grid() * 512;
    bf16_t* KC = (bf16_t*)(p->ws + WS_KC); bf16_t* VCT = (bf16_t*)(p->ws + WS_VCT);
    for (int o = gt; o < 2 * 2048 * 64; o += NGT) {
        const int n = o & 63, r = (o >> 6) & 2047, kv = o >> 17;
        const bf16_t* hid = (const bf16_t*)(p->ws + (kv ? WS_HIDV : WS_HIDK)) + (size_t)r * 256;
        const float* w2 = p->in[kv ? 14 : 12] + (size_t)L * 256 * 64;
        float a = 0.f;
        for (int j = 0; j < 256; ++j) a += bf2f(hid[j]) * w2[j * 64 + n];
        if (kv == 0) KC[(size_t)r * 64 + n] = (bf16_t)f2bf(a);
        else VCT[((size_t)(r >> 9) * 64 + n) * 512 + (r & 511)] = (bf16_t)f2bf(a);
    }
}

__device__ __forceinline__ unsigned quant16(float v, float lo, float scale) { const float q = (v - lo) * scale; return min(65535u, (unsigned)q); }
__device__ __forceinline__ void scan_bins(const LAS unsigned* h, unsigned need, int lane, LAS int* outb, LAS int* outneed) {
    const unsigned h0 = h[4 * lane], h1 = h[4 * lane + 1], h2 = h[4 * lane + 2], h3 = h[4 * lane + 3];
    const unsigned tot = h0 + h1 + h2 + h3;
    unsigned suf = tot;
#pragma unroll
    for (int o = 1; o < 64; o <<= 1) { const unsigned t = __shfl_down(suf, o); if (lane + o < 64) suf += t; }
    unsigned cum = suf - tot;
    const unsigned hh[4] = {h0, h1, h2, h3};
#pragma unroll
    for (int b = 3; b >= 0; --b) { if (cum < need && cum + hh[b] >= need) { *outb = 4 * lane + b; *outneed = (int)(need - cum); } cum += hh[b]; }
}
__device__ __forceinline__ void indexer_phase(KP p, LAS unsigned char* lds, int L, int wv, int cslot, const bool score_only = false) {
    int tid_ = mk_tid(wv); asm volatile("" : "+v"(tid_)); const int tid = tid_, lane = tid & 63; int wave = wv; asm volatile("" : "+s"(wave));
    LAS float* sc = (LAS float*)lds;
    LAS unsigned* hist = (LAS unsigned*)(lds + 131072);
    LAS float* mm = (LAS float*)(lds + 131072 + 4096);
    LAS int* ctl = (LAS int*)(lds + 131072 + 4096 + 256);
    const bf16_t* QI = (const bf16_t*)(p->ws + WS_QI); const bf16_t* KI = (const bf16_t*)(p->ws + WS_KI); const float* WI = (const float*)(p->ws + WS_WI);
    unsigned short* IDX = (unsigned short*)(p->ws + WS_IDX); int* CNT = (int*)(p->ws + WS_CNT);
    unsigned* ctr = (unsigned*)(p->ws + WS_CTL) + 64 * L + cslot;
    const int r = lane & 31, hi = lane >> 5;
    for (;;) {
        __syncthreads();
        if (tid == 0) ctl[0] = (int)atomicAdd(ctr, 1u);
        for (int i = tid; i < 1024; i += 512) hist[i] = 0u;
        __syncthreads();
        const int item = ctl[0];
        if (item >= T / 4) break;
        const int tg0 = (T / 4 - 1 - item) * 4, b = tg0 >> 13, s0 = tg0 & (S - 1);
        const int ntile = (s0 + 4 + 31) >> 5;
        const int i16 = (r & 3) + 4 * (r >> 3), aq = 2 * ((r >> 2) & 1) + (i16 >> 3), ah = i16 & 7;
        const bf16_t* qp = QI + (size_t)(tg0 + aq) * 256 + ah * 32 + 8 * hi;
        const bf16x8 a0 = *(const bf16x8*)qp, a1 = *(const bf16x8*)(qp + 16);
        float w[16];
#pragma unroll
        for (int i = 0; i < 16; ++i) w[i] = WI[(size_t)(tg0 + 2 * hi + (i >> 3)) * 8 + (i & 7)];
        float mn2[2] = {3.0e38f, 3.0e38f}, mx2[2] = {-3.0e38f, -3.0e38f};
        for (int kt = wave; kt < ntile; kt += 8) {
            const int key = kt * 32 + r;
            const bf16_t* kp = KI + ((size_t)b * S + key) * 32 + 8 * hi;
            const bf16x8 b0 = *(const bf16x8*)kp, b1 = *(const bf16x8*)(kp + 16);
            f32x16 acc;
#pragma unroll
            for (int i = 0; i < 16; ++i) acc[i] = 0.f;
            acc = __builtin_amdgcn_mfma_f32_32x32x16_bf16(a0, b0, acc, 0, 0, 0);
            acc = __builtin_amdgcn_mfma_f32_32x32x16_bf16(a1, b1, acc, 0, 0, 0);
#pragma unroll
            for (int ql = 0; ql < 2; ++ql) {
                float pq = 0.f;
#pragma unroll
                for (int i = 0; i < 8; ++i) pq += w[ql * 8 + i] * fmaxf(acc[8 * ql + i], 0.f);
                const int q = 2 * hi + ql;
                const bool valid = key <= s0 + q;
                const float plo = valid ? pq : -3.0e38f;
                mn2[ql] = fminf(mn2[ql], valid ? pq : 3.0e38f); mx2[ql] = fmaxf(mx2[ql], plo);
                sc[q * 8192 + key] = plo;
            }
        }
        float mn[4], mx[4];
#pragma unroll
        for (int q = 0; q < 4; ++q) { const bool own = hi == (q >> 1); mn[q] = own ? mn2[q & 1] : 3.0e38f; mx[q] = own ? mx2[q & 1] : -3.0e38f; }
#pragma unroll
        for (int q = 0; q < 4; ++q)
#pragma unroll
            for (int o = 1; o < 64; o <<= 1) { mn[q] = fminf(mn[q], __shfl_xor(mn[q], o)); mx[q] = fmaxf(mx[q], __shfl_xor(mx[q], o)); }
        if (lane == 0) {
#pragma unroll
            for (int q = 0; q < 4; ++q) { mm[wave * 8 + q] = mn[q]; mm[wave * 8 + 4 + q] = mx[q]; }
        }
        __syncthreads();
        if (score_only) continue;
        {
            const int row = tid >> 7, j = tid & 127, nrow = s0 + row + 1;
            float lo = 3.0e38f, hv = -3.0e38f;
#pragma unroll
            for (int w8 = 0; w8 < 8; ++w8) { lo = fminf(lo, mm[w8 * 8 + row]); hv = fmaxf(hv, mm[w8 * 8 + 4 + row]); }
            const float scale = hv > lo ? 65535.f / (hv - lo) : 0.f;
            if (nrow > 256) for (int i = j; i < nrow; i += 128) __hip_atomic_fetch_add(&hist[row * 256 + (quant16(sc[row * 8192 + i], lo, scale) >> 8)], 1u, __ATOMIC_RELAXED, __HIP_MEMORY_SCOPE_WORKGROUP);
            __syncthreads();
            if (wave < 4 && s0 + wave + 1 > 256) scan_bins(hist + wave * 256, 256u, lane, ctl + 4 + wave, ctl + 8 + wave);
            __syncthreads();
            for (int i = tid; i < 1024; i += 512) hist[i] = 0u;
            __syncthreads();
            if (nrow > 256) { const unsigned B1 = (unsigned)ctl[4 + row];
                for (int i = j; i < nrow; i += 128) { const unsigned k16 = quant16(sc[row * 8192 + i], lo, scale); if ((k16 >> 8) == B1) __hip_atomic_fetch_add(&hist[row * 256 + (k16 & 255u)], 1u, __ATOMIC_RELAXED, __HIP_MEMORY_SCOPE_WORKGROUP); } }
            __syncthreads();
            if (wave < 4 && s0 + wave + 1 > 256) scan_bins(hist + wave * 256, (unsigned)ctl[8 + wave], lane, ctl + 12 + wave, ctl + 16 + wave);
            __syncthreads();
        }
        {
            const int row = tid >> 7, j = tid & 127, nrow = s0 + row + 1; const size_t tg = (size_t)tg0 + row;
            const bool big = nrow > 256;
            float lo = 3.0e38f, hv = -3.0e38f;
#pragma unroll
            for (int w8 = 0; w8 < 8; ++w8) { lo = fminf(lo, mm[w8 * 8 + row]); hv = fmaxf(hv, mm[w8 * 8 + 4 + row]); }
            const float scale = hv > lo ? 65535.f / (hv - lo) : 0.f;
            const unsigned T16 = ((unsigned)ctl[4 + row] << 8) | (unsigned)ctl[12 + row]; const int need2 = ctl[16 + row];
            const int chunk = ((nrow + 127) >> 7) | 1, beg = j * chunk, end = min(beg + chunk, nrow);
            int cg = 0, ce = 0;
            if (big) for (int i = beg; i < end; ++i) { const unsigned k16 = quant16(sc[row * 8192 + i], lo, scale); cg += k16 > T16 ? 1 : 0; ce += k16 == T16 ? 1 : 0; }
            const unsigned v = (unsigned)cg | ((unsigned)ce << 16);
            unsigned incl = v;
#pragma unroll
            for (int o = 1; o < 64; o <<= 1) { const unsigned t = __shfl_up(incl, o); if (lane >= o) incl += t; }
            LAS unsigned* wsum = (LAS unsigned*)(ctl + 32);
            if (lane == 63) wsum[wave] = incl;
            __syncthreads();
            const unsigned pre = incl - v + ((wave & 1) ? wsum[wave - 1] : 0u);
            if (big) {
                int eb = (int)(pre >> 16); int pos = (int)(pre & 0xffffu) + min(eb, need2);
                for (int i = beg; i < end; ++i) { const unsigned k16 = quant16(sc[row * 8192 + i], lo, scale);
                    if (k16 > T16) { if (pos < 256) IDX[tg * 256 + pos] = (unsigned short)i; ++pos; }
                    else if (k16 == T16) { if (eb < need2) { if (pos < 256) IDX[tg * 256 + pos] = (unsigned short)i; ++pos; } ++eb; } }
                if (j == 0) CNT[tg] = 256;
            } else {
#pragma unroll
                for (int i = 0; i < 2; ++i) { const int e = j + 128 * i; IDX[tg * 256 + e] = (unsigned short)(e < nrow ? e : 0); }
                if (j == 0) CNT[tg] = nrow;
            }
        }
    }
}

__device__ __forceinline__ f32x4 mfma16(bf16x8 a, bf16x8 b, f32x4 c) { return __builtin_amdgcn_mfma_f32_16x16x32_bf16(a, b, c, 0, 0, 0); }
__device__ __forceinline__ float ex2(float v) { return __builtin_amdgcn_exp2f(v); }
__device__ __forceinline__ float fmax2(float a, float b) { return __builtin_amdgcn_fmed3f(a, b, __builtin_inff()); }
__device__ __forceinline__ float fmax3(float a, float b, float c) { return fmax2(fmax2(a, b), c); }
__device__ __forceinline__ unsigned cvtpk(float lo, float hi) { unsigned r; asm("v_cvt_pk_bf16_f32 %0, %1, %2" : "=v"(r) : "v"(lo), "v"(hi)); return r; }
__device__ __forceinline__ void load_k64(const bf16_t* Kb, int kb, int krow0, int kq, bf16x8 (&k)[8]) {
#pragma unroll
    for (int j = 0; j < 4; ++j) { const bf16_t* p = Kb + (size_t)(kb + 32 * (j >> 1) + 4 * (j & 1) + krow0) * 64 + 8 * kq; k[2 * j] = *(const bf16x8*)p; k[2 * j + 1] = *(const bf16x8*)(p + 32); }
}
__device__ __forceinline__ void load_v64(const bf16_t* Vt, int ldv, int kb, int lc, int kq, bf16x8 (&v)[8]) {
#pragma unroll
    for (int dt = 0; dt < 4; ++dt) { const bf16_t* p = Vt + (size_t)(16 * dt + lc) * ldv + kb + 8 * kq; v[2 * dt] = *(const bf16x8*)p; v[2 * dt + 1] = *(const bf16x8*)(p + 32); }
}
__device__ __forceinline__ void qk64(const bf16x8 (&k)[8], bf16x8 q0, bf16x8 q1, float (&s)[16]) {
    __builtin_amdgcn_s_setprio(1);
#pragma unroll
    for (int j = 0; j < 4; ++j) { f32x4 a = (f32x4){0.f, 0.f, 0.f, 0.f}; a = mfma16(k[2 * j], q0, a); a = mfma16(k[2 * j + 1], q1, a);
#pragma unroll
        for (int i = 0; i < 4; ++i) s[(j >> 1) * 8 + (j & 1) * 4 + i] = a[i]; }
    __builtin_amdgcn_s_setprio(0);
}
#define VAL64(d, lim, i) ((unsigned)((d) - (32 * ((i) >> 3) + ((i) & 7))) < (lim))
template <bool FULL> __device__ __forceinline__ void sm64(const float (&s)[16], int d, unsigned lim, float& m, float& l, f32x4 (&o)[4], bf16x8& pf0, bf16x8& pf1) {
    float mx = -1e30f;
#pragma unroll
    for (int i = 0; i < 16; i += 2) mx = fmax3(mx, (FULL || VAL64(d, lim, i)) ? s[i] : -1e30f, (FULL || VAL64(d, lim, i + 1)) ? s[i + 1] : -1e30f);
    mx = fmax2(mx, __shfl_xor(mx, 16)); mx = fmax2(mx, __shfl_xor(mx, 32));
    const float mn = fmax2(m, mx), alpha = ex2(m - mn);
    float pr[16], sum = 0.f;
#pragma unroll
    for (int i = 0; i < 16; ++i) { pr[i] = (FULL || VAL64(d, lim, i)) ? ex2(s[i] - mn) : 0.f; sum += pr[i]; }
    l = l * alpha + sum; m = mn;
#pragma unroll
    for (int dt = 0; dt < 4; ++dt) o[dt] = o[dt] * alpha;
    u32x4 w0, w1;
    w0.x = cvtpk(pr[0], pr[1]); w0.y = cvtpk(pr[2], pr[3]); w0.z = cvtpk(pr[4], pr[5]); w0.w = cvtpk(pr[6], pr[7]);
    w1.x = cvtpk(pr[8], pr[9]); w1.y = cvtpk(pr[10], pr[11]); w1.z = cvtpk(pr[12], pr[13]); w1.w = cvtpk(pr[14], pr[15]);
    pf0 = __builtin_bit_cast(bf16x8, w0); pf1 = __builtin_bit_cast(bf16x8, w1);
}
__device__ __forceinline__ void pv64(const bf16x8 (&v)[8], bf16x8 pf0, bf16x8 pf1, f32x4 (&o)[4]) {
    __builtin_amdgcn_s_setprio(1);
#pragma unroll
    for (int dt = 0; dt < 4; ++dt) { o[dt] = mfma16(v[2 * dt], pf0, o[dt]); o[dt] = mfma16(v[2 * dt + 1], pf1, o[dt]); }
    __builtin_amdgcn_s_setprio(0);
}
struct WinF { int kb0, tq, kq, s0; static constexpr unsigned LIM = 512u;
    __device__ __forceinline__ int kb(int i) const { return kb0 + 64 * i; }
    __device__ __forceinline__ bool full(int kbv) const { return kbv + 63 <= s0 && kbv > s0 + 15 - 512; }
    __device__ __forceinline__ int d(int kbv) const { return tq - kbv - 8 * kq; } };
struct SelF { int selv; int tq, kq, tqu; static constexpr unsigned LIM = 0x80000000u;
    __device__ __forceinline__ int kb(int i) const { return 64 * __builtin_amdgcn_readlane(selv, i); }
    __device__ __forceinline__ bool full(int kbv) const { return kbv + 63 <= tqu; }
    __device__ __forceinline__ int d(int kbv) const { return tq - kbv - 8 * kq; } };
template <class F> __device__ __forceinline__ void attn_blocks(const bf16_t* Kb, const bf16_t* Vt, int ldv, int n, const F& f, bf16x8 q0, bf16x8 q1, float& m, float& l, f32x4 (&o)[4], int lc, int kq, int krow0) {
    bf16x8 kA[8], kB[8], vA[8];
    int kbc = f.kb(0);
    load_k64(Kb, kbc, krow0, kq, kA);
#define ATT_STEP(KC, KN, idx) { \
        int kbn = kbc; const bool more = (idx) + 1 < n; \
        load_v64(Vt, ldv, kbc, lc, kq, vA); \
        if (more) { kbn = f.kb((idx) + 1); load_k64(Kb, kbn, krow0, kq, KN); } \
        __builtin_amdgcn_sched_barrier(0); \
        float s[16]; qk64(KC, q0, q1, s); bf16x8 pf0, pf1; if (f.full(kbc)) sm64<true>(s, 0, 0u, m, l, o, pf0, pf1); else sm64<false>(s, f.d(kbc), F::LIM, m, l, o, pf0, pf1); pv64(vA, pf0, pf1, o); kbc = kbn; __builtin_amdgcn_sched_barrier(0); }
#pragma unroll 1
    for (int i = 0; i < n; i += 2) {
        ATT_STEP(kA, kB, i)
        if (i + 1 < n) ATT_STEP(kB, kA, i + 1)
    }
#undef ATT_STEP
}
struct StgW { LAS unsigned char* gb; const bf16_t* kg; const bf16_t* vg; int wofs; };
__device__ __forceinline__ StgW stg_make(LAS unsigned char* stg, const bf16_t* Kb, const bf16_t* Vt, int ldv, int wave, int lane) {
    const int w4 = wave & 3, lr = lane >> 2, lcn = lane & 3; StgW w;
    w.gb = stg + (wave >> 2) * 36864; w.kg = Kb + (size_t)(16 * w4 + lr) * 64 + 16 * lcn; w.vg = Vt + (size_t)(16 * w4 + lr) * ldv + 16 * lcn; w.wofs = (16 * w4 + lr) * 144 + 32 * lcn; return w; }
__device__ __forceinline__ void stg_ldk(const StgW& w, int kb, u32x4& a, u32x4& b) { const bf16_t* kp = w.kg + (size_t)kb * 64; a = *(const u32x4*)kp; b = *(const u32x4*)(kp + 8); }
__device__ __forceinline__ void stg_ldv(const StgW& w, int kb, u32x4& a, u32x4& b) { const bf16_t* vp = w.vg + kb; a = *(const u32x4*)vp; b = *(const u32x4*)(vp + 8); }
__device__ __forceinline__ void stg_stk(const StgW& w, int buf, u32x4 a, u32x4 b) { LAS unsigned char* d = w.gb + buf * 18432 + w.wofs; *(LAS u32x4*)d = a; *(LAS u32x4*)(d + 16) = b; }
__device__ __forceinline__ void stg_stv(const StgW& w, int buf, u32x4 a, u32x4 b) { LAS unsigned char* d = w.gb + buf * 18432 + 9216 + w.wofs; *(LAS u32x4*)d = a; *(LAS u32x4*)(d + 16) = b; }
__device__ __forceinline__ void stg_rdk(const LAS unsigned char* b, int krow0, int kq, bf16x8 (&kf)[8]) {
#pragma unroll
    for (int j = 0; j < 4; ++j) { const LAS unsigned char* rp = b + (32 * (j >> 1) + 4 * (j & 1) + krow0) * 144 + 16 * kq; kf[2 * j] = *(const LAS bf16x8*)rp; kf[2 * j + 1] = *(const LAS bf16x8*)(rp + 64); }
}
__device__ __forceinline__ void stg_rdv(const LAS unsigned char* b, int lc, int kq, bf16x8 (&vf)[8]) {
#pragma unroll
    for (int dt = 0; dt < 4; ++dt) { const LAS unsigned char* rp = b + 9216 + (16 * dt + lc) * 144 + 16 * kq; vf[2 * dt] = *(const LAS bf16x8*)rp; vf[2 * dt + 1] = *(const LAS bf16x8*)(rp + 64); }
}
__device__ __forceinline__ void window_lds(LAS unsigned char* stg, const bf16_t* Kw, const bf16_t* Vw, int kb0, int n, int wave, int lane, int lc, int kq, int krow0, const WinF& wf,
                                           bf16x8 q0, bf16x8 q1, float& m, float& l, f32x4 (&o)[4]) {
    const int w4 = wave & 3;
    LAS unsigned char* gb = stg + (wave >> 2) * 36864;
    const int lr = lane >> 2, lcn = lane & 3;
    const bf16_t* kg = Kw + (size_t)(16 * w4 + lr) * 64 + 16 * lcn;
    const bf16_t* vg = Vw + (size_t)(16 * w4 + lr) * LDV + 16 * lcn;
    const int wofs = (16 * w4 + lr) * 144 + 32 * lcn;
    u32x4 pk0, pk1, pv0, pv1;
    { const bf16_t* kp = kg + (size_t)kb0 * 64; const bf16_t* vp = vg + kb0;
      pk0 = *(const u32x4*)kp; pk1 = *(const u32x4*)(kp + 8); pv0 = *(const u32x4*)vp; pv1 = *(const u32x4*)(vp + 8); }
    *(LAS u32x4*)(gb + wofs) = pk0; *(LAS u32x4*)(gb + wofs + 16) = pk1; *(LAS u32x4*)(gb + 9216 + wofs) = pv0; *(LAS u32x4*)(gb + 9216 + wofs + 16) = pv1;
    __syncthreads();
#pragma unroll 1
    for (int i = 0; i < n; ++i) {
        const int kbc = kb0 + 64 * i; const bool more = i + 1 < n;
        if (more) { const bf16_t* kp = kg + (size_t)(kbc + 64) * 64; const bf16_t* vp = vg + kbc + 64;
            pk0 = *(const u32x4*)kp; pk1 = *(const u32x4*)(kp + 8); pv0 = *(const u32x4*)vp; pv1 = *(const u32x4*)(vp + 8); }
        const LAS unsigned char* b = gb + (i & 1) * 18432;
        bf16x8 kf[8], vf[8];
#pragma unroll
        for (int j = 0; j < 4; ++j) { const LAS unsigned char* rp = b + (32 * (j >> 1) + 4 * (j & 1) + krow0) * 144 + 16 * kq; kf[2 * j] = *(const LAS bf16x8*)rp; kf[2 * j + 1] = *(const LAS bf16x8*)(rp + 64); }
#pragma unroll
        for (int dt = 0; dt < 4; ++dt) { const LAS unsigned char* rp = b + 9216 + (16 * dt + lc) * 144 + 16 * kq; vf[2 * dt] = *(const LAS bf16x8*)rp; vf[2 * dt + 1] = *(const LAS bf16x8*)(rp + 64); }
        float s[16]; qk64(kf, q0, q1, s); bf16x8 pf0, pf1;
        if (wf.full(kbc)) sm64<true>(s, 0, 0u, m, l, o, pf0, pf1); else sm64<false>(s, wf.d(kbc), WinF::LIM, m, l, o, pf0, pf1);
        pv64(vf, pf0, pf1, o);
        if (more) { LAS unsigned char* nb = gb + ((i + 1) & 1) * 18432;
            *(LAS u32x4*)(nb + wofs) = pk0; *(LAS u32x4*)(nb + wofs + 16) = pk1; *(LAS u32x4*)(nb + 9216 + wofs) = pv0; *(LAS u32x4*)(nb + 9216 + wofs + 16) = pv1; }
        __syncthreads();
    }
}
__device__ __forceinline__ void qk32(const bf16_t* k0p, const bf16_t* k1p, bf16x8 q0, bf16x8 q1, float (&s)[8]) {
    const bf16x8 ka = *(const bf16x8*)k0p, kb = *(const bf16x8*)(k0p + 32), kc = *(const bf16x8*)k1p, kd = *(const bf16x8*)(k1p + 32);
    f32x4 s0 = (f32x4){0.f, 0.f, 0.f, 0.f}, s1 = s0;
    s0 = mfma16(ka, q0, s0); s0 = mfma16(kb, q1, s0); s1 = mfma16(kc, q0, s1); s1 = mfma16(kd, q1, s1);
#pragma unroll
    for (int i = 0; i < 4; ++i) { s[i] = s0[i]; s[4 + i] = s1[i]; }
}
__device__ __forceinline__ bf16x8 sm_step(const float (&s)[8], int d2, float& m, float& l, f32x4 (&o)[4]) {
    float mx = -1e30f;
#pragma unroll
    for (int i = 0; i < 8; i += 2) mx = fmax3(mx, (i < d2) ? s[i] : -1e30f, (i + 1 < d2) ? s[i + 1] : -1e30f);
    mx = fmax2(mx, __shfl_xor(mx, 16)); mx = fmax2(mx, __shfl_xor(mx, 32));
    const float mn = fmax2(m, mx), alpha = ex2(m - mn);
    float pr[8], sum = 0.f;
#pragma unroll
    for (int i = 0; i < 8; ++i) { pr[i] = (i < d2) ? ex2(s[i] - mn) : 0.f; sum += pr[i]; }
    l = l * alpha + sum; m = mn;
#pragma unroll
    for (int dt = 0; dt < 4; ++dt) o[dt] = o[dt] * alpha;
    u32x4 w; w.x = cvtpk(pr[0], pr[1]); w.y = cvtpk(pr[2], pr[3]); w.z = cvtpk(pr[4], pr[5]); w.w = cvtpk(pr[6], pr[7]);
    return __builtin_bit_cast(bf16x8, w);
}
struct DsaL { bf16x8 ka, kb, kc, kd; u32x4 v0, v1, v2, v3; };
__device__ __forceinline__ void dsa_load(const unsigned short* idx, int sb, int krow0, int kq, int lane, const bf16_t* Kb, const bf16_t* Vb, DsaL& L) {
    const int i0 = idx[sb + krow0], i1 = idx[sb + krow0 + 4], vkey = idx[sb + (lane >> 1)];
    const bf16_t* k0p = Kb + (size_t)i0 * 64 + 8 * kq; const bf16_t* k1p = Kb + (size_t)i1 * 64 + 8 * kq;
    L.ka = *(const bf16x8*)k0p; L.kb = *(const bf16x8*)(k0p + 32); L.kc = *(const bf16x8*)k1p; L.kd = *(const bf16x8*)(k1p + 32);
    const bf16_t* vp = Vb + (size_t)vkey * 64 + (lane & 1) * 32;
    L.v0 = *(const u32x4*)vp; L.v1 = *(const u32x4*)(vp + 8); L.v2 = *(const u32x4*)(vp + 16); L.v3 = *(const u32x4*)(vp + 24);
}
__device__ __forceinline__ void dsa_compute(const DsaL& L, bf16x8 q0, bf16x8 q1, int d2, float& m, float& l, f32x4 (&o)[4], LAS unsigned char* vreg, int lane, int lc, int kq) {
    f32x4 s0 = (f32x4){0.f, 0.f, 0.f, 0.f}, s1 = s0;
    s0 = mfma16(L.ka, q0, s0); s0 = mfma16(L.kb, q1, s0); s1 = mfma16(L.kc, q0, s1); s1 = mfma16(L.kd, q1, s1);
    float s[8];
#pragma unroll
    for (int i = 0; i < 4; ++i) { s[i] = s0[i]; s[4 + i] = s1[i]; }
    const bf16x8 pf = sm_step(s, d2, m, l, o);
    LAS u32x4* wdst = (LAS u32x4*)(vreg + (lane >> 1) * 144 + (lane & 1) * 64);
    wdst[0] = L.v0; wdst[1] = L.v1; wdst[2] = L.v2; wdst[3] = L.v3;
    LDS_WAIT();
    const unsigned taddr = (unsigned)(size_t)vreg + (unsigned)((8 * kq + (lc >> 2)) * 144 + 8 * (lc & 3));
    u32x2 t0, t1, t2, t3, t4, t5, t6, t7;
    asm volatile("ds_read_b64_tr_b16 %0, %8\n\tds_read_b64_tr_b16 %1, %8 offset:576\n\tds_read_b64_tr_b16 %2, %8 offset:32\n\tds_read_b64_tr_b16 %3, %8 offset:608\n\t"
                 "ds_read_b64_tr_b16 %4, %8 offset:64\n\tds_read_b64_tr_b16 %5, %8 offset:640\n\tds_read_b64_tr_b16 %6, %8 offset:96\n\tds_read_b64_tr_b16 %7, %8 offset:672\n\ts_waitcnt lgkmcnt(0)"
                 : "=&v"(t0), "=&v"(t1), "=&v"(t2), "=&v"(t3), "=&v"(t4), "=&v"(t5), "=&v"(t6), "=&v"(t7) : "v"(taddr) : "memory");
    o[0] = mfma16(__builtin_bit_cast(bf16x8, (u32x4){t0.x, t0.y, t1.x, t1.y}), pf, o[0]);
    o[1] = mfma16(__builtin_bit_cast(bf16x8, (u32x4){t2.x, t2.y, t3.x, t3.y}), pf, o[1]);
    o[2] = mfma16(__builtin_bit_cast(bf16x8, (u32x4){t4.x, t4.y, t5.x, t5.y}), pf, o[2]);
    o[3] = mfma16(__builtin_bit_cast(bf16x8, (u32x4){t6.x, t6.y, t7.x, t7.y}), pf, o[3]);
}
__device__ __forceinline__ void attn_phase(KP p, LAS unsigned char* lds, int wv) {
    int tid_ = mk_tid(wv); asm volatile("" : "+v"(tid_)); const int tid = tid_, lane = tid & 63; int wave = wv; asm volatile("" : "+s"(wave));
    LAS float* imp = (LAS float*)lds;
    LAS float* obuf = (LAS float*)(lds + 65536);
    LAS int* sel = (LAS int*)(lds + 98304);
    const bf16_t* QA = (const bf16_t*)(p->ws + WS_QA); const bf16_t* QB = (const bf16_t*)(p->ws + WS_QB);
    const bf16_t* KA = (const bf16_t*)(p->ws + WS_KA); const bf16_t* VA = (const bf16_t*)(p->ws + WS_VA);
    const bf16_t* KS = (const bf16_t*)(p->ws + WS_KS); const bf16_t* KW = (const bf16_t*)(p->ws + WS_KW);
    const bf16_t* VST = (const bf16_t*)(p->ws + WS_VST); const bf16_t* VWT = (const bf16_t*)(p->ws + WS_VWT);
    const bf16_t* KC = (const bf16_t*)(p->ws + WS_KC); const bf16_t* VCT = (const bf16_t*)(p->ws + WS_VCT);
    const float* GATES = (const float*)(p->ws + WS_GATES);
    const unsigned short* IDX = (const unsigned short*)(p->ws + WS_IDX); const int* CNT = (const int*)(p->ws + WS_CNT);
    bf16_t* OA = (bf16_t*)(p->ws + WS_OA); bf16_t* OB = (bf16_t*)(p->ws + WS_OB);
    const int G_ = mk_grid(), bid_ = mk_bid();
    const bool aff = (G_ & 1) == 0;
    int* SELG = (int*)(p->ws + WS_SEL);
#pragma unroll 1
    for (int it_ = 0; ; ++it_) {
        int tile;
        if (aff) { const int hw = G_ >> 1, li = bid_ >> 1; if (it_ * hw >= T / 32) break; tile = (bid_ & 1) * (T / 32) + hw * it_ + ((it_ & 1) ? (hw - 1 - li) : li); }
        else { tile = bid_ + G_ * it_; if (tile >= T / 16) break; }
        const int tg0 = tile * 16, b = tg0 >> 13, s0 = tg0 & (S - 1);
        __syncthreads();
        for (int i = tid; i < 8 * 16 * 128; i += 512) imp[i] = 0.f;
        __syncthreads();
        {
            int l2_ = lane; asm volatile("" : "+v"(l2_)); const int lc = l2_ & 15, kq = l2_ >> 4, krow0 = 8 * (lc >> 2) + (lc & 3);
            const int h = wave, g = h >> 2, bg = b * 2 + g;
            const int tq = s0 + lc;
            const bf16_t* qrow = QB + (size_t)(tg0 + lc) * 512 + h * 64 + 8 * kq;
            const bf16x8 q0 = *(const bf16x8*)qrow, q1 = *(const bf16x8*)(qrow + 32);
            const float g0 = GATES[(size_t)(tg0 + lc) * 24 + h * 3 + 0], g2 = GATES[(size_t)(tg0 + lc) * 24 + h * 3 + 2];
            f32x4 oc[4], ow[4];
#pragma unroll
            for (int dt = 0; dt < 4; ++dt) { oc[dt] = (f32x4){0.f, 0.f, 0.f, 0.f}; ow[dt] = oc[dt]; }
            if (s0 + 15 >= 31) {
                const int cmax = (s0 + 15 - 31) >> 4;
                const bf16_t* Kc = KC + (size_t)bg * 512 * 64; const bf16_t* Vc = VCT + (size_t)bg * 64 * 512;
                const int cq = tq >= 31 ? (tq - 31) >> 4 : -1;
                const int nst = cmax / 64 + 1;
                float m = -1e30f, l = 0.f;
                const StgW sw = stg_make(lds + 65536, Kc, Vc, 512, wave, lane);
                {
                    u32x4 pk0, pk1;
                    stg_ldk(sw, 0, pk0, pk1); stg_stk(sw, 0, pk0, pk1);
                    __syncthreads();
#pragma unroll 1
                    for (int st = 0; st < nst; ++st) {
                        const bool more = st + 1 < nst;
                        if (more) stg_ldk(sw, 64 * (st + 1), pk0, pk1);
                        bf16x8 kf[8]; stg_rdk(sw.gb + (st & 1) * 18432, krow0, kq, kf);
                        float s[16]; qk64(kf, q0, q1, s); const int kb = 64 * st; float mx = -1e30f;
                        const int dd = cq - kb - 8 * kq;
#pragma unroll
                        for (int i = 0; i < 16; i += 2) mx = fmax3(mx, VAL64(dd, 0x80000000u, i) ? s[i] : -1e30f, VAL64(dd, 0x80000000u, i + 1) ? s[i + 1] : -1e30f);
                        mx = fmax2(mx, __shfl_xor(mx, 16)); mx = fmax2(mx, __shfl_xor(mx, 32));
                        const float mn = fmax2(m, mx); float sum = 0.f;
#pragma unroll
                        for (int i = 0; i < 16; ++i) sum += VAL64(dd, 0x80000000u, i) ? ex2(s[i] - mn) : 0.f;
                        l = l * ex2(m - mn) + sum; m = mn;
                        if (more) stg_stk(sw, (st + 1) & 1, pk0, pk1);
                        __syncthreads();
                    }
                }
                l += __shfl_xor(l, 16); l += __shfl_xor(l, 32);
                const float inv = l > 0.f ? 1.f / l : 0.f;
                float carry = 0.f;
                u32x4 pk0, pk1, pv0, pv1;
                stg_ldk(sw, 0, pk0, pk1); stg_ldv(sw, 0, pv0, pv1); stg_stk(sw, 0, pk0, pk1); stg_stv(sw, 0, pv0, pv1);
                __syncthreads();
#pragma unroll 1
                for (int st = 0; st < nst; ++st) {
                    const int kb = 64 * st; bf16x8 kA[8], vA[8]; float s[16], pr[16];
                    const bool more = st + 1 < nst;
                    if (more) { stg_ldk(sw, kb + 64, pk0, pk1); stg_ldv(sw, kb + 64, pv0, pv1); }
                    stg_rdk(sw.gb + (st & 1) * 18432, krow0, kq, kA); stg_rdv(sw.gb + (st & 1) * 18432, lc, kq, vA);
                    qk64(kA, q0, q1, s);
#pragma unroll
                    for (int i = 0; i < 16; ++i) pr[i] = VAL64(cq - kb - 8 * kq, 0x80000000u, i) ? ex2(s[i] - m) * inv : 0.f;
                    u32x4 w0, w1;
                    w0.x = cvtpk(pr[0], pr[1]); w0.y = cvtpk(pr[2], pr[3]); w0.z = cvtpk(pr[4], pr[5]); w0.w = cvtpk(pr[6], pr[7]);
                    w1.x = cvtpk(pr[8], pr[9]); w1.y = cvtpk(pr[10], pr[11]); w1.z = cvtpk(pr[12], pr[13]); w1.w = cvtpk(pr[14], pr[15]);
                    pv64(vA, __builtin_bit_cast(bf16x8, w0), __builtin_bit_cast(bf16x8, w1), oc);
#pragma unroll
                    for (int gr = 0; gr < 2; ++gr) {
                        const float p7 = pr[8 * gr + 7];
                        const float up = __shfl_up(p7, 16);
                        const float wrap = __shfl_down(p7, 48);
                        const float prev = kq == 0 ? carry : up;
                        carry = wrap;
                        const float e0 = (pr[8 * gr + 0] + pr[8 * gr + 1]) + (pr[8 * gr + 2] + pr[8 * gr + 3]) + prev;
                        const float e1 = (pr[8 * gr + 4] + pr[8 * gr + 5]) + (pr[8 * gr + 6] + pr[8 * gr + 7]) + pr[8 * gr + 3];
                        const int n0 = (kb + 32 * gr) / 4 + 2 * kq;
                        imp[(h * 16 + lc) * 128 + n0] = e0; imp[(h * 16 + lc) * 128 + n0 + 1] = e1;
                    }
                    if (more) { stg_stk(sw, (st + 1) & 1, pk0, pk1); stg_stv(sw, (st + 1) & 1, pv0, pv1); }
                    __syncthreads();
                }
            }
            {
                const bf16_t* Kw = KW + (size_t)bg * S * 64; const bf16_t* Vw = VWT + (size_t)bg * 64 * LDV;
                float m = -1e30f, l = 0.f;
                const int kb0 = s0 >= 512 ? s0 - 512 : 0;
                const WinF wf{kb0, tq, kq, s0};
                window_lds(lds + 65536, Kw, Vw, kb0, (s0 + 16 - kb0 + 63) >> 6, wave, lane, lc, kq, krow0, wf, q0, q1, m, l, ow);
                l += __shfl_xor(l, 16); l += __shfl_xor(l, 32);
                const float inv = l > 0.f ? g2 / l : 0.f;
#pragma unroll
                for (int dt = 0; dt < 4; ++dt) { const f32x4 o = oc[dt] * g0 + ow[dt] * inv; *(LAS f32x4*)(obuf + lc * 512 + h * 64 + 16 * dt + 4 * kq) = o; }
            }
        }
        __syncthreads();
#pragma unroll 1
        for (int rr = 0; rr < 4; ++rr) {
            const int row = wave * 4 + rr, q = row >> 1, g = row & 1, tq = s0 + q, cur = tq >> 6;
            LAS unsigned long long* kbuf = (LAS unsigned long long*)(lds + 100352 + wave * 1024);
            unsigned long long key[2];
#pragma unroll
            for (int hf = 0; hf < 2; ++hf) { const int n = lane + 64 * hf;
                float v = ((imp[((4 * g + 0) * 16 + q) * 128 + n] + imp[((4 * g + 1) * 16 + q) * 128 + n]) + imp[((4 * g + 2) * 16 + q) * 128 + n]) + imp[((4 * g + 3) * 16 + q) * 128 + n];
                if (n == 0 || n == cur) v = 1e4f; else if (64 * n > tq) v = -1.f;
                unsigned u = __builtin_bit_cast(unsigned, v); u = (u & 0x80000000u) ? ~u : (u | 0x80000000u);
                key[hf] = ((unsigned long long)u << 32) | (unsigned)(127 - n); }
            LDS_WAIT();
            kbuf[lane] = key[0]; kbuf[lane + 64] = key[1];
            LDS_WAIT();
            int r0 = 0, r1 = 0;
#pragma unroll 16
            for (int mI = 0; mI < 128; ++mI) { const unsigned long long k = kbuf[mI]; r0 += k > key[0] ? 1 : 0; r1 += k > key[1] ? 1 : 0; }
            if (r0 < 16) { sel[row * 16 + r0] = lane; SELG[((size_t)tile * 32 + row) * 16 + r0] = lane; }
            if (r1 < 16) { sel[row * 16 + r1] = lane + 64; SELG[((size_t)tile * 32 + row) * 16 + r1] = lane + 64; }
        }
        __syncthreads();
        {
            int l2_ = lane; asm volatile("" : "+v"(l2_)); const int lc = l2_ & 15, kq = l2_ >> 4, krow0 = 8 * (lc >> 2) + (lc & 3);
            const size_t tgA = (size_t)tg0 + wave * 2, tgB = tgA + 1;
            const bf16_t* qrA = QA + tgA * 512 + (lc & 7) * 64 + 8 * kq; const bf16_t* qrB = qrA + 512;
            const bf16x8 qA0 = *(const bf16x8*)qrA, qA1 = *(const bf16x8*)(qrA + 32), qB0 = *(const bf16x8*)qrB, qB1 = *(const bf16x8*)(qrB + 32);
            const int cntA = CNT[tgA], cntB = CNT[tgB], cmaxq = cntA > cntB ? cntA : cntB;
            const unsigned short* idxA = IDX + tgA * 256; const unsigned short* idxB = IDX + tgB * 256;
            const bf16_t* Kb = KA + (size_t)b * S * 64; const bf16_t* Vb = VA + (size_t)b * S * 64;
            LAS unsigned char* vregA = lds + 108544 + wave * 4608; LAS unsigned char* vregB = lds + wave * 4608;
            f32x4 oA[4], oB[4];
#pragma unroll
            for (int dt = 0; dt < 4; ++dt) { oA[dt] = (f32x4){0.f, 0.f, 0.f, 0.f}; oB[dt] = oA[dt]; }
            float mA = -1e30f, lA = 0.f, mB = -1e30f, lB = 0.f;
#pragma unroll 1
            for (int sb = 0; sb < 256; sb += 32) {
                if (sb >= cmaxq) break;
                DsaL LA, LB;
                dsa_load(idxA, sb, krow0, kq, lane, Kb, Vb, LA); dsa_load(idxB, sb, krow0, kq, lane, Kb, Vb, LB);
                __builtin_amdgcn_sched_barrier(0);
                dsa_compute(LA, qA0, qA1, cntA - sb - 8 * kq, mA, lA, oA, vregA, lane, lc, kq);
                dsa_compute(LB, qB0, qB1, cntB - sb - 8 * kq, mB, lB, oB, vregB, lane, lc, kq);
            }
            lA += __shfl_xor(lA, 16); lA += __shfl_xor(lA, 32); lB += __shfl_xor(lB, 16); lB += __shfl_xor(lB, 32);
            const float invA = lA > 0.f ? 1.f / lA : 0.f, invB = lB > 0.f ? 1.f / lB : 0.f;
            if (lc < 8) {
#pragma unroll
                for (int dt = 0; dt < 4; ++dt) { const f32x4 va = oA[dt] * invA, vb = oB[dt] * invB; u32x2 wa, wb; wa.x = pk2(va[0], va[1]); wa.y = pk2(va[2], va[3]); wb.x = pk2(vb[0], vb[1]); wb.y = pk2(vb[2], vb[3]);
                    *(u32x2*)(OA + tgA * 1024 + lc * 64 + 16 * dt + 4 * kq) = wa; *(u32x2*)(OA + tgB * 1024 + lc * 64 + 16 * dt + 4 * kq) = wb; }
            }
        }
        __syncthreads();
#pragma unroll
        for (int i = 0; i < 2; ++i) { const int e = (i * 512 + tid) * 8;
            const f32x4 a = *(const LAS f32x4*)(obuf + e), c = *(const LAS f32x4*)(obuf + e + 4);
            u32x4 w; w.x = pk2(a[0], a[1]); w.y = pk2(a[2], a[3]); w.z = pk2(c[0], c[1]); w.w = pk2(c[2], c[3]);
            *(u32x4*)(OA + (size_t)(tg0 + (e >> 9)) * 1024 + 512 + (e & 511)) = w; }
    }
}

struct SetSt { bf16x8 q0, q1; float m, l; f32x4 o[4]; unsigned long long mlo, mhi; int tq, tqmin; };
__device__ __forceinline__ void set_step(SetSt& st, const bf16x8 (&KC)[8], const bf16x8 (&vA)[8], int kbc, int kq) {
    const int n = kbc >> 6; const unsigned long long mw = n < 64 ? st.mlo : st.mhi; const bool mem = (mw >> (n & 63)) & 1ull;
    const unsigned long long bm = __ballot(mem);
    if (bm != 0ull) {
        float s[16]; qk64(KC, st.q0, st.q1, s); bf16x8 pf0, pf1;
        if (bm == ~0ull && kbc + 63 <= st.tqmin) sm64<true>(s, 0, 0u, st.m, st.l, st.o, pf0, pf1);
        else sm64<false>(s, mem ? st.tq - kbc - 8 * kq : -1, 0x80000000u, st.m, st.l, st.o, pf0, pf1);
        pv64(vA, pf0, pf1, st.o);
    }
}
__device__ __forceinline__ void attn_sel_phase_walk(KP p, LAS unsigned char* lds, int wv, const bool dummy, const bool nowrite = false) {
    int tid_ = mk_tid(wv); asm volatile("" : "+v"(tid_)); const int lane = tid_ & 63; int wave = wv; asm volatile("" : "+s"(wave));
    const bf16_t* QB = (const bf16_t*)(p->ws + WS_QB); const bf16_t* KS = (const bf16_t*)(p->ws + WS_KS); const bf16_t* VST = (const bf16_t*)(p->ws + WS_VST);
    const float* GATES = (const float*)(p->ws + WS_GATES); const int* SELG = (const int*)(p->ws + WS_SEL); bf16_t* OB = (bf16_t*)(p->ws + WS_OA);
    LAS int* list = (LAS int*)(lds + wave * 512);
    const int G_ = mk_grid(), bid_ = mk_bid();
    const bool aff2 = (G_ & 3) == 0 && ((T / 32) % (G_ >> 2)) == 0 && (((T / 32) / (G_ >> 2)) & 3) == 0;
    const int npass = aff2 ? ((T / 32) / (G_ >> 2)) / 4 : (T / 32 + G_ - 1) / G_;
#pragma unroll 1
    for (int ps = 0; ps < npass; ++ps) {
        int l2_ = lane; asm volatile("" : "+v"(l2_)); const int lc = l2_ & 15, kq = l2_ >> 4, krow0 = 8 * (lc >> 2) + (lc & 3);
        int tile, g, half;
        if (aff2) { const int nb = G_ >> 2, jb = bid_ >> 2, k = 4 * ps + (wave >> 1);
            tile = (bid_ & 1) * (T / 32) + nb * k + ((k & 1) ? (nb - 1 - jb) : jb); g = (bid_ >> 1) & 1; half = wave & 1; }
        else { const int tp = ps * G_ + ((ps & 1) ? (G_ - 1 - bid_) : bid_); if (tp >= T / 32) continue;
            tile = 2 * tp + (wave >> 2); g = (wave >> 1) & 1; half = wave & 1; }
        const int tg0 = tile * 16, b = tg0 >> 13, s0 = tg0 & (S - 1), bg = b * 2 + g, hh = 4 * g + (lc & 3);
        SetSt st[2];
#pragma unroll
        for (int si = 0; si < 2; ++si) {
            const int q = 8 * half + 4 * si + (lc >> 2), row = q * 2 + g;
            unsigned mk0 = 0u, mk1 = 0u, mk2 = 0u, mk3 = 0u;
            const int* sp = SELG + ((size_t)tile * 32 + row) * 16;
#pragma unroll
            for (int c4 = 0; c4 < 4; ++c4) { const u32x4 v = *(const u32x4*)(sp + 4 * c4); const unsigned va[4] = {v.x, v.y, v.z, v.w};
#pragma unroll
                for (int j = 0; j < 4; ++j) { const unsigned n = dummy ? 0u : va[j], bit = 1u << (n & 31u), w = n >> 5;
                    mk0 |= w == 0u ? bit : 0u; mk1 |= w == 1u ? bit : 0u; mk2 |= w == 2u ? bit : 0u; mk3 |= w == 3u ? bit : 0u; } }
            st[si].mlo = (unsigned long long)mk0 | ((unsigned long long)mk1 << 32); st[si].mhi = (unsigned long long)mk2 | ((unsigned long long)mk3 << 32);
            st[si].tq = s0 + q; st[si].tqmin = s0 + 8 * half + 4 * si;
            const bf16_t* qrow = QB + (size_t)(tg0 + q) * 512 + hh * 64 + 8 * kq;
            st[si].q0 = *(const bf16x8*)qrow; st[si].q1 = *(const bf16x8*)(qrow + 32);
            st[si].m = -1e30f; st[si].l = 0.f;
#pragma unroll
            for (int dt = 0; dt < 4; ++dt) st[si].o[dt] = (f32x4){0.f, 0.f, 0.f, 0.f};
        }
        unsigned long long Ulo = 0ull, Uhi = 0ull;
#pragma unroll
        for (int si = 0; si < 2; ++si)
#pragma unroll
            for (int j = 0; j < 4; ++j) {
                Ulo |= (unsigned long long)(unsigned)__builtin_amdgcn_readlane((int)(unsigned)st[si].mlo, 4 * j) | ((unsigned long long)(unsigned)__builtin_amdgcn_readlane((int)(unsigned)(st[si].mlo >> 32), 4 * j) << 32);
                Uhi |= (unsigned long long)(unsigned)__builtin_amdgcn_readlane((int)(unsigned)st[si].mhi, 4 * j) | ((unsigned long long)(unsigned)__builtin_amdgcn_readlane((int)(unsigned)(st[si].mhi >> 32), 4 * j) << 32);
            }
        LDS_WAIT();
        const unsigned long long ltm = (1ull << lane) - 1ull;
        const int c0 = __popcll(Ulo), cntu = c0 + __popcll(Uhi);
        if ((Ulo >> lane) & 1ull) list[__popcll(Ulo & ltm)] = lane;
        if ((Uhi >> lane) & 1ull) list[c0 + __popcll(Uhi & ltm)] = 64 + lane;
        LDS_WAIT();
        const int listv = list[lane], listv2 = list[64 + lane];
        LDS_WAIT();
        const bf16_t* Ks = KS + (size_t)bg * S * 64; const bf16_t* Vs = VST + (size_t)bg * 64 * LDV;
        {
            bf16x8 kA[8], kB[8], vA[8];
#define LISTKB(i) (64 * ((i) < 64 ? __builtin_amdgcn_readlane(listv, (i)) : __builtin_amdgcn_readlane(listv2, (i) - 64)))
            int kbc = LISTKB(0);
            load_k64(Ks, kbc, krow0, kq, kA);
#define SEL_STEP(KC, KN, idx) { \
            int kbn = kbc; const bool more = (idx) + 1 < cntu; \
            load_v64(Vs, LDV, kbc, lc, kq, vA); \
            if (more) { kbn = LISTKB((idx) + 1); load_k64(Ks, kbn, krow0, kq, KN); } \
            __builtin_amdgcn_sched_barrier(0); \
            set_step(st[0], KC, vA, kbc, kq); set_step(st[1], KC, vA, kbc, kq); \
            kbc = kbn; __builtin_amdgcn_sched_barrier(0); }
#pragma unroll 1
            for (int i = 0; i < cntu; i += 2) {
                SEL_STEP(kA, kB, i)
                if (i + 1 < cntu) SEL_STEP(kB, kA, i + 1)
            }
#undef SEL_STEP
#undef LISTKB
        }
#pragma unroll
        for (int si = 0; si < 2; ++si) {
            const int q = 8 * half + 4 * si + (lc >> 2);
            float l = st[si].l; l += __shfl_xor(l, 16); l += __shfl_xor(l, 32);
            const float g1 = GATES[(size_t)(tg0 + q) * 24 + hh * 3 + 1];
            const float inv = l > 0.f ? g1 / l : 0.f;
            if ((!dummy && !nowrite) || l == -1.f) {
#pragma unroll
                for (int dt = 0; dt < 4; ++dt) { bf16_t* dst = OB + (size_t)(tg0 + q) * 1024 + 512 + hh * 64 + 16 * dt + 4 * kq; const u32x2 ow = *(const u32x2*)dst;
                    const f32x4 v = st[si].o[dt] * inv; u32x2 w; w.x = pk2(bflo(ow.x) + v[0], bfhi(ow.x) + v[1]); w.y = pk2(bflo(ow.y) + v[2], bfhi(ow.y) + v[3]); *(u32x2*)dst = w; }
            }
        }
    }
}

__device__ __forceinline__ void attn_sel_phase(KP p, LAS unsigned char* lds, int wv, const bool dummy, const bool nowrite = false) {
    const int G_ = mk_grid(), bid_ = mk_bid();
    const bool aff2 = (G_ & 3) == 0 && ((T / 32) % (G_ >> 2)) == 0 && (((T / 32) / (G_ >> 2)) & 3) == 0;
    if (!aff2 || dummy) { attn_sel_phase_walk(p, lds, wv, dummy, nowrite); return; }
    int tid_ = mk_tid(wv); asm volatile("" : "+v"(tid_)); const int lane = tid_ & 63; int wave = wv; asm volatile("" : "+s"(wave));
    const bf16_t* QB = (const bf16_t*)(p->ws + WS_QB); const bf16_t* KS = (const bf16_t*)(p->ws + WS_KS); const bf16_t* VST = (const bf16_t*)(p->ws + WS_VST);
    const float* GATES = (const float*)(p->ws + WS_GATES); const int* SELG = (const int*)(p->ws + WS_SEL); bf16_t* OB = (bf16_t*)(p->ws + WS_OA);
    const int nb = G_ >> 2, jb = bid_ >> 2, b = bid_ & 1, g = (bid_ >> 1) & 1, bg = b * 2 + g;
    const int npass = ((T / 32) / nb) / 4;
    const bf16_t* Ks = KS + (size_t)bg * S * 64; const bf16_t* Vs = VST + (size_t)bg * 64 * LDV;
    const int srow = 8 * wave + (lane >> 3), sch = lane & 7;
    const bf16_t* kgp = Ks + (size_t)srow * 64 + 8 * sch;
    const bf16_t* vgp = Vs + (size_t)srow * LDV + 8 * sch;
    const int wofs = srow * 144 + 16 * sch;
#pragma unroll 1
    for (int ps = 0; ps < npass; ++ps) {
        int l2_ = lane; asm volatile("" : "+v"(l2_)); const int lc = l2_ & 15, kq = l2_ >> 4, krow0 = 8 * (lc >> 2) + (lc & 3);
        const int k = 4 * ps + (wave >> 1), half = wave & 1;
        const int tile = b * (T / 32) + nb * k + ((k & 1) ? (nb - 1 - jb) : jb);
        const int tg0 = tile * 16, s0 = tg0 & (S - 1), hh = 4 * g + (lc & 3);
        const int k3 = 4 * ps + 3, s0max = 16 * (nb * k3 + ((k3 & 1) ? (nb - 1 - jb) : jb));
        const int nsteps = ((s0max + 15) >> 6) + 1;
        SetSt st[2];
#pragma unroll
        for (int si = 0; si < 2; ++si) {
            const int q = 8 * half + 4 * si + (lc >> 2), row = q * 2 + g;
            unsigned mk0 = 0u, mk1 = 0u, mk2 = 0u, mk3 = 0u;
            const int* sp = SELG + ((size_t)tile * 32 + row) * 16;
#pragma unroll
            for (int c4 = 0; c4 < 4; ++c4) { const u32x4 v = *(const u32x4*)(sp + 4 * c4); const unsigned va[4] = {v.x, v.y, v.z, v.w};
#pragma unroll
                for (int j = 0; j < 4; ++j) { const unsigned n = va[j], bit = 1u << (n & 31u), w = n >> 5;
                    mk0 |= w == 0u ? bit : 0u; mk1 |= w == 1u ? bit : 0u; mk2 |= w == 2u ? bit : 0u; mk3 |= w == 3u ? bit : 0u; } }
            st[si].mlo = (unsigned long long)mk0 | ((unsigned long long)mk1 << 32); st[si].mhi = (unsigned long long)mk2 | ((unsigned long long)mk3 << 32);
            st[si].tq = s0 + q; st[si].tqmin = s0 + 8 * half + 4 * si;
            const bf16_t* qrow = QB + (size_t)(tg0 + q) * 512 + hh * 64 + 8 * kq;
            st[si].q0 = *(const bf16x8*)qrow; st[si].q1 = *(const bf16x8*)(qrow + 32);
            st[si].m = -1e30f; st[si].l = 0.f;
#pragma unroll
            for (int dt = 0; dt < 4; ++dt) st[si].o[dt] = (f32x4){0.f, 0.f, 0.f, 0.f};
        }
        unsigned long long Ulo = 0ull, Uhi = 0ull;
#pragma unroll
        for (int si = 0; si < 2; ++si)
#pragma unroll
            for (int j = 0; j < 4; ++j) {
                Ulo |= (unsigned long long)(unsigned)__builtin_amdgcn_readlane((int)(unsigned)st[si].mlo, 4 * j) | ((unsigned long long)(unsigned)__builtin_amdgcn_readlane((int)(unsigned)(st[si].mlo >> 32), 4 * j) << 32);
                Uhi |= (unsigned long long)(unsigned)__builtin_amdgcn_readlane((int)(unsigned)st[si].mhi, 4 * j) | ((unsigned long long)(unsigned)__builtin_amdgcn_readlane((int)(unsigned)(st[si].mhi >> 32), 4 * j) << 32);
            }
        u32x4 pk, pv;
        __syncthreads();
        pk = *(const u32x4*)kgp; pv = *(const u32x4*)vgp;
        *(LAS u32x4*)(lds + wofs) = pk; *(LAS u32x4*)(lds + 9216 + wofs) = pv;
        __syncthreads();
#pragma unroll 1
        for (int n = 0; n < nsteps; ++n) {
            const int kbc = 64 * n; const bool more = n + 1 < nsteps;
            if (more) { pk = *(const u32x4*)(kgp + (size_t)(kbc + 64) * 64); pv = *(const u32x4*)(vgp + kbc + 64); }
            const bool mine = ((n < 64 ? Ulo : Uhi) >> (n & 63)) & 1ull;
            if (mine) {
                const LAS unsigned char* bb = lds + (n & 1) * 18432;
                bf16x8 kf[8], vf[8]; stg_rdk(bb, krow0, kq, kf); stg_rdv(bb, lc, kq, vf);
                set_step(st[0], kf, vf, kbc, kq); set_step(st[1], kf, vf, kbc, kq);
            }
            if (more) { LAS unsigned char* nbuf = lds + ((n + 1) & 1) * 18432; *(LAS u32x4*)(nbuf + wofs) = pk; *(LAS u32x4*)(nbuf + 9216 + wofs) = pv; }
            __syncthreads();
        }
#pragma unroll
        for (int si = 0; si < 2; ++si) {
            const int q = 8 * half + 4 * si + (lc >> 2);
            float l = st[si].l; l += __shfl_xor(l, 16); l += __shfl_xor(l, 32);
            const float g1 = GATES[(size_t)(tg0 + q) * 24 + hh * 3 + 1];
            const float inv = l > 0.f ? g1 / l : 0.f;
            if (!nowrite || l == -1.f) {
#pragma unroll
                for (int dt = 0; dt < 4; ++dt) { bf16_t* dst = OB + (size_t)(tg0 + q) * 1024 + 512 + hh * 64 + 16 * dt + 4 * kq; const u32x2 ow = *(const u32x2*)dst;
                    const f32x4 v = st[si].o[dt] * inv; u32x2 w; w.x = pk2(bflo(ow.x) + v[0], bfhi(ow.x) + v[1]); w.y = pk2(bflo(ow.y) + v[2], bfhi(ow.y) + v[3]); *(u32x2*)dst = w; }
            }
        }
    }
}

#define XB_TMO      128
#define XB_XCNT(j)  (256  + 64 * (j))
#define XB_XSUB(j)  (1280 + 64 * (j))
#define XB_XGEN(j)  (2304 + 64 * (j))
#define XB_TOP      3328
#define XB_TOPGEN   3392
#define XCD_BAR_WORDS 3456
#define XB_SPIN_CAP (1u << 18)

__device__ __forceinline__ unsigned xb_ld(unsigned* p)              { return __hip_atomic_load(p, __ATOMIC_RELAXED, __HIP_MEMORY_SCOPE_AGENT); }
__device__ __forceinline__ unsigned xb_add(unsigned* p, unsigned v) { return __hip_atomic_fetch_add(p, v, __ATOMIC_RELAXED, __HIP_MEMORY_SCOPE_AGENT); }
__device__ __forceinline__ unsigned xb_xcc_id() { return (unsigned)__builtin_amdgcn_s_getreg((3 << 11) | 20) & 0xFu; }
#define XB_SPIN(cond, bar) do { unsigned _sp = 0; while (cond) { __builtin_amdgcn_s_sleep(1); \
    if ((++_sp & 255u) == 0u) { if (xb_ld(&(bar)[XB_TMO])) break; if (_sp > XB_SPIN_CAP) { atomicAdd(&(bar)[XB_TMO], 1u); break; } } } } while (0)

struct XcdBarrier {
    unsigned* bar; unsigned x;
    volatile LAS unsigned* st;
};

__device__ __forceinline__ XcdBarrier xcd_barrier_post(unsigned* bar, volatile LAS unsigned* st, int tid) {
    XcdBarrier b; b.bar = bar; b.x = xb_xcc_id(); b.st = st;
    if (tid == 0) (void)xb_add(&bar[XB_XCNT(b.x)], 1u);
    return b;
}
__device__ __forceinline__ void xcd_barrier_complete(unsigned* bar, unsigned x, unsigned& nloc, unsigned& nx) {
    const unsigned G = gridDim.x * gridDim.y * gridDim.z;
    unsigned sum, cnt, mine, sp = 0u;
    for (;;) {
        sum = 0u; cnt = 0u; mine = 0u;
#pragma unroll
        for (unsigned j = 0; j < 16; ++j) { const unsigned c = xb_ld(&bar[XB_XCNT(j)]); sum += c; cnt += (c > 0u) ? 1u : 0u; mine = (j == x) ? c : mine; }
        if (sum == G) break;
        __builtin_amdgcn_s_sleep(1);
        if ((++sp & 255u) == 0u) { if (xb_ld(&bar[XB_TMO])) break; if (sp > XB_SPIN_CAP) { atomicAdd(&bar[XB_TMO], 1u); break; } }
    }
    nloc = mine > 0u ? mine : 1u; nx = cnt > 0u ? cnt : 1u;
}

__device__ __forceinline__ void xcd_barrier(const XcdBarrier& b, int tid) {
    asm volatile("s_waitcnt vmcnt(0)" ::: "memory");
    __syncthreads();
    if (tid == 0) {
        unsigned* bar = b.bar;
        __builtin_amdgcn_s_waitcnt(0);
        unsigned nloc = b.st[0], nx = b.st[1];
        if (nloc == 0u) { xcd_barrier_complete(bar, b.x, nloc, nx); b.st[0] = nloc; b.st[1] = nx; }
        const unsigned old = xb_add(&bar[XB_XSUB(b.x)], 1u);
        const unsigned gen = old / nloc;
        if (old + 1u == (gen + 1u) * nloc) {
            __builtin_amdgcn_fence(__ATOMIC_RELEASE, "agent");
            asm volatile("s_waitcnt vmcnt(0)" ::: "memory");
            const unsigned og = xb_add(&bar[XB_TOP], 1u);
            const unsigned tg = og / nx;
            if (og + 1u == (tg + 1u) * nx) xb_add(&bar[XB_TOPGEN], 1u);
            else XB_SPIN(xb_ld(&bar[XB_TOPGEN]) == tg, bar);
            __builtin_amdgcn_fence(__ATOMIC_ACQUIRE, "agent");
            xb_add(&bar[XB_XGEN(b.x)], 1u);
            asm volatile("s_waitcnt vmcnt(0)" ::: "memory");
        } else {
            XB_SPIN(xb_ld(&bar[XB_XGEN(b.x)]) == gen, bar);
            __builtin_amdgcn_fence(__ATOMIC_ACQUIRE, "agent");
            asm volatile("s_waitcnt vmcnt(0)" ::: "memory");
        }
    }
    __syncthreads();
}

__global__ void __launch_bounds__(512, 2) mk_fwd(P pv) {
    extern __shared__ __attribute__((aligned(16))) unsigned char lds_raw[];
    LAS unsigned char* lds = (LAS unsigned char*)lds_raw;
    cg::grid_group grid = cg::this_grid();
    const int wv = __builtin_amdgcn_readfirstlane((int)(threadIdx.x >> 6));
    if (threadIdx.x < 2) ((LAS unsigned*)(lds + LDS_BARST))[threadIdx.x] = 0u;
    __syncthreads();
    (void)xcd_barrier_post((unsigned*)(pv.ws + WS_BAR), (volatile LAS unsigned*)(lds + LDS_BARST), (int)threadIdx.x);
#define GRID_BAR() do { KP pb_ = (KP)__builtin_amdgcn_kernarg_segment_ptr(); asm volatile("" : "+s"(pb_)); XcdBarrier xb_; xb_.bar = (unsigned*)(pb_->ws + WS_BAR); xb_.x = xb_xcc_id(); xb_.st = (volatile LAS unsigned*)(lds + LDS_BARST); xcd_barrier(xb_, mk_tid(wv)); } while (0)
    for (int ph = pv.ph_lo; ph < pv.ph_hi; ++ph) {
        if (ph > pv.ph_lo) { if (ph == 1) grid.sync(); else GRID_BAR(); }
        KP p = (KP)__builtin_amdgcn_kernarg_segment_ptr();
        asm volatile("" : "+s"(p));
        unsigned char* ws = p->ws;
        float* X = (float*)(ws + WS_X); float* SS = (float*)(ws + WS_SSP);
        bf16_t* XG = (bf16_t*)(ws + WS_XG); bf16_t* XGB = (bf16_t*)(ws + WS_XGB);
        bf16_t* Z = (bf16_t*)(ws + WS_Z); bf16_t* U = (bf16_t*)(ws + WS_U); bf16_t* PP = (bf16_t*)(ws + WS_PP); bf16_t* MERGED = (bf16_t*)(ws + WS_MERGED);
        const float* BIAS = (const float*)(ws + WS_BIAS);
#if defined(PROBE_SYNC)
        if (ph == 1) { for (int i_ = 0; i_ < 50; ++i_) GRID_BAR(); }
#endif
        if (ph == 0) { prologue_phase(p, lds, wv);
#if defined(PROBE_PRO2)
            prologue_phase(p, lds, wv);
#endif
            continue; }
        if (ph == NPH - 1) {
            const float* ssf = SS + (size_t)16 * T * 16; const float* gf = p->in[25];
            for (int o = mk_bid() * 512 + mk_tid(wv); o < T * D / 4; o += mk_grid() * 512) {
                const int r = o >> 8, c = (o & 255) * 4; const float rs = row_rs(ssf, r);
                const f32x4 v = *(const f32x4*)(X + (size_t)o * 4), g = *(const f32x4*)(gf + c);
                *(f32x4*)(p->out + (size_t)o * 4) = v * rs * g;
            }
            continue;
        }
        const int L = (ph - 1) / 12, j = (ph - 1) % 12;
        const bf16_t* WB = (const bf16_t*)(ws + ((L & 1) ? WS_WB1 : WS_WB0));
        switch (j) {
        case 0: {
            EpiSwiglu E{U, SS + (size_t)(4 * L + 0) * T * 16};
            run_gemm(lds, L == 0 ? XG : XGB, D, WB + WO_13A, T, 2 * FF, D, 0, E, wv);
#if defined(PROBE_GEMM2)
            run_gemm(lds, L == 0 ? XG : XGB, D, WB + WO_13A, T, 2 * FF, D, 0, E, wv);
#endif
        } break;
        case 1: {
            EpiResid<0> E{L == 0 ? p->in[0] : X, X, XG, p->in[6] + L * D, SS + (size_t)(4 * L + 1) * T * 16, 0.5f, nullptr, nullptr};
            run_gemm(lds, U, FF, WB + WO_2A, T, D, FF, 0, E, wv);
        } break;
        case 2: {
            EpiRow<0> E{Z, NZ, SS + (size_t)(4 * L + 1) * T * 16, nullptr, nullptr, 0};
            run_gemm(lds, XG, D, WB + WO_IN, T, NZ, D, 0, E, wv);
#if defined(PROBE_G_IN)
            run_gemm(lds, XG, D, WB + WO_IN, T, NZ, D, 0, E, wv);
#endif
        } break;
        case 3: post_phase(p, lds, wv);
#if defined(PROBE_MISC2)
            post_phase(p, lds, wv);
#endif
            break;
        case 4: {
            EpiRow<1> Ek{(bf16_t*)(ws + WS_HIDK), 256, nullptr, BIAS, nullptr, 0};
            run_gemm(lds, (const bf16_t*)(ws + WS_KCMP), 1024, WB + WO_CK, 2048, 256, 2048, 0, Ek, wv);
            EpiRow<1> Ev{(bf16_t*)(ws + WS_HIDV), 256, nullptr, BIAS + 256, nullptr, 0};
            run_gemm(lds, (const bf16_t*)(ws + WS_VCMP), 1024, WB + WO_CV, 2048, 256, 2048, 8, Ev, wv);
            indexer_phase(p, lds, L, wv, 0);
#if defined(PROBE_IDX2)
            indexer_phase(p, lds, L, wv, 32);
#endif
#if defined(PROBE_IDXSCORE)
            indexer_phase(p, lds, L, wv, 32, true);
#endif
        } break;
        case 5: {
            cmp2_phase(p, L, wv);
            if (L + 1 < DEPTH) convert_layer(p, L + 1, (bf16_t*)(ws + (((L + 1) & 1) ? WS_WB1 : WS_WB0)), lds, wv);
#if defined(PROBE_MISC2)
            cmp2_phase(p, L, wv);
            if (L + 1 < DEPTH) convert_layer(p, L + 1, (bf16_t*)(ws + (((L + 1) & 1) ? WS_WB1 : WS_WB0)), lds, wv);
#endif
        } break;
        case 6: attn_phase(p, lds, wv);
#if defined(PROBE_ATTNA2)
            attn_phase(p, lds, wv);
#endif
            GRID_BAR();
            attn_sel_phase(p, lds, wv, false);
#if defined(PROBE_SELDUMMY)
            attn_sel_phase(p, lds, wv, true);
#endif
#if defined(PROBE_SEL2)
            attn_sel_phase(p, lds, wv, false, true);
#endif
            break;
        case 7: {
            EpiMerge E{MERGED, Z};
            run_gemm(lds, (const bf16_t*)(ws + WS_OA), 1024, WB + WO_PA, T, 2048, 1024, 0, E, wv);
        } break;
        case 8: {
            EpiResid<0> E{X, X, XG, p->in[18] + L * D, SS + (size_t)(4 * L + 2) * T * 16, 1.0f, nullptr, nullptr};
            run_gemm(lds, MERGED, D, WB + WO_WO, T, D, D, 0, E, wv);
        } break;
        case 9: {
            EpiSwiglu E{U, SS + (size_t)(4 * L + 2) * T * 16};
            run_gemm(lds, XG, D, WB + WO_13B, T, 2 * FF, D, 0, E, wv);
            EpiRow<2> Ep{PP, D, nullptr, nullptr, nullptr, 0};
            run_gemm(lds, (const bf16_t*)(ws + WS_PBF) + (size_t)(L & 1) * T * PLE, PLE, WB + WO_PP, T, D, PLE, 0, Ep, wv);
        } break;
        case 10: {
            EpiResid<0> E{X, X, XG, p->in[22] + L * D, SS + (size_t)(4 * L + 3) * T * 16, 0.5f, nullptr, nullptr};
            run_gemm(lds, U, FF, WB + WO_2B, T, D, FF, 0, E, wv);
        } break;
        case 11: {
            EpiResid<1> E{X, X, XGB, L + 1 < DEPTH ? p->in[2] + (L + 1) * D : p->in[25], SS + (size_t)(4 * L + 4) * T * 16, 1.0f, SS + (size_t)(4 * L + 3) * T * 16, PP};
            run_gemm(lds, XG, D, WB + WO_PG, T, D, D, 0, E, wv);
        } break;
        }
    }
}

extern "C" void kernel_launch(void* const* d_in, const int* in_sizes, int n_in, void* d_out, int out_size, void* d_ws, size_t ws_size, hipStream_t stream) {
    static int grid = 0;
    if (grid == 0) {
        if (n_in != 26 || ws_size < WS_END) { fprintf(stderr, "kernel_launch: unexpected n_in %d / ws %zu\n", n_in, ws_size); grid = -1; return; }
        int dev = 0, cus = 0, per_cu = 0;
        hipGetDevice(&dev); hipDeviceGetAttribute(&cus, hipDeviceAttributeMultiprocessorCount, dev);
        if (hipFuncSetAttribute((const void*)mk_fwd, hipFuncAttributeMaxDynamicSharedMemorySize, LDS_BYTES) != hipSuccess) { fprintf(stderr, "hipFuncSetAttribute failed\n"); grid = -1; return; }
        if (hipOccupancyMaxActiveBlocksPerMultiprocessor(&per_cu, (const void*)mk_fwd, 512, LDS_BYTES) != hipSuccess || per_cu < 1) { fprintf(stderr, "occupancy query: %d\n", per_cu); per_cu = 1; }
        (void)hipGetLastError();
        grid = cus * 1;
    }
    if (grid < 0) return;
    hipMemsetAsync((char*)d_ws + WS_CTL, 0, CTL_BYTES, stream);
    P a{};
    for (int i = 0; i < 26; ++i) a.in[i] = (const float*)d_in[i];
    a.out = (float*)d_out; a.ws = (unsigned char*)d_ws;
#if MK_MULTI
    for (int ph = 0; ph < NPH; ++ph) { a.ph_lo = ph; a.ph_hi = ph + 1; hipLaunchKernelGGL(mk_fwd, dim3(grid), dim3(512), LDS_BYTES, stream, a); }
#else
    a.ph_lo = 0; a.ph_hi = NPH;
    void* args[] = {&a};
    hipError_t e = hipLaunchCooperativeKernel((const void*)mk_fwd, dim3(grid), dim3(512), args, LDS_BYTES, stream);
    if (e != hipSuccess) fprintf(stderr, "cooperative launch failed: %s (grid %d)\n", hipGetErrorString(e), grid);
#endif
}
```

```cpp
#include <hip/hip_runtime.h>
#include <hip/hip_cooperative_groups.h>
#include <cstdio>
#include <cstdint>
namespace cg = cooperative_groups;
#ifndef MK_MULTI
#define MK_MULTI 0
#endif
__device__ __forceinline__ int mk_tid(int wv) { int lane; asm volatile("v_mbcnt_lo_u32_b32 %0, -1, 0\n\tv_mbcnt_hi_u32_b32 %0, -1, %0" : "=v"(lane)); return lane + 64 * wv; }
__device__ __forceinline__ int mk_bid() { int b = blockIdx.x; asm volatile("" : "+s"(b)); return b; }
__device__ __forceinline__ int mk_grid() { int g = gridDim.x; asm volatile("" : "+s"(g)); return g; }
namespace pg8 {
#define PG8_LAS __attribute__((address_space(3)))
typedef unsigned short bf16_t;
typedef short bf16x8 __attribute__((ext_vector_type(8)));
typedef float f32x4 __attribute__((ext_vector_type(4)));
typedef unsigned u32x4 __attribute__((ext_vector_type(4)));
constexpr int BM = 256, BK = 64, HALF = 128, HTB = HALF * BK * 2  , STAGE_BYTES = 8 * HTB, NXCD = 8, WGM = 8;

__host__ __device__ __forceinline__ int lds_byte(int r, int c) { const int st = (r >> 4) * 2 + (c >> 5), rr = r & 15, cc = c & 31, ob = rr * 64 + cc * 2; return st * 1024 + (ob ^ (((ob >> 9) & 1) << 5)); }
__host__ __device__ __forceinline__ void stage_rc(int b, int& R, int& C) { const int st = b / 1024, sb = b % 1024, swz = sb ^ (((sb >> 9) & 1) << 5); R = (st >> 1) * 16 + swz / 64; C = (st & 1) * 32 + (swz % 64) / 2; }
__host__ __device__ __forceinline__ int perm32(int rho) { const int n = rho >> 4, i = rho & 15; return 8 * (i >> 2) + 4 * n + (i & 3); }

struct Unit { int pm, pn; };
struct Gemm { const bf16_t* A; const bf16_t* Bt; int M, N, K, lda; };

struct StaticOrder {
    int nM, nN, nwg, G, c;
    __host__ __device__ void init(int M, int N, int G_, int c_) { nM = M / BM; nN = N / BM; nwg = nM * nN; G = G_; c = c_; }
    __host__ __device__ bool next(int i, Unit& u) const {
        const long L = (long)i * G + c; if (L >= nwg) return false;
        int wgid = (int)L; { const int q = nwg / NXCD, r = nwg % NXCD, xcd = wgid % NXCD, off = wgid / NXCD; wgid = (xcd < r ? xcd * (q + 1) : r * (q + 1) + (xcd - r) * q) + off; }
        const int nig = WGM * nN, gid = wgid / nig, fm = gid * WGM, gsz = (nM - fm) < WGM ? (nM - fm) : WGM;
        u.pm = fm + ((wgid % nig) % gsz); u.pn = (wgid % nig) / gsz; return true;
    }
    __device__ __forceinline__ void a_ready(const Unit&) const {}
    __device__ __forceinline__ void done(const Unit&) const {}
};

__device__ __forceinline__ unsigned cvt_pk_bf16(float lo, float hi) { unsigned r; asm volatile("v_cvt_pk_bf16_f32 %0, %1, %2" : "=v"(r) : "v"(lo), "v"(hi)); return r; }
typedef float f32x2 __attribute__((ext_vector_type(2)));
template <class Epi, class Sched, bool ALIGN_EPI = false, bool SP2 = false>
__device__ __forceinline__ void gemm_phase(PG8_LAS unsigned char* lds, const Gemm g, const Sched& S, const Epi& E, int wv) {
    int wv_ = wv; asm volatile("" : "+s"(wv_)); int tid_ = mk_tid(wv_); asm volatile("" : "+v"(tid_)); const int tid = tid_, wid = wv_, lane = tid & 63, wr = wid >> 2, wc = wid & 3, fr = lane & 15, fq = lane >> 4;
    const int K = g.K, nt = K / BK;
    unsigned voffA[2], voffB[2];
#pragma unroll
    for (int i = 0; i < 2; ++i) { int R, C; stage_rc(tid * 16 + i * 8192, R, C); const int Rb = Epi::PERM ? ((R & ~31) + perm32(R & 31)) : R;
        voffA[i] = (unsigned)(R * g.lda + C) * 2u; voffB[i] = (unsigned)(Rb * K + C) * 2u; }
    const size_t kstep = (size_t)(BK * 2);
    const size_t hstepB = (size_t)HALF * K * 2, hstepA = (size_t)HALF * g.lda * 2;
    const size_t tstepA = 2 * hstepA, tstepB = 2 * hstepB;
    const unsigned ldsw = (unsigned)wid * 1024u;
    const int aoff = lds_byte(wr * 64 + fr, fq * 8), boff = lds_byte(wc * 32 + fr, fq * 8);
#define PG8_SA(b, h) (((b) * 2 + (h)) * HTB)
#define PG8_SB(b, h) ((4 + (b) * 2 + (h)) * HTB)
#define PG8_STAGE(bufoff, gbase, voff) do { _Pragma("unroll") for (int _i = 0; _i < 2; ++_i) \
        __builtin_amdgcn_global_load_lds((const unsigned*)((const char*)(gbase) + (voff)[_i]), (PG8_LAS unsigned*)(lds + (bufoff) + ldsw + _i * 8192), 16, 0, 0); } while (0)
#define PG8_LDA(dst, b, h) do { _Pragma("unroll") for (int m = 0; m < 4; ++m) _Pragma("unroll") for (int k = 0; k < 2; ++k) dst[m][k] = *(const PG8_LAS bf16x8*)(lds + PG8_SA(b, h) + aoff + m * 2048 + k * 1024); } while (0)
#define PG8_LDB(dst, b, h) do { _Pragma("unroll") for (int n = 0; n < 2; ++n) _Pragma("unroll") for (int k = 0; k < 2; ++k) dst[n][k] = *(const PG8_LAS bf16x8*)(lds + PG8_SB(b, h) + boff + n * 2048 + k * 1024); } while (0)
#define PG8_MMA(ai, bj, At, Bt) do { __builtin_amdgcn_s_setprio(1); _Pragma("unroll") for (int m = 0; m < 4; ++m) _Pragma("unroll") for (int n = 0; n < 2; ++n) _Pragma("unroll") for (int k = 0; k < 2; ++k) \
        acc[ai][bj][m][n] = __builtin_amdgcn_mfma_f32_16x16x32_bf16(Bt[n][k], At[m][k], acc[ai][bj][m][n], 0, 0, 0); __builtin_amdgcn_s_setprio(0); } while (0)
#define PG8_WAIT_V(n) asm volatile("s_waitcnt vmcnt(" #n ")" ::: "memory")
#define PG8_WAIT_L(n) asm volatile("s_waitcnt lgkmcnt(" #n ")" ::: "memory")
#define PG8_BAR __builtin_amdgcn_s_barrier()
#define PG8_SCHED __builtin_amdgcn_sched_barrier(0)
    Unit cur, nxt; int ui = 0;
    if (!S.next(0, cur)) return;
    f32x4 acc[2][2][4][2];
#pragma unroll
    for (int a = 0; a < 2; ++a)
#pragma unroll
        for (int b = 0; b < 2; ++b)
#pragma unroll
            for (int m = 0; m < 4; ++m)
#pragma unroll
                for (int n = 0; n < 2; ++n) acc[a][b][m][n] = (f32x4){0.f, 0.f, 0.f, 0.f};
    bf16x8 At[4][2], B0[2][2], B1[2][2];
    const char* cA = (const char*)g.A + (size_t)cur.pm * tstepA; const char* cB = (const char*)g.Bt + (size_t)cur.pn * tstepB;
    S.a_ready(cur);
    if constexpr (SP2) {
        PG8_STAGE(PG8_SB(0, 0), cB, voffB); PG8_STAGE(PG8_SB(0, 1), cB + hstepB, voffB); PG8_STAGE(PG8_SA(0, 0), cA, voffA); PG8_STAGE(PG8_SA(0, 1), cA + hstepA, voffA);
        if (wr == 1) PG8_BAR;
        PG8_WAIT_V(2); PG8_BAR;
        PG8_STAGE(PG8_SB(1, 0), cB + kstep, voffB); PG8_STAGE(PG8_SA(1, 0), cA + kstep, voffA); PG8_STAGE(PG8_SB(1, 1), cB + hstepB + kstep, voffB);
        PG8_WAIT_V(6); PG8_BAR;
    } else {
        PG8_STAGE(PG8_SB(0, 0), cB, voffB); PG8_STAGE(PG8_SA(0, 0), cA, voffA); PG8_STAGE(PG8_SB(0, 1), cB + hstepB, voffB); PG8_STAGE(PG8_SA(0, 1), cA + hstepA, voffA);
        if (wr == 1) PG8_BAR;
        PG8_WAIT_V(4); PG8_BAR;
        PG8_STAGE(PG8_SB(1, 0), cB + kstep, voffB); PG8_STAGE(PG8_SA(1, 0), cA + kstep, voffA); PG8_STAGE(PG8_SB(1, 1), cB + hstepB + kstep, voffB);
        PG8_WAIT_V(6); PG8_BAR;
    }
    for (;;) {
        const bool has_next = S.next(ui + 1, nxt);
        const char* nA = has_next ? (const char*)g.A + (size_t)nxt.pm * tstepA : cA; const char* nB = has_next ? (const char*)g.Bt + (size_t)nxt.pn * tstepB : cB;
        for (int t = 0; t < nt; t += 2) {
            const bool last = (t == nt - 2);
            const char* a1 = cA + (size_t)(t + 1) * kstep;
            const char* a2 = last ? nA : cA + (size_t)(t + 2) * kstep; const char* b2 = last ? nB : cB + (size_t)(t + 2) * kstep;
            const char* a3 = a2 + kstep; const char* b3 = b2 + kstep;
            if (last && has_next) S.a_ready(nxt);
            if constexpr (SP2) {
            PG8_LDB(B0, 0, 0); PG8_LDB(B1, 0, 1); PG8_SCHED; PG8_LDA(At, 0, 0); PG8_STAGE(PG8_SA(1, 1), a1 + hstepA, voffA);
            PG8_WAIT_V(8); PG8_WAIT_L(0); PG8_BAR; PG8_MMA(0, 0, At, B0); PG8_MMA(0, 1, At, B1); PG8_BAR; PG8_SCHED;
            PG8_LDA(At, 0, 1); PG8_STAGE(PG8_SB(0, 0), b2, voffB); PG8_STAGE(PG8_SB(0, 1), b2 + hstepB, voffB); PG8_STAGE(PG8_SA(0, 0), a2, voffA);
            PG8_WAIT_V(8); PG8_WAIT_L(0); PG8_BAR; PG8_MMA(1, 0, At, B0); PG8_MMA(1, 1, At, B1); PG8_BAR; PG8_SCHED;
            PG8_LDB(B0, 1, 0); PG8_LDB(B1, 1, 1); PG8_SCHED; PG8_LDA(At, 1, 0); PG8_STAGE(PG8_SA(0, 1), a2 + hstepA, voffA);
            PG8_WAIT_V(8); PG8_WAIT_L(0); PG8_BAR; PG8_MMA(0, 0, At, B0); PG8_MMA(0, 1, At, B1); PG8_BAR; PG8_SCHED;
            PG8_LDA(At, 1, 1); PG8_STAGE(PG8_SB(1, 0), b3, voffB); PG8_STAGE(PG8_SB(1, 1), b3 + hstepB, voffB); PG8_STAGE(PG8_SA(1, 0), a3, voffA);
            PG8_WAIT_V(8); PG8_WAIT_L(0); PG8_BAR; PG8_MMA(1, 0, At, B0); PG8_MMA(1, 1, At, B1); PG8_BAR; PG8_SCHED;
            } else {
            PG8_LDB(B0, 0, 0); PG8_SCHED; PG8_LDA(At, 0, 0); PG8_STAGE(PG8_SA(1, 1), a1 + hstepA, voffA);
            PG8_WAIT_L(8); PG8_BAR; PG8_WAIT_L(0); PG8_MMA(0, 0, At, B0); PG8_BAR; PG8_SCHED;
            PG8_LDB(B1, 0, 1); PG8_STAGE(PG8_SB(0, 0), b2, voffB);
            PG8_BAR; PG8_WAIT_L(0); PG8_MMA(0, 1, At, B1); PG8_BAR;
            PG8_LDA(At, 0, 1); PG8_STAGE(PG8_SA(0, 0), a2, voffA);
            PG8_BAR; PG8_WAIT_L(0); PG8_MMA(1, 0, At, B0); PG8_BAR; PG8_SCHED;
            PG8_STAGE(PG8_SB(0, 1), b2 + hstepB, voffB);
            PG8_WAIT_V(6); PG8_BAR; PG8_MMA(1, 1, At, B1); PG8_BAR;
            PG8_LDB(B0, 1, 0); PG8_SCHED; PG8_LDA(At, 1, 0); PG8_STAGE(PG8_SA(0, 1), a2 + hstepA, voffA);
            PG8_WAIT_L(8); PG8_BAR; PG8_WAIT_L(0); PG8_MMA(0, 0, At, B0); PG8_BAR; PG8_SCHED;
            PG8_LDB(B1, 1, 1); PG8_STAGE(PG8_SB(1, 0), b3, voffB);
            PG8_BAR; PG8_WAIT_L(0); PG8_MMA(0, 1, At, B1); PG8_BAR;
            PG8_LDA(At, 1, 1); PG8_STAGE(PG8_SA(1, 0), a3, voffA);
            PG8_BAR; PG8_WAIT_L(0); PG8_MMA(1, 0, At, B0); PG8_BAR; PG8_SCHED;
            PG8_STAGE(PG8_SB(1, 1), b3 + hstepB, voffB);
            PG8_WAIT_V(6); PG8_BAR; PG8_MMA(1, 1, At, B1); PG8_BAR;
            }
        }
        if constexpr (ALIGN_EPI) { if (wr == 0) PG8_BAR; }
        if constexpr (!Epi::AFTER_DRAIN) { const int l2_ = mk_tid(wv_) & 63; E(acc, cur, wr, wc, l2_ & 15, l2_ >> 4); S.done(cur); }
        if (!has_next) break;
#pragma unroll
        for (int a = 0; a < 2; ++a)
#pragma unroll
            for (int b = 0; b < 2; ++b)
#pragma unroll
                for (int m = 0; m < 4; ++m)
#pragma unroll
                    for (int n = 0; n < 2; ++n) acc[a][b][m][n] = (f32x4){0.f, 0.f, 0.f, 0.f};
        cur = nxt; cA = nA; cB = nB; ++ui;
        if constexpr (ALIGN_EPI) { if (wr == 1) PG8_BAR; }
    }
    PG8_WAIT_V(0);
    if constexpr (!ALIGN_EPI) { if (wr == 0) PG8_BAR; }
    PG8_BAR;
    if constexpr (Epi::AFTER_DRAIN) { E.fused(acc, cur, wr, wc, fr, fq, lds, wid, lane); S.done(cur); }
#undef PG8_SA
#undef PG8_SB
#undef PG8_STAGE
#undef PG8_LDA
#undef PG8_LDB
#undef PG8_MMA
#undef PG8_WAIT_V
#undef PG8_WAIT_L
#undef PG8_BAR
#undef PG8_SCHED
}
}

#define LAS __attribute__((address_space(3)))
typedef unsigned short bf16_t;
typedef short bf16x8 __attribute__((ext_vector_type(8)));
typedef float f32x4 __attribute__((ext_vector_type(4)));
typedef float f32x16 __attribute__((ext_vector_type(16)));
typedef unsigned u32x4 __attribute__((ext_vector_type(4)));
typedef unsigned u32x2 __attribute__((ext_vector_type(2)));

constexpr int T = 16384, S = 8192, D = 1024, FF = 2816, NZ = 4608, DEPTH = 4, PLE = 256;
constexpr float EPS = 1e-6f;
constexpr int LDV = S + 64;
constexpr int Z_QA = 0, Z_CKV = 512, Z_QI = 640, Z_KI = 896, Z_WI = 928, Z_QB = 936, Z_KVB = 1448, Z_GB = 2216, Z_GM = 2240, Z_KV = 4288;
constexpr int NPH = 50;

constexpr size_t MiB = 1u << 20;
constexpr size_t WS_CTL = 0, CTL_BYTES = 2 * MiB, WS_SS = 64 * 1024;
constexpr size_t WS_ROPE = 2 * MiB, WS_BIAS = 3 * MiB;
constexpr size_t WS_BAR = 16 * 1024;
constexpr int LDS_BARST = 147456 - 64;
constexpr size_t WS_X = 4 * MiB, WS_XG = 68 * MiB, WS_WB0 = 100 * MiB, WS_WB1 = 154 * MiB, WS_Z = 208 * MiB;
constexpr size_t WS_QA = 352 * MiB, WS_QB = 368 * MiB, WS_KA = 384 * MiB, WS_VA = 386 * MiB, WS_QI = 388 * MiB, WS_KI = 396 * MiB, WS_WI = 397 * MiB;
constexpr size_t WS_KCMP = 398 * MiB, WS_VCMP = 403 * MiB, WS_KS = 408 * MiB, WS_KW = 413 * MiB, WS_VST = 418 * MiB, WS_VWT = 423 * MiB;
constexpr size_t WS_GATES = 428 * MiB, WS_HIDK = 430 * MiB, WS_HIDV = 431 * MiB, WS_KC = 432 * MiB, WS_VCT = 433 * MiB, WS_IDX = 434 * MiB, WS_CNT = 442 * MiB;
constexpr size_t WS_OA = 443 * MiB, WS_OB = 459 * MiB, WS_PBF = 475 * MiB  , WS_SSP = 491 * MiB  , WS_SEL = 509 * MiB  , WS_END = 511 * MiB;
constexpr size_t WS_U = WS_Z, WS_PP = WS_Z + 96 * MiB, WS_MERGED = WS_QA, WS_XGB = WS_QA;
constexpr size_t WO_13A = 0, WO_2A = WO_13A + (size_t)2 * FF * D, WO_IN = WO_2A + (size_t)D * FF, WO_CK = WO_IN + (size_t)NZ * D, WO_CV = WO_CK + 256 * 2048,
                 WO_PA = WO_CV + 256 * 2048  , WO_WO = WO_PA + 2048 * 1024, WO_13B = WO_WO + 1024 * 1024, WO_2B = WO_13B + (size_t)2 * FF * D,
                 WO_PG = WO_2B + (size_t)D * FF, WO_PP = WO_PG + 1024 * 1024, WO_END = WO_PP + 1024 * 256;
static_assert(WO_END * 2 <= 54 * MiB, "weight buffer");
constexpr int LDS_BYTES = 147456;

__device__ __forceinline__ unsigned f2bf(float f) { unsigned u = __builtin_bit_cast(unsigned, f); return (u + 0x7fffu + ((u >> 16) & 1u)) >> 16; }
__device__ __forceinline__ unsigned pk2(float lo, float hi) { return f2bf(lo) | (f2bf(hi) << 16); }
__device__ __forceinline__ float bf2f(unsigned h) { return __builtin_bit_cast(float, (h & 0xffffu) << 16); }
__device__ __forceinline__ float bflo(unsigned w) { return __builtin_bit_cast(float, w << 16); }
__device__ __forceinline__ float bfhi(unsigned w) { return __builtin_bit_cast(float, w & 0xffff0000u); }
__device__ __forceinline__ float row_rs(const float* ssp, int r) {
    const f32x4 a = *(const f32x4*)(ssp + (size_t)r * 16), b = *(const f32x4*)(ssp + (size_t)r * 16 + 4), c = *(const f32x4*)(ssp + (size_t)r * 16 + 8), d = *(const f32x4*)(ssp + (size_t)r * 16 + 12);
    const float t = (((a[0] + a[1]) + (a[2] + a[3])) + ((b[0] + b[1]) + (b[2] + b[3]))) + (((c[0] + c[1]) + (c[2] + c[3])) + ((d[0] + d[1]) + (d[2] + d[3])));
    return rsqrtf(t * (1.f / 1024.f) + 1e-6f);
}
__device__ __forceinline__ float sigmoidf_(float v) { return __builtin_amdgcn_rcpf(1.f + __expf(-v)); }
__device__ __forceinline__ float wave_sum(float v) {
#pragma unroll
    for (int o = 1; o < 64; o <<= 1) v += __shfl_xor(v, o);
    return v;
}
#define LDS_WAIT() asm volatile("s_waitcnt lgkmcnt(0)" ::: "memory")

using pg8::Unit;
struct EpiSwiglu {
    static constexpr bool PERM = true, AFTER_DRAIN = false;
    bf16_t* U; const float* ss;
    __device__ __forceinline__ void operator()(const f32x4 (&acc)[2][2][4][2], const Unit& u, int wr, int wc, int fr_, int fq_) const {
        int fr = fr_, fq = fq_; asm volatile("" : "+v"(fr), "+v"(fq));
#pragma unroll
        for (int ai = 0; ai < 2; ++ai)
#pragma unroll
            for (int m = 0; m < 4; ++m) {
                const int r = u.pm * 256 + ai * 128 + wr * 64 + m * 16 + fr;
                const float rs = row_rs(ss, r);
#pragma unroll
                for (int bj = 0; bj < 2; ++bj) {
                    const f32x4 a = acc[ai][bj][m][0] * rs, b = acc[ai][bj][m][1] * rs;
                    float o[4];
#pragma unroll
                    for (int i = 0; i < 4; ++i) o[i] = a[i] * __builtin_amdgcn_rcpf(1.f + __expf(-a[i])) * b[i];
                    u32x2 w; w.x = pk2(o[0], o[1]); w.y = pk2(o[2], o[3]);
                    *(u32x2*)(U + (size_t)r * FF + u.pn * 128 + bj * 64 + wc * 16 + fq * 4) = w;
                }
            }
    }
};
template <int MODE> struct EpiResid {
    static constexpr bool PERM = false, AFTER_DRAIN = false;
    const float* xin; float* xout; bf16_t* xg; const float* gnext; float* ssnext; float alpha; const float* sscur; const bf16_t* pp;
    __device__ __forceinline__ void operator()(const f32x4 (&acc)[2][2][4][2], const Unit& u, int wr, int wc, int fr_, int fq_) const {
        int fr = fr_, fq = fq_; asm volatile("" : "+v"(fr), "+v"(fq));
#pragma unroll
        for (int ai = 0; ai < 2; ++ai)
#pragma unroll
            for (int m = 0; m < 4; ++m) {
                const int r = u.pm * 256 + ai * 128 + wr * 64 + m * 16 + fr;
                float rs = 1.f; if (MODE == 1) rs = row_rs(sscur, r);
                float sq = 0.f;
#pragma unroll
                for (int bj = 0; bj < 2; ++bj)
#pragma unroll
                    for (int n = 0; n < 2; ++n) {
                        const int c = u.pn * 256 + bj * 128 + wc * 32 + n * 16 + fq * 4;
                        const size_t off = (size_t)r * D + c;
                        const f32x4 xi = *(const f32x4*)(xin + off), v = acc[ai][bj][m][n];
                        f32x4 xn;
                        if (MODE == 0) xn = xi + v * alpha;
                        else { const u32x2 pw = *(const u32x2*)(pp + off);
                            xn[0] = xi[0] + sigmoidf_(v[0] * rs) * bflo(pw.x); xn[1] = xi[1] + sigmoidf_(v[1] * rs) * bfhi(pw.x);
                            xn[2] = xi[2] + sigmoidf_(v[2] * rs) * bflo(pw.y); xn[3] = xi[3] + sigmoidf_(v[3] * rs) * bfhi(pw.y); }
                        *(f32x4*)(xout + off) = xn;
                        const f32x4 g = *(const f32x4*)(gnext + c);
                        u32x2 w; w.x = pk2(xn[0] * g[0], xn[1] * g[1]); w.y = pk2(xn[2] * g[2], xn[3] * g[3]);
                        *(u32x2*)(xg + off) = w;
                        sq += (xn[0] * xn[0] + xn[1] * xn[1]) + (xn[2] * xn[2] + xn[3] * xn[3]);
                    }
                sq += __shfl_xor(sq, 16); sq += __shfl_xor(sq, 32);
                if (fq == 0) ssnext[(size_t)r * 16 + u.pn * 4 + wc] = sq;
            }
    }
};
template <int MODE> struct EpiRow {
    static constexpr bool PERM = true, AFTER_DRAIN = false;
    bf16_t* O; int ldc; const float* ss; const float* bias; const bf16_t* gate; int ldg;
    __device__ __forceinline__ void operator()(const f32x4 (&acc)[2][2][4][2], const Unit& u, int wr, int wc, int fr_, int fq_) const {
        int fr = fr_, fq = fq_; asm volatile("" : "+v"(fr), "+v"(fq));
#pragma unroll
        for (int ai = 0; ai < 2; ++ai)
#pragma unroll
            for (int m = 0; m < 4; ++m) {
                const int r = u.pm * 256 + ai * 128 + wr * 64 + m * 16 + fr;
                float rs = 1.f; if (MODE == 0) rs = row_rs(ss, r);
#pragma unroll
                for (int bj = 0; bj < 2; ++bj) {
                    const int c = u.pn * 256 + bj * 128 + wc * 32 + fq * 8;
                    float v[8];
#pragma unroll
                    for (int i = 0; i < 4; ++i) { v[i] = acc[ai][bj][m][0][i]; v[4 + i] = acc[ai][bj][m][1][i]; }
                    if (MODE == 0) {
#pragma unroll
                        for (int i = 0; i < 8; ++i) v[i] *= rs;
                    }
                    if (MODE == 1) {
#pragma unroll
                        for (int i = 0; i < 8; ++i) { const float a = v[i] + bias[c + i]; v[i] = a * __builtin_amdgcn_rcpf(1.f + __expf(-a)); }
                    }
                    if (MODE == 3 || MODE == 4) {
                        const u32x4 gw = *(const u32x4*)(gate + (size_t)r * ldg + c);
                        const unsigned gwa[4] = {gw.x, gw.y, gw.z, gw.w};
#pragma unroll
                        for (int i = 0; i < 4; ++i) { v[2 * i] *= sigmoidf_(bflo(gwa[i])); v[2 * i + 1] *= sigmoidf_(bfhi(gwa[i])); }
                    }
                    bf16_t* op = O + (size_t)r * ldc + c;
                    if (MODE == 4) {
                        const u32x4 ow = *(const u32x4*)op; const unsigned owa[4] = {ow.x, ow.y, ow.z, ow.w};
#pragma unroll
                        for (int i = 0; i < 4; ++i) { v[2 * i] += bflo(owa[i]); v[2 * i + 1] += bfhi(owa[i]); }
                    }
                    u32x4 w; w.x = pk2(v[0], v[1]); w.y = pk2(v[2], v[3]); w.z = pk2(v[4], v[5]); w.w = pk2(v[6], v[7]);
                    *(u32x4*)op = w;
                }
            }
    }
};

struct EpiMerge {
    static constexpr bool PERM = true, AFTER_DRAIN = false;
    bf16_t* O; const bf16_t* z;
    __device__ __forceinline__ void operator()(const f32x4 (&acc)[2][2][4][2], const Unit& u, int wr, int wc, int fr_, int fq_) const {
        int fr = fr_, fq = fq_; asm volatile("" : "+v"(fr), "+v"(fq));
#pragma unroll
        for (int ai = 0; ai < 2; ++ai)
#pragma unroll
            for (int m = 0; m < 4; ++m) {
                const int r = u.pm * 256 + ai * 128 + wr * 64 + m * 16 + fr;
#pragma unroll
                for (int bj = 0; bj < 2; ++bj) {
                    const int c = u.pn * 128 + bj * 64 + wc * 16 + fq * 4;
                    const u32x2 ga = *(const u32x2*)(z + (size_t)r * NZ + Z_GM + c), gb = *(const u32x2*)(z + (size_t)r * NZ + Z_GM + 1024 + c);
                    const f32x4 a = acc[ai][bj][m][0], b = acc[ai][bj][m][1];
                    u32x2 w;
                    w.x = pk2(sigmoidf_(bflo(ga.x)) * a[0] + sigmoidf_(bflo(gb.x)) * b[0], sigmoidf_(bfhi(ga.x)) * a[1] + sigmoidf_(bfhi(gb.x)) * b[1]);
                    w.y = pk2(sigmoidf_(bflo(ga.y)) * a[2] + sigmoidf_(bflo(gb.y)) * b[2], sigmoidf_(bfhi(ga.y)) * a[3] + sigmoidf_(bfhi(gb.y)) * b[3]);
                    *(u32x2*)(O + (size_t)r * D + c) = w;
                }
            }
    }
};
template <class Epi> __device__ __forceinline__ void run_gemm(LAS unsigned char* lds, const bf16_t* A, int lda, const bf16_t* Bt, int M, int N, int K, int cshift, const Epi& E, int wv) {
    pg8::Gemm g{A, Bt, M, N, K, lda};
    pg8::StaticOrder So; So.init(M, N, mk_grid(), (int)((mk_bid() + mk_grid() - cshift) % mk_grid()));
    pg8::gemm_phase<Epi, pg8::StaticOrder, true, true>(lds, g, So, E, wv);
}

__device__ __forceinline__ void transpose_item(const float* W, int K, int N, bf16_t* WT, int row_off, int mode, LAS float* scr, int item, int lane, int ldw = 0, int koff = 0) {
    if (ldw == 0) ldw = K;
    const int nblk = N / 32, kb = item / nblk, nb = item % nblk, k0 = 64 * kb, n0 = 32 * nb;
    const int kr = lane >> 3, n4 = (lane & 7) * 4;
#pragma unroll
    for (int i = 0; i < 8; ++i) { const int kk = 8 * i + kr; const f32x4 v = *(const f32x4*)(W + (size_t)(k0 + kk) * N + n0 + n4);
        LAS float* d = scr + kk * 33 + n4; d[0] = v[0]; d[1] = v[1]; d[2] = v[2]; d[3] = v[3]; }
    LDS_WAIT();
    const int c = lane & 7;
#pragma unroll
    for (int j = 0; j < 4; ++j) { const int nl = (lane >> 3) + 8 * j; const LAS float* s = scr + (8 * c) * 33 + nl;
        u32x4 o; o.x = pk2(s[0 * 33], s[1 * 33]); o.y = pk2(s[2 * 33], s[3 * 33]); o.z = pk2(s[4 * 33], s[5 * 33]); o.w = pk2(s[6 * 33], s[7 * 33]);
        const int n = n0 + nl; const int dr = mode == 0 ? row_off + n : (8 * (n >> 2) + (n & 3) + (mode == 2 ? 4 : 0));
        *(u32x4*)(WT + (size_t)dr * ldw + koff + k0 + 8 * c) = o; }
    LDS_WAIT();
}

struct P {
    const float* in[26];
    float* out; unsigned char* ws;
    int ph_lo, ph_hi;
};
typedef const __attribute__((address_space(4))) P* KP;

__device__ __forceinline__ void convert_layer(KP p, int L, bf16_t* WB, LAS unsigned char* lds, int wv) {
    int tid_ = mk_tid(wv); asm volatile("" : "+v"(tid_)); const int tid = tid_, lane = tid & 63; int wave = wv; asm volatile("" : "+s"(wave));
    LAS float* scr = (LAS float*)(lds + wave * 16384);
    const int gw = mk_bid() * 8 + wave, NGW = mk_grid() * 8;
    constexpr int I_13 = 16 * 88, I_2 = 44 * 32, I_IN = 16 * 134, I_C = 32 * 8, I_PR = 8 * 32, I_SQ = 16 * 32, I_PP = 4 * 32;
    constexpr int NIT = 4 * I_13 + 2 * I_2 + I_IN + 2 * I_C + 2 * I_PR + 2 * I_SQ + I_PP;
    const size_t l13 = (size_t)L * D * FF, lsq = (size_t)L * D * D;
    for (int it = gw; it < NIT; it += NGW) {
        int r = it;
        if (r < I_13) { transpose_item(p->in[3] + l13, D, FF, WB + WO_13A, 0, 1, scr, r, lane); continue; } r -= I_13;
        if (r < I_13) { transpose_item(p->in[4] + l13, D, FF, WB + WO_13A, 0, 2, scr, r, lane); continue; } r -= I_13;
        if (r < I_2) { transpose_item(p->in[5] + l13, FF, D, WB + WO_2A, 0, 0, scr, r, lane); continue; } r -= I_2;
        if (r < I_IN) { transpose_item(p->in[7] + (size_t)L * D * 4288, D, 4288, WB + WO_IN, 0, 0, scr, r, lane); continue; } r -= I_IN;
        if (r < I_C) { transpose_item(p->in[11] + (size_t)L * 2048 * 256, 2048, 256, WB + WO_CK, 0, 0, scr, r, lane); continue; } r -= I_C;
        if (r < I_C) { transpose_item(p->in[13] + (size_t)L * 2048 * 256, 2048, 256, WB + WO_CV, 0, 0, scr, r, lane); continue; } r -= I_C;
        if (r < I_PR) { transpose_item(p->in[15] + (size_t)L * 512 * D, 512, D, WB + WO_PA, 0, 1, scr, r, lane, 1024, 0); continue; } r -= I_PR;
        if (r < I_PR) { transpose_item(p->in[16] + (size_t)L * 512 * D, 512, D, WB + WO_PA, 0, 2, scr, r, lane, 1024, 512); continue; } r -= I_PR;
        if (r < I_SQ) { transpose_item(p->in[17] + lsq, D, D, WB + WO_WO, 0, 0, scr, r, lane); continue; } r -= I_SQ;
        if (r < I_13) { transpose_item(p->in[19] + l13, D, FF, WB + WO_13B, 0, 1, scr, r, lane); continue; } r -= I_13;
        if (r < I_13) { transpose_item(p->in[20] + l13, D, FF, WB + WO_13B, 0, 2, scr, r, lane); continue; } r -= I_13;
        if (r < I_2) { transpose_item(p->in[21] + l13, FF, D, WB + WO_2B, 0, 0, scr, r, lane); continue; } r -= I_2;
        if (r < I_SQ) { transpose_item(p->in[23] + lsq, D, D, WB + WO_PG, 0, 0, scr, r, lane); continue; } r -= I_SQ;
        transpose_item(p->in[24] + (size_t)L * PLE * D, PLE, D, WB + WO_PP, 0, 0, scr, r, lane);
    }
    const int gt = mk_bid() * 512 + tid, NGT = mk_grid() * 512;
    const float* win = p->in[7] + (size_t)L * D * 4288; const float* gkv = p->in[8] + L * 128; const float* ukv = p->in[9] + (size_t)L * 128 * 128;
    for (int o = gt; o < 128 * 1024; o += NGT) {
        const int n = o & 127, k = o >> 7; float a = 0.f;
        for (int j = 0; j < 128; ++j) a += win[(size_t)k * 4288 + 512 + j] * gkv[j] * ukv[j * 128 + n];
        WB[WO_IN + (size_t)(4288 + n) * D + k] = (bf16_t)f2bf(a);
    }
    for (int o = gt; o < 2048 * 64; o += NGT) { const int row = o >> 6, ch = o & 63; unsigned zz; asm volatile("v_mov_b32 %0, 0" : "=v"(zz));
        *(u32x4*)(WB + WO_PA + (size_t)row * 1024 + ((row & 4) ? 0 : 512) + ch * 8) = (u32x4){zz, zz, zz, zz}; }
    for (int o = gt; o < 192 * 1024 / 8; o += NGT) { unsigned zz; asm volatile("v_mov_b32 %0, 0" : "=v"(zz)); *(u32x4*)(WB + WO_IN + (size_t)4416 * D + (size_t)o * 8) = (u32x4){zz, zz, zz, zz}; }
    float* bias = (float*)(p->ws + WS_BIAS);
    for (int o = gw; o < 512; o += NGW) {
        const int n = o & 255, kv = o >> 8; const float* w1 = p->in[kv ? 13 : 11] + (size_t)L * 2048 * 256; const float* pos = p->in[10] + L * 2048; float a = 0.f;
#pragma unroll 8
        for (int k = lane; k < 2048; k += 64) a += pos[k] * w1[(size_t)k * 256 + n];
        a = wave_sum(a);
        if (lane == 0) bias[o] = a;
    }
    const float* pl = p->in[1] + (size_t)L * T * PLE; bf16_t* pb = (bf16_t*)(p->ws + WS_PBF) + (size_t)(L & 1) * T * PLE;
    for (int o = gt; o < T * PLE / 8; o += NGT) { const f32x4 a = *(const f32x4*)(pl + (size_t)o * 8), b = *(const f32x4*)(pl + (size_t)o * 8 + 4);
        u32x4 w; w.x = pk2(a[0], a[1]); w.y = pk2(a[2], a[3]); w.z = pk2(b[0], b[1]); w.w = pk2(b[2], b[3]); *(u32x4*)(pb + (size_t)o * 8) = w; }
}

__device__ __forceinline__ void prologue_phase(KP p, LAS unsigned char* lds, int wv) {
    int tid_ = mk_tid(wv); asm volatile("" : "+v"(tid_)); const int tid = tid_, lane = tid & 63; int wave = wv; asm volatile("" : "+s"(wave));
    const int gt = mk_bid() * 512 + tid, NGT = mk_grid() * 512;
    float* rope = (float*)(p->ws + WS_ROPE);
    for (int o = gt; o < S * 12; o += NGT) {
        int pos, j; float inv;
        if (o < S * 8) { pos = o >> 3; j = o & 7;
            inv = j == 0 ? 1.0f : j == 1 ? 0.19392274f : j == 2 ? 0.037606031f : j == 3 ? 0.0072926646f : j == 4 ? 0.0014142136f : j == 5 ? 0.00027424819f : j == 6 ? 5.3182957e-05f : 1.0313385e-05f; }
        else { const int o2 = o - S * 8; pos = o2 >> 2; j = o2 & 3;
            inv = j == 0 ? 1.0f : j == 1 ? 0.037606031f : j == 2 ? 0.0014142136f : 5.3182957e-05f; }
        const float ang = (float)pos * inv;
        const double rev = (double)ang * 0.15915494309189533577;
        const float fr = (float)(rev - __builtin_floor(rev));
        const float c = __builtin_amdgcn_cosf(fr), s = __builtin_amdgcn_sinf(fr);
        if (o < S * 8) { rope[o] = c; rope[S * 8 + o] = s; } else { rope[S * 16 + (o - S * 8)] = c; rope[S * 20 + (o - S * 8)] = s; }
    }
    convert_layer(p, 0, (bf16_t*)(p->ws + WS_WB0), lds, wv);
    const float* x = p->in[0]; const float* g = p->in[2]; bf16_t* xg = (bf16_t*)(p->ws + WS_XG); float* ss = (float*)(p->ws + WS_SSP);
    const int gw = mk_bid() * 8 + wave, NGW = mk_grid() * 8;
    for (int r = gw; r < T; r += NGW) {
        float sq = 0.f;
#pragma unroll
        for (int j = 0; j < 4; ++j) { const int c = (j * 64 + lane) * 4; const f32x4 v = *(const f32x4*)(x + (size_t)r * D + c), gg = *(const f32x4*)(g + c);
            sq += (v[0] * v[0] + v[1] * v[1]) + (v[2] * v[2] + v[3] * v[3]);
            u32x2 w; w.x = pk2(v[0] * gg[0], v[1] * gg[1]); w.y = pk2(v[2] * gg[2], v[3] * gg[3]); *(u32x2*)(xg + (size_t)r * D + c) = w; }
        sq = wave_sum(sq);
        if (lane < 16) ss[(size_t)r * 16 + lane] = lane == 0 ? sq : 0.f;
    }
}

__device__ __forceinline__ float rope_at(const LAS bf16_t* base, int d, int half, const float* cs, const float* sn) {
    const int j = d < half ? d : d - half;
    const float x1 = bf2f(base[j]), x2 = bf2f(base[j + half]);
    return d < half ? x1 * cs[j] - x2 * sn[j] : x2 * cs[j] + x1 * sn[j];
}
__device__ __forceinline__ void post_phase(KP p, LAS unsigned char* lds, int wv) {
    int tid_ = mk_tid(wv); asm volatile("" : "+v"(tid_)); const int tid = tid_, lane = tid & 63; int wave = wv; asm volatile("" : "+s"(wave));
    LAS bf16_t* zr = (LAS bf16_t*)(lds + wave * 16384);
    LAS bf16_t* vt = (LAS bf16_t*)(lds + wave * 16384 + 9216);
    const bf16_t* Z = (const bf16_t*)(p->ws + WS_Z);
    const float* rope = (const float*)(p->ws + WS_ROPE);
    bf16_t* QA = (bf16_t*)(p->ws + WS_QA); bf16_t* QB = (bf16_t*)(p->ws + WS_QB); bf16_t* KA = (bf16_t*)(p->ws + WS_KA); bf16_t* VA = (bf16_t*)(p->ws + WS_VA);
    bf16_t* QI = (bf16_t*)(p->ws + WS_QI); bf16_t* KI = (bf16_t*)(p->ws + WS_KI); float* WI = (float*)(p->ws + WS_WI); float* GATES = (float*)(p->ws + WS_GATES);
    bf16_t* KCMP = (bf16_t*)(p->ws + WS_KCMP); bf16_t* VCMP = (bf16_t*)(p->ws + WS_VCMP); bf16_t* KS = (bf16_t*)(p->ws + WS_KS); bf16_t* KW = (bf16_t*)(p->ws + WS_KW);
    bf16_t* VST = (bf16_t*)(p->ws + WS_VST); bf16_t* VWT = (bf16_t*)(p->ws + WS_VWT);
    const int gw = mk_bid() * 8 + wave, NGW = mk_grid() * 8;
    for (int grp = gw; grp < T / 8; grp += NGW) {
        const int tg0 = grp * 8, b = tg0 >> 13, s0 = tg0 & (S - 1);
        u32x4 zp[9];
#pragma unroll
        for (int i = 0; i < 9; ++i) zp[i] = *(const u32x4*)(Z + (size_t)tg0 * NZ + (i * 64 + lane) * 8);
#pragma unroll 1
        for (int tt = 0; tt < 8; ++tt) {
            const int tg = tg0 + tt, s = s0 + tt;
            LDS_WAIT();
#pragma unroll
            for (int i = 0; i < 9; ++i) *(LAS u32x4*)(zr + (i * 64 + lane) * 8) = zp[i];
            if (tt + 1 < 8) {
#pragma unroll
                for (int i = 0; i < 9; ++i) zp[i] = *(const u32x4*)(Z + (size_t)(tg + 1) * NZ + (i * 64 + lane) * 8);
            }
            LDS_WAIT();
            const float* c16 = rope + s * 8; const float* s16 = rope + S * 8 + s * 8; const float* c8 = rope + S * 16 + s * 4; const float* s8 = rope + S * 20 + s * 4;
#pragma unroll
            for (int i = 0; i < 8; ++i) { const int e = lane + 64 * i, d = e & 63;
                float va = d < 16 ? rope_at(zr + Z_QA + (e & ~63), d, 8, c16, s16) : bf2f(zr[Z_QA + e]);
                float vb = d < 16 ? rope_at(zr + Z_QB + (e & ~63), d, 8, c16, s16) : bf2f(zr[Z_QB + e]);
                QA[(size_t)tg * 512 + e] = (bf16_t)f2bf(va * 0.18033688011112042f); QB[(size_t)tg * 512 + e] = (bf16_t)f2bf(vb * 0.18033688011112042f); }
#pragma unroll
            for (int i = 0; i < 4; ++i) { const int e = lane + 64 * i, d = e & 31;
                float v = d < 8 ? rope_at(zr + Z_QI + (e & ~31), d, 4, c8, s8) : bf2f(zr[Z_QI + e]);
                QI[(size_t)tg * 256 + e] = (bf16_t)f2bf(v); }
            if (lane < 32) { const int d = lane; float v = d < 8 ? rope_at(zr + Z_KI, d, 4, c8, s8) : bf2f(zr[Z_KI + d]); KI[(size_t)tg * 32 + d] = (bf16_t)f2bf(v); }
            if (lane < 8) WI[(size_t)tg * 8 + lane] = bf2f(zr[Z_WI + lane]) * 0.35355339059327373f;
            if (lane < 24) GATES[(size_t)tg * 24 + lane] = sigmoidf_(bf2f(zr[Z_GB + lane]));
            { const float a = bf2f(zr[Z_CKV + lane]), c = bf2f(zr[Z_CKV + 64 + lane]);
              const float rs = rsqrtf(wave_sum(a * a + c * c) * (1.f / 128.f) + EPS);
              const int d = lane;
              float kv = d < 16 ? rope_at(zr + Z_KV, d, 8, c16, s16) : bf2f(zr[Z_KV + d]);
              KA[(size_t)tg * 64 + d] = (bf16_t)f2bf(kv * rs);
              VA[(size_t)tg * 64 + d] = (bf16_t)f2bf(bf2f(zr[Z_KV + 64 + d]) * rs); }
#pragma unroll
            for (int i = 0; i < 2; ++i) { const int e = lane + 64 * i, g = i, d = lane;
                const size_t dst = ((size_t)(b * 2 + g) * S + s) * 64 + d;
                float kc = d < 16 ? rope_at(zr + Z_KVB + 0 + g * 64, d, 8, c16, s16) : bf2f(zr[Z_KVB + 0 + e]);
                float ks = d < 16 ? rope_at(zr + Z_KVB + 256 + g * 64, d, 8, c16, s16) : bf2f(zr[Z_KVB + 256 + e]);
                float kw = d < 16 ? rope_at(zr + Z_KVB + 512 + g * 64, d, 8, c16, s16) : bf2f(zr[Z_KVB + 512 + e]);
                KCMP[dst] = (bf16_t)f2bf(kc); KS[dst] = (bf16_t)f2bf(ks); KW[dst] = (bf16_t)f2bf(kw);
                VCMP[dst] = zr[Z_KVB + 128 + e];
                vt[(e) * 8 + tt] = zr[Z_KVB + 384 + e];
                vt[(128 + e) * 8 + tt] = zr[Z_KVB + 640 + e]; }
        }
        LDS_WAIT();
#pragma unroll
        for (int i = 0; i < 4; ++i) { const int rr = lane + 64 * i, e = rr & 127, g = e >> 6, d = e & 63;
            bf16_t* dst = (rr >> 7 ? VWT : VST) + ((size_t)(b * 2 + g) * 64 + d) * LDV + s0;
            *(u32x4*)dst = *(const LAS u32x4*)(vt + rr * 8); }
        LDS_WAIT();
    }
}

__device__ __forceinline__ void cmp2_phase(KP p, int L, int wv) {
    int tid_ = mk_tid(wv); asm volatile("" : "+v"(tid_)); const int gt = mk_bid() * 512 + tid_, NGT = mk_grid() * 512;
    bf16_t* KC = (bf16_t*)(p->ws + WS_KC); bf16_t* VCT = (bf16_t*)(p->ws + WS_VCT);
    for (int o = gt; o < 2 * 2048 * 64; o += NGT) {
        const int n = o & 63, r = (o >> 6) & 2047, kv = o >> 17;
        const bf16_t* hid = (const bf16_t*)(p->ws + (kv ? WS_HIDV : WS_HIDK)) + (size_t)r * 256;
        const float* w2 = p->in[kv ? 14 : 12] + (size_t)L * 256 * 64;
        float a = 0.f;
        for (int j = 0; j < 256; ++j) a += bf2f(hid[j]) * w2[j * 64 + n];
        if (kv == 0) KC[(size_t)r * 64 + n] = (bf16_t)f2bf(a);
        else VCT[((size_t)(r >> 9) * 64 + n) * 512 + (r & 511)] = (bf16_t)f2bf(a);
    }
}

__device__ __forceinline__ unsigned quant16(float v, float lo, float scale) { const float q = (v - lo) * scale; return min(65535u, (unsigned)q); }
__device__ __forceinline__ void scan_bins(const LAS unsigned* h, unsigned need, int lane, LAS int* outb, LAS int* outneed) {
    const unsigned h0 = h[4 * lane], h1 = h[4 * lane + 1], h2 = h[4 * lane + 2], h3 = h[4 * lane + 3];
    const unsigned tot = h0 + h1 + h2 + h3;
    unsigned suf = tot;
#pragma unroll
    for (int o = 1; o < 64; o <<= 1) { const unsigned t = __shfl_down(suf, o); if (lane + o < 64) suf += t; }
    unsigned cum = suf - tot;
    const unsigned hh[4] = {h0, h1, h2, h3};
#pragma unroll
    for (int b = 3; b >= 0; --b) { if (cum < need && cum + hh[b] >= need) { *outb = 4 * lane + b; *outneed = (int)(need - cum); } cum += hh[b]; }
}
__device__ __forceinline__ void indexer_phase(KP p, LAS unsigned char* lds, int L, int wv, int cslot, const bool score_only = false) {
    int tid_ = mk_tid(wv); asm volatile("" : "+v"(tid_)); const int tid = tid_, lane = tid & 63; int wave = wv; asm volatile("" : "+s"(wave));
    LAS float* sc = (LAS float*)lds;
    LAS unsigned* hist = (LAS unsigned*)(lds + 131072);
    LAS float* mm = (LAS float*)(lds + 131072 + 4096);
    LAS int* ctl = (LAS int*)(lds + 131072 + 4096 + 256);
    const bf16_t* QI = (const bf16_t*)(p->ws + WS_QI); const bf16_t* KI = (const bf16_t*)(p->ws + WS_KI); const float* WI = (const float*)(p->ws + WS_WI);
    unsigned short* IDX = (unsigned short*)(p->ws + WS_IDX); int* CNT = (int*)(p->ws + WS_CNT);
    unsigned* ctr = (unsigned*)(p->ws + WS_CTL) + 64 * L + cslot;
    const int r = lane & 31, hi = lane >> 5;
    for (;;) {
        __syncthreads();
        if (tid == 0) ctl[0] = (int)atomicAdd(ctr, 1u);
        for (int i = tid; i < 1024; i += 512) hist[i] = 0u;
        __syncthreads();
        const int item = ctl[0];
        if (item >= T / 4) break;
        const int tg0 = (T / 4 - 1 - item) * 4, b = tg0 >> 13, s0 = tg0 & (S - 1);
        const int ntile = (s0 + 4 + 31) >> 5;
        const int i16 = (r & 3) + 4 * (r >> 3), aq = 2 * ((r >> 2) & 1) + (i16 >> 3), ah = i16 & 7;
        const bf16_t* qp = QI + (size_t)(tg0 + aq) * 256 + ah * 32 + 8 * hi;
        const bf16x8 a0 = *(const bf16x8*)qp, a1 = *(const bf16x8*)(qp + 16);
        float w[16];
#pragma unroll
        for (int i = 0; i < 16; ++i) w[i] = WI[(size_t)(tg0 + 2 * hi + (i >> 3)) * 8 + (i & 7)];
        float mn2[2] = {3.0e38f, 3.0e38f}, mx2[2] = {-3.0e38f, -3.0e38f};
        for (int kt = wave; kt < ntile; kt += 8) {
            const int key = kt * 32 + r;
            const bf16_t* kp = KI + ((size_t)b * S + key) * 32 + 8 * hi;
            const bf16x8 b0 = *(const bf16x8*)kp, b1 = *(const bf16x8*)(kp + 16);
            f32x16 acc;
#pragma unroll
            for (int i = 0; i < 16; ++i) acc[i] = 0.f;
            acc = __builtin_amdgcn_mfma_f32_32x32x16_bf16(a0, b0, acc, 0, 0, 0);
            acc = __builtin_amdgcn_mfma_f32_32x32x16_bf16(a1, b1, acc, 0, 0, 0);
#pragma unroll
            for (int ql = 0; ql < 2; ++ql) {
                float pq = 0.f;
#pragma unroll
                for (int i = 0; i < 8; ++i) pq += w[ql * 8 + i] * fmaxf(acc[8 * ql + i], 0.f);
                const int q = 2 * hi + ql;
                const bool valid = key <= s0 + q;
                const float plo = valid ? pq : -3.0e38f;
                mn2[ql] = fminf(mn2[ql], valid ? pq : 3.0e38f); mx2[ql] = fmaxf(mx2[ql], plo);
                sc[q * 8192 + key] = plo;
            }
        }
        float mn[4], mx[4];
#pragma unroll
        for (int q = 0; q < 4; ++q) { const bool own = hi == (q >> 1); mn[q] = own ? mn2[q & 1] : 3.0e38f; mx[q] = own ? mx2[q & 1] : -3.0e38f; }
#pragma unroll
        for (int q = 0; q < 4; ++q)
#pragma unroll
            for (int o = 1; o < 64; o <<= 1) { mn[q] = fminf(mn[q], __shfl_xor(mn[q], o)); mx[q] = fmaxf(mx[q], __shfl_xor(mx[q], o)); }
        if (lane == 0) {
#pragma unroll
            for (int q = 0; q < 4; ++q) { mm[wave * 8 + q] = mn[q]; mm[wave * 8 + 4 + q] = mx[q]; }
        }
        __syncthreads();
        if (score_only) continue;
        {
            const int row = tid >> 7, j = tid & 127, nrow = s0 + row + 1;
            float lo = 3.0e38f, hv = -3.0e38f;
#pragma unroll
            for (int w8 = 0; w8 < 8; ++w8) { lo = fminf(lo, mm[w8 * 8 + row]); hv = fmaxf(hv, mm[w8 * 8 + 4 + row]); }
            const float scale = hv > lo ? 65535.f / (hv - lo) : 0.f;
            if (nrow > 256) for (int i = j; i < nrow; i += 128) __hip_atomic_fetch_add(&hist[row * 256 + (quant16(sc[row * 8192 + i], lo, scale) >> 8)], 1u, __ATOMIC_RELAXED, __HIP_MEMORY_SCOPE_WORKGROUP);
            __syncthreads();
            if (wave < 4 && s0 + wave + 1 > 256) scan_bins(hist + wave * 256, 256u, lane, ctl + 4 + wave, ctl + 8 + wave);
            __syncthreads();
            for (int i = tid; i < 1024; i += 512) hist[i] = 0u;
            __syncthreads();
            if (nrow > 256) { const unsigned B1 = (unsigned)ctl[4 + row];
                for (int i = j; i < nrow; i += 128) { const unsigned k16 = quant16(sc[row * 8192 + i], lo, scale); if ((k16 >> 8) == B1) __hip_atomic_fetch_add(&hist[row * 256 + (k16 & 255u)], 1u, __ATOMIC_RELAXED, __HIP_MEMORY_SCOPE_WORKGROUP); } }
            __syncthreads();
            if (wave < 4 && s0 + wave + 1 > 256) scan_bins(hist + wave * 256, (unsigned)ctl[8 + wave], lane, ctl + 12 + wave, ctl + 16 + wave);
            __syncthreads();
        }
        {
            const int row = tid >> 7, j = tid & 127, nrow = s0 + row + 1; const size_t tg = (size_t)tg0 + row;
            const bool big = nrow > 256;
            float lo = 3.0e38f, hv = -3.0e38f;
#pragma unroll
            for (int w8 = 0; w8 < 8; ++w8) { lo = fminf(lo, mm[w8 * 8 + row]); hv = fmaxf(hv, mm[w8 * 8 + 4 + row]); }
            const float scale = hv > lo ? 65535.f / (hv - lo) : 0.f;
            const unsigned T16 = ((unsigned)ctl[4 + row] << 8) | (unsigned)ctl[12 + row]; const int need2 = ctl[16 + row];
            const int chunk = ((nrow + 127) >> 7) | 1, beg = j * chunk, end = min(beg + chunk, nrow);
            int cg = 0, ce = 0;
            if (big) for (int i = beg; i < end; ++i) { const unsigned k16 = quant16(sc[row * 8192 + i], lo, scale); cg += k16 > T16 ? 1 : 0; ce += k16 == T16 ? 1 : 0; }
            const unsigned v = (unsigned)cg | ((unsigned)ce << 16);
            unsigned incl = v;
#pragma unroll
            for (int o = 1; o < 64; o <<= 1) { const unsigned t = __shfl_up(incl, o); if (lane >= o) incl += t; }
            LAS unsigned* wsum = (LAS unsigned*)(ctl + 32);
            if (lane == 63) wsum[wave] = incl;
            __syncthreads();
            const unsigned pre = incl - v + ((wave & 1) ? wsum[wave - 1] : 0u);
            if (big) {
                int eb = (int)(pre >> 16); int pos = (int)(pre & 0xffffu) + min(eb, need2);
                for (int i = beg; i < end; ++i) { const unsigned k16 = quant16(sc[row * 8192 + i], lo, scale);
                    if (k16 > T16) { if (pos < 256) IDX[tg * 256 + pos] = (unsigned short)i; ++pos; }
                    else if (k16 == T16) { if (eb < need2) { if (pos < 256) IDX[tg * 256 + pos] = (unsigned short)i; ++pos; } ++eb; } }
                if (j == 0) CNT[tg] = 256;
            } else {
#pragma unroll
                for (int i = 0; i < 2; ++i) { const int e = j + 128 * i; IDX[tg * 256 + e] = (unsigned short)(e < nrow ? e : 0); }
                if (j == 0) CNT[tg] = nrow;
            }
        }
    }
}

__device__ __forceinline__ f32x4 mfma16(bf16x8 a, bf16x8 b, f32x4 c) { return __builtin_amdgcn_mfma_f32_16x16x32_bf16(a, b, c, 0, 0, 0); }
__device__ __forceinline__ float ex2(float v) { return __builtin_amdgcn_exp2f(v); }
__device__ __forceinline__ float fmax2(float a, float b) { return __builtin_amdgcn_fmed3f(a, b, __builtin_inff()); }
__device__ __forceinline__ float fmax3(float a, float b, float c) { return fmax2(fmax2(a, b), c); }
__device__ __forceinline__ unsigned cvtpk(float lo, float hi) { unsigned r; asm("v_cvt_pk_bf16_f32 %0, %1, %2" : "=v"(r) : "v"(lo), "v"(hi)); return r; }
__device__ __forceinline__ void load_k64(const bf16_t* Kb, int kb, int krow0, int kq, bf16x8 (&k)[8]) {
#pragma unroll
    for (int j = 0; j < 4; ++j) { const bf16_t* p = Kb + (size_t)(kb + 32 * (j >> 1) + 4 * (j & 1) + krow0) * 64 + 8 * kq; k[2 * j] = *(const bf16x8*)p; k[2 * j + 1] = *(const bf16x8*)(p + 32); }
}
__device__ __forceinline__ void load_v64(const bf16_t* Vt, int ldv, int kb, int lc, int kq, bf16x8 (&v)[8]) {
#pragma unroll
    for (int dt = 0; dt < 4; ++dt) { const bf16_t* p = Vt + (size_t)(16 * dt + lc) * ldv + kb + 8 * kq; v[2 * dt] = *(const bf16x8*)p; v[2 * dt + 1] = *(const bf16x8*)(p + 32); }
}
__device__ __forceinline__ void qk64(const bf16x8 (&k)[8], bf16x8 q0, bf16x8 q1, float (&s)[16]) {
#pragma unroll
    for (int j = 0; j < 4; ++j) { f32x4 a = (f32x4){0.f, 0.f, 0.f, 0.f}; a = mfma16(k[2 * j], q0, a); a = mfma16(k[2 * j + 1], q1, a);
#pragma unroll
        for (int i = 0; i < 4; ++i) s[(j >> 1) * 8 + (j & 1) * 4 + i] = a[i]; }
}
#define VAL64(d, lim, i) ((unsigned)((d) - (32 * ((i) >> 3) + ((i) & 7))) < (lim))
template <bool FULL> __device__ __forceinline__ void sm64(const float (&s)[16], int d, unsigned lim, float& m, float& l, f32x4 (&o)[4], bf16x8& pf0, bf16x8& pf1) {
    float mx = -1e30f;
#pragma unroll
    for (int i = 0; i < 16; i += 2) mx = fmax3(mx, (FULL || VAL64(d, lim, i)) ? s[i] : -1e30f, (FULL || VAL64(d, lim, i + 1)) ? s[i + 1] : -1e30f);
    mx = fmax2(mx, __shfl_xor(mx, 16)); mx = fmax2(mx, __shfl_xor(mx, 32));
    const float mn = fmax2(m, mx), alpha = ex2(m - mn);
    float pr[16], sum = 0.f;
#pragma unroll
    for (int i = 0; i < 16; ++i) { pr[i] = (FULL || VAL64(d, lim, i)) ? ex2(s[i] - mn) : 0.f; sum += pr[i]; }
    l = l * alpha + sum; m = mn;
#pragma unroll
    for (int dt = 0; dt < 4; ++dt) o[dt] = o[dt] * alpha;
    u32x4 w0, w1;
    w0.x = cvtpk(pr[0], pr[1]); w0.y = cvtpk(pr[2], pr[3]); w0.z = cvtpk(pr[4], pr[5]); w0.w = cvtpk(pr[6], pr[7]);
    w1.x = cvtpk(pr[8], pr[9]); w1.y = cvtpk(pr[10], pr[11]); w1.z = cvtpk(pr[12], pr[13]); w1.w = cvtpk(pr[14], pr[15]);
    pf0 = __builtin_bit_cast(bf16x8, w0); pf1 = __builtin_bit_cast(bf16x8, w1);
}
__device__ __forceinline__ void pv64(const bf16x8 (&v)[8], bf16x8 pf0, bf16x8 pf1, f32x4 (&o)[4]) {
#pragma unroll
    for (int dt = 0; dt < 4; ++dt) { o[dt] = mfma16(v[2 * dt], pf0, o[dt]); o[dt] = mfma16(v[2 * dt + 1], pf1, o[dt]); }
}
struct WinF { int kb0, tq, kq, s0; static constexpr unsigned LIM = 512u;
    __device__ __forceinline__ int kb(int i) const { return kb0 + 64 * i; }
    __device__ __forceinline__ bool full(int kbv) const { return kbv + 63 <= s0 && kbv > s0 + 15 - 512; }
    __device__ __forceinline__ int d(int kbv) const { return tq - kbv - 8 * kq; } };
struct SelF { int selv; int tq, kq, tqu; static constexpr unsigned LIM = 0x80000000u;
    __device__ __forceinline__ int kb(int i) const { return 64 * __builtin_amdgcn_readlane(selv, i); }
    __device__ __forceinline__ bool full(int kbv) const { return kbv + 63 <= tqu; }
    __device__ __forceinline__ int d(int kbv) const { return tq - kbv - 8 * kq; } };
template <class F> __device__ __forceinline__ void attn_blocks(const bf16_t* Kb, const bf16_t* Vt, int ldv, int n, const F& f, bf16x8 q0, bf16x8 q1, float& m, float& l, f32x4 (&o)[4], int lc, int kq, int krow0) {
    bf16x8 kA[8], kB[8], vA[8];
    int kbc = f.kb(0);
    load_k64(Kb, kbc, krow0, kq, kA);
#define ATT_STEP(KC, KN, idx) { \
        int kbn = kbc; const bool more = (idx) + 1 < n; \
        load_v64(Vt, ldv, kbc, lc, kq, vA); \
        if (more) { kbn = f.kb((idx) + 1); load_k64(Kb, kbn, krow0, kq, KN); } \
        __builtin_amdgcn_sched_barrier(0); \
        float s[16]; qk64(KC, q0, q1, s); bf16x8 pf0, pf1; if (f.full(kbc)) sm64<true>(s, 0, 0u, m, l, o, pf0, pf1); else sm64<false>(s, f.d(kbc), F::LIM, m, l, o, pf0, pf1); pv64(vA, pf0, pf1, o); kbc = kbn; __builtin_amdgcn_sched_barrier(0); }
#pragma unroll 1
    for (int i = 0; i < n; i += 2) {
        ATT_STEP(kA, kB, i)
        if (i + 1 < n) ATT_STEP(kB, kA, i + 1)
    }
#undef ATT_STEP
}
struct StgW { LAS unsigned char* gb; const bf16_t* kg; const bf16_t* vg; int wofs; };
__device__ __forceinline__ StgW stg_make(LAS unsigned char* stg, const bf16_t* Kb, const bf16_t* Vt, int ldv, int wave, int lane) {
    const int w4 = wave & 3, lr = lane >> 2, lcn = lane & 3; StgW w;
    w.gb = stg + (wave >> 2) * 36864; w.kg = Kb + (size_t)(16 * w4 + lr) * 64 + 16 * lcn; w.vg = Vt + (size_t)(16 * w4 + lr) * ldv + 16 * lcn; w.wofs = (16 * w4 + lr) * 144 + 32 * lcn; return w; }
__device__ __forceinline__ void stg_ldk(const StgW& w, int kb, u32x4& a, u32x4& b) { const bf16_t* kp = w.kg + (size_t)kb * 64; a = *(const u32x4*)kp; b = *(const u32x4*)(kp + 8); }
__device__ __forceinline__ void stg_ldv(const StgW& w, int kb, u32x4& a, u32x4& b) { const bf16_t* vp = w.vg + kb; a = *(const u32x4*)vp; b = *(const u32x4*)(vp + 8); }
__device__ __forceinline__ void stg_stk(const StgW& w, int buf, u32x4 a, u32x4 b) { LAS unsigned char* d = w.gb + buf * 18432 + w.wofs; *(LAS u32x4*)d = a; *(LAS u32x4*)(d + 16) = b; }
__device__ __forceinline__ void stg_stv(const StgW& w, int buf, u32x4 a, u32x4 b) { LAS unsigned char* d = w.gb + buf * 18432 + 9216 + w.wofs; *(LAS u32x4*)d = a; *(LAS u32x4*)(d + 16) = b; }
__device__ __forceinline__ void stg_rdk(const LAS unsigned char* b, int krow0, int kq, bf16x8 (&kf)[8]) {
#pragma unroll
    for (int j = 0; j < 4; ++j) { const LAS unsigned char* rp = b + (32 * (j >> 1) + 4 * (j & 1) + krow0) * 144 + 16 * kq; kf[2 * j] = *(const LAS bf16x8*)rp; kf[2 * j + 1] = *(const LAS bf16x8*)(rp + 64); }
}
__device__ __forceinline__ void stg_rdv(const LAS unsigned char* b, int lc, int kq, bf16x8 (&vf)[8]) {
#pragma unroll
    for (int dt = 0; dt < 4; ++dt) { const LAS unsigned char* rp = b + 9216 + (16 * dt + lc) * 144 + 16 * kq; vf[2 * dt] = *(const LAS bf16x8*)rp; vf[2 * dt + 1] = *(const LAS bf16x8*)(rp + 64); }
}
__device__ __forceinline__ void window_lds(LAS unsigned char* stg, const bf16_t* Kw, const bf16_t* Vw, int kb0, int n, int wave, int lane, int lc, int kq, int krow0, const WinF& wf,
                                           bf16x8 q0, bf16x8 q1, float& m, float& l, f32x4 (&o)[4]) {
    const int w4 = wave & 3;
    LAS unsigned char* gb = stg + (wave >> 2) * 36864;
    const int lr = lane >> 2, lcn = lane & 3;
    const bf16_t* kg = Kw + (size_t)(16 * w4 + lr) * 64 + 16 * lcn;
    const bf16_t* vg = Vw + (size_t)(16 * w4 + lr) * LDV + 16 * lcn;
    const int wofs = (16 * w4 + lr) * 144 + 32 * lcn;
    u32x4 pk0, pk1, pv0, pv1;
    { const bf16_t* kp = kg + (size_t)kb0 * 64; const bf16_t* vp = vg + kb0;
      pk0 = *(const u32x4*)kp; pk1 = *(const u32x4*)(kp + 8); pv0 = *(const u32x4*)vp; pv1 = *(const u32x4*)(vp + 8); }
    *(LAS u32x4*)(gb + wofs) = pk0; *(LAS u32x4*)(gb + wofs + 16) = pk1; *(LAS u32x4*)(gb + 9216 + wofs) = pv0; *(LAS u32x4*)(gb + 9216 + wofs + 16) = pv1;
    __syncthreads();
#pragma unroll 1
    for (int i = 0; i < n; ++i) {
        const int kbc = kb0 + 64 * i; const bool more = i + 1 < n;
        if (more) { const bf16_t* kp = kg + (size_t)(kbc + 64) * 64; const bf16_t* vp = vg + kbc + 64;
            pk0 = *(const u32x4*)kp; pk1 = *(const u32x4*)(kp + 8); pv0 = *(const u32x4*)vp; pv1 = *(const u32x4*)(vp + 8); }
        const LAS unsigned char* b = gb + (i & 1) * 18432;
        bf16x8 kf[8], vf[8];
#pragma unroll
        for (int j = 0; j < 4; ++j) { const LAS unsigned char* rp = b + (32 * (j >> 1) + 4 * (j & 1) + krow0) * 144 + 16 * kq; kf[2 * j] = *(const LAS bf16x8*)rp; kf[2 * j + 1] = *(const LAS bf16x8*)(rp + 64); }
#pragma unroll
        for (int dt = 0; dt < 4; ++dt) { const LAS unsigned char* rp = b + 9216 + (16 * dt + lc) * 144 + 16 * kq; vf[2 * dt] = *(const LAS bf16x8*)rp; vf[2 * dt + 1] = *(const LAS bf16x8*)(rp + 64); }
        float s[16]; qk64(kf, q0, q1, s); bf16x8 pf0, pf1;
        if (wf.full(kbc)) sm64<true>(s, 0, 0u, m, l, o, pf0, pf1); else sm64<false>(s, wf.d(kbc), WinF::LIM, m, l, o, pf0, pf1);
        pv64(vf, pf0, pf1, o);
        if (more) { LAS unsigned char* nb = gb + ((i + 1) & 1) * 18432;
            *(LAS u32x4*)(nb + wofs) = pk0; *(LAS u32x4*)(nb + wofs + 16) = pk1; *(LAS u32x4*)(nb + 9216 + wofs) = pv0; *(LAS u32x4*)(nb + 9216 + wofs + 16) = pv1; }
        __syncthreads();
    }
}
__device__ __forceinline__ void qk32(const bf16_t* k0p, const bf16_t* k1p, bf16x8 q0, bf16x8 q1, float (&s)[8]) {
    const bf16x8 ka = *(const bf16x8*)k0p, kb = *(const bf16x8*)(k0p + 32), kc = *(const bf16x8*)k1p, kd = *(const bf16x8*)(k1p + 32);
    f32x4 s0 = (f32x4){0.f, 0.f, 0.f, 0.f}, s1 = s0;
    s0 = mfma16(ka, q0, s0); s0 = mfma16(kb, q1, s0); s1 = mfma16(kc, q0, s1); s1 = mfma16(kd, q1, s1);
#pragma unroll
    for (int i = 0; i < 4; ++i) { s[i] = s0[i]; s[4 + i] = s1[i]; }
}
__device__ __forceinline__ bf16x8 sm_step(const float (&s)[8], int d2, float& m, float& l, f32x4 (&o)[4]) {
    float mx = -1e30f;
#pragma unroll
    for (int i = 0; i < 8; i += 2) mx = fmax3(mx, (i < d2) ? s[i] : -1e30f, (i + 1 < d2) ? s[i + 1] : -1e30f);
    mx = fmax2(mx, __shfl_xor(mx, 16)); mx = fmax2(mx, __shfl_xor(mx, 32));
    const float mn = fmax2(m, mx), alpha = ex2(m - mn);
    float pr[8], sum = 0.f;
#pragma unroll
    for (int i = 0; i < 8; ++i) { pr[i] = (i < d2) ? ex2(s[i] - mn) : 0.f; sum += pr[i]; }
    l = l * alpha + sum; m = mn;
#pragma unroll
    for (int dt = 0; dt < 4; ++dt) o[dt] = o[dt] * alpha;
    u32x4 w; w.x = cvtpk(pr[0], pr[1]); w.y = cvtpk(pr[2], pr[3]); w.z = cvtpk(pr[4], pr[5]); w.w = cvtpk(pr[6], pr[7]);
    return __builtin_bit_cast(bf16x8, w);
}
struct DsaL { bf16x8 ka, kb, kc, kd; u32x4 v0, v1, v2, v3; };
__device__ __forceinline__ void dsa_load(const unsigned short* idx, int sb, int krow0, int kq, int lane, const bf16_t* Kb, const bf16_t* Vb, DsaL& L) {
    const int i0 = idx[sb + krow0], i1 = idx[sb + krow0 + 4], vkey = idx[sb + (lane >> 1)];
    const bf16_t* k0p = Kb + (size_t)i0 * 64 + 8 * kq; const bf16_t* k1p = Kb + (size_t)i1 * 64 + 8 * kq;
    L.ka = *(const bf16x8*)k0p; L.kb = *(const bf16x8*)(k0p + 32); L.kc = *(const bf16x8*)k1p; L.kd = *(const bf16x8*)(k1p + 32);
    const bf16_t* vp = Vb + (size_t)vkey * 64 + (lane & 1) * 32;
    L.v0 = *(const u32x4*)vp; L.v1 = *(const u32x4*)(vp + 8); L.v2 = *(const u32x4*)(vp + 16); L.v3 = *(const u32x4*)(vp + 24);
}
__device__ __forceinline__ void dsa_compute(const DsaL& L, bf16x8 q0, bf16x8 q1, int d2, float& m, float& l, f32x4 (&o)[4], LAS unsigned char* vreg, int lane, int lc, int kq) {
    f32x4 s0 = (f32x4){0.f, 0.f, 0.f, 0.f}, s1 = s0;
    s0 = mfma16(L.ka, q0, s0); s0 = mfma16(L.kb, q1, s0); s1 = mfma16(L.kc, q0, s1); s1 = mfma16(L.kd, q1, s1);
    float s[8];
#pragma unroll
    for (int i = 0; i < 4; ++i) { s[i] = s0[i]; s[4 + i] = s1[i]; }
    const bf16x8 pf = sm_step(s, d2, m, l, o);
    LAS u32x4* wdst = (LAS u32x4*)(vreg + (lane >> 1) * 144 + (lane & 1) * 64);
    wdst[0] = L.v0; wdst[1] = L.v1; wdst[2] = L.v2; wdst[3] = L.v3;
    LDS_WAIT();
    const unsigned taddr = (unsigned)(size_t)vreg + (unsigned)((8 * kq + (lc >> 2)) * 144 + 8 * (lc & 3));
    u32x2 t0, t1, t2, t3, t4, t5, t6, t7;
    asm volatile("ds_read_b64_tr_b16 %0, %8\n\tds_read_b64_tr_b16 %1, %8 offset:576\n\tds_read_b64_tr_b16 %2, %8 offset:32\n\tds_read_b64_tr_b16 %3, %8 offset:608\n\t"
                 "ds_read_b64_tr_b16 %4, %8 offset:64\n\tds_read_b64_tr_b16 %5, %8 offset:640\n\tds_read_b64_tr_b16 %6, %8 offset:96\n\tds_read_b64_tr_b16 %7, %8 offset:672\n\ts_waitcnt lgkmcnt(0)"
                 : "=&v"(t0), "=&v"(t1), "=&v"(t2), "=&v"(t3), "=&v"(t4), "=&v"(t5), "=&v"(t6), "=&v"(t7) : "v"(taddr) : "memory");
    o[0] = mfma16(__builtin_bit_cast(bf16x8, (u32x4){t0.x, t0.y, t1.x, t1.y}), pf, o[0]);
    o[1] = mfma16(__builtin_bit_cast(bf16x8, (u32x4){t2.x, t2.y, t3.x, t3.y}), pf, o[1]);
    o[2] = mfma16(__builtin_bit_cast(bf16x8, (u32x4){t4.x, t4.y, t5.x, t5.y}), pf, o[2]);
    o[3] = mfma16(__builtin_bit_cast(bf16x8, (u32x4){t6.x, t6.y, t7.x, t7.y}), pf, o[3]);
}
__device__ __forceinline__ void attn_phase(KP p, LAS unsigned char* lds, int wv) {
    int tid_ = mk_tid(wv); asm volatile("" : "+v"(tid_)); const int tid = tid_, lane = tid & 63; int wave = wv; asm volatile("" : "+s"(wave));
    LAS float* imp = (LAS float*)lds;
    LAS float* obuf = (LAS float*)(lds + 65536);
    LAS int* sel = (LAS int*)(lds + 98304);
    const bf16_t* QA = (const bf16_t*)(p->ws + WS_QA); const bf16_t* QB = (const bf16_t*)(p->ws + WS_QB);
    const bf16_t* KA = (const bf16_t*)(p->ws + WS_KA); const bf16_t* VA = (const bf16_t*)(p->ws + WS_VA);
    const bf16_t* KS = (const bf16_t*)(p->ws + WS_KS); const bf16_t* KW = (const bf16_t*)(p->ws + WS_KW);
    const bf16_t* VST = (const bf16_t*)(p->ws + WS_VST); const bf16_t* VWT = (const bf16_t*)(p->ws + WS_VWT);
    const bf16_t* KC = (const bf16_t*)(p->ws + WS_KC); const bf16_t* VCT = (const bf16_t*)(p->ws + WS_VCT);
    const float* GATES = (const float*)(p->ws + WS_GATES);
    const unsigned short* IDX = (const unsigned short*)(p->ws + WS_IDX); const int* CNT = (const int*)(p->ws + WS_CNT);
    bf16_t* OA = (bf16_t*)(p->ws + WS_OA); bf16_t* OB = (bf16_t*)(p->ws + WS_OB);
    const int G_ = mk_grid(), bid_ = mk_bid();
    const bool aff = (G_ & 1) == 0;
    int* SELG = (int*)(p->ws + WS_SEL);
#pragma unroll 1
    for (int it_ = 0; ; ++it_) {
        int tile;
        if (aff) { const int hw = G_ >> 1, li = bid_ >> 1; if (it_ * hw >= T / 32) break; tile = (bid_ & 1) * (T / 32) + hw * it_ + ((it_ & 1) ? (hw - 1 - li) : li); }
        else { tile = bid_ + G_ * it_; if (tile >= T / 16) break; }
        const int tg0 = tile * 16, b = tg0 >> 13, s0 = tg0 & (S - 1);
        __syncthreads();
        for (int i = tid; i < 8 * 16 * 128; i += 512) imp[i] = 0.f;
        __syncthreads();
        {
            int l2_ = lane; asm volatile("" : "+v"(l2_)); const int lc = l2_ & 15, kq = l2_ >> 4, krow0 = 8 * (lc >> 2) + (lc & 3);
            const int h = wave, g = h >> 2, bg = b * 2 + g;
            const int tq = s0 + lc;
            const bf16_t* qrow = QB + (size_t)(tg0 + lc) * 512 + h * 64 + 8 * kq;
            const bf16x8 q0 = *(const bf16x8*)qrow, q1 = *(const bf16x8*)(qrow + 32);
            const float g0 = GATES[(size_t)(tg0 + lc) * 24 + h * 3 + 0], g2 = GATES[(size_t)(tg0 + lc) * 24 + h * 3 + 2];
            f32x4 oc[4], ow[4];
#pragma unroll
            for (int dt = 0; dt < 4; ++dt) { oc[dt] = (f32x4){0.f, 0.f, 0.f, 0.f}; ow[dt] = oc[dt]; }
            if (s0 + 15 >= 31) {
                const int cmax = (s0 + 15 - 31) >> 4;
                const bf16_t* Kc = KC + (size_t)bg * 512 * 64; const bf16_t* Vc = VCT + (size_t)bg * 64 * 512;
                const int cq = tq >= 31 ? (tq - 31) >> 4 : -1;
                const int nst = cmax / 64 + 1;
                float m = -1e30f, l = 0.f;
                const StgW sw = stg_make(lds + 65536, Kc, Vc, 512, wave, lane);
                {
                    u32x4 pk0, pk1;
                    stg_ldk(sw, 0, pk0, pk1); stg_stk(sw, 0, pk0, pk1);
                    __syncthreads();
#pragma unroll 1
                    for (int st = 0; st < nst; ++st) {
                        const bool more = st + 1 < nst;
                        if (more) stg_ldk(sw, 64 * (st + 1), pk0, pk1);
                        bf16x8 kf[8]; stg_rdk(sw.gb + (st & 1) * 18432, krow0, kq, kf);
                        float s[16]; qk64(kf, q0, q1, s); const int kb = 64 * st; float mx = -1e30f;
                        const int dd = cq - kb - 8 * kq;
#pragma unroll
                        for (int i = 0; i < 16; i += 2) mx = fmax3(mx, VAL64(dd, 0x80000000u, i) ? s[i] : -1e30f, VAL64(dd, 0x80000000u, i + 1) ? s[i + 1] : -1e30f);
                        mx = fmax2(mx, __shfl_xor(mx, 16)); mx = fmax2(mx, __shfl_xor(mx, 32));
                        const float mn = fmax2(m, mx); float sum = 0.f;
#pragma unroll
                        for (int i = 0; i < 16; ++i) sum += VAL64(dd, 0x80000000u, i) ? ex2(s[i] - mn) : 0.f;
                        l = l * ex2(m - mn) + sum; m = mn;
                        if (more) stg_stk(sw, (st + 1) & 1, pk0, pk1);
                        __syncthreads();
                    }
                }
                l += __shfl_xor(l, 16); l += __shfl_xor(l, 32);
                const float inv = l > 0.f ? 1.f / l : 0.f;
                float carry = 0.f;
                u32x4 pk0, pk1, pv0, pv1;
                stg_ldk(sw, 0, pk0, pk1); stg_ldv(sw, 0, pv0, pv1); stg_stk(sw, 0, pk0, pk1); stg_stv(sw, 0, pv0, pv1);
                __syncthreads();
#pragma unroll 1
                for (int st = 0; st < nst; ++st) {
                    const int kb = 64 * st; bf16x8 kA[8], vA[8]; float s[16], pr[16];
                    const bool more = st + 1 < nst;
                    if (more) { stg_ldk(sw, kb + 64, pk0, pk1); stg_ldv(sw, kb + 64, pv0, pv1); }
                    stg_rdk(sw.gb + (st & 1) * 18432, krow0, kq, kA); stg_rdv(sw.gb + (st & 1) * 18432, lc, kq, vA);
                    qk64(kA, q0, q1, s);
#pragma unroll
                    for (int i = 0; i < 16; ++i) pr[i] = VAL64(cq - kb - 8 * kq, 0x80000000u, i) ? ex2(s[i] - m) * inv : 0.f;
                    u32x4 w0, w1;
                    w0.x = cvtpk(pr[0], pr[1]); w0.y = cvtpk(pr[2], pr[3]); w0.z = cvtpk(pr[4], pr[5]); w0.w = cvtpk(pr[6], pr[7]);
                    w1.x = cvtpk(pr[8], pr[9]); w1.y = cvtpk(pr[10], pr[11]); w1.z = cvtpk(pr[12], pr[13]); w1.w = cvtpk(pr[14], pr[15]);
                    pv64(vA, __builtin_bit_cast(bf16x8, w0), __builtin_bit_cast(bf16x8, w1), oc);
#pragma unroll
                    for (int gr = 0; gr < 2; ++gr) {
                        const float p7 = pr[8 * gr + 7];
                        const float up = __shfl_up(p7, 16);
                        const float wrap = __shfl_down(p7, 48);
                        const float prev = kq == 0 ? carry : up;
                        carry = wrap;
                        const float e0 = (pr[8 * gr + 0] + pr[8 * gr + 1]) + (pr[8 * gr + 2] + pr[8 * gr + 3]) + prev;
                        const float e1 = (pr[8 * gr + 4] + pr[8 * gr + 5]) + (pr[8 * gr + 6] + pr[8 * gr + 7]) + pr[8 * gr + 3];
                        const int n0 = (kb + 32 * gr) / 4 + 2 * kq;
                        imp[(h * 16 + lc) * 128 + n0] = e0; imp[(h * 16 + lc) * 128 + n0 + 1] = e1;
                    }
                    if (more) { stg_stk(sw, (st + 1) & 1, pk0, pk1); stg_stv(sw, (st + 1) & 1, pv0, pv1); }
                    __syncthreads();
                }
            }
            {
                const bf16_t* Kw = KW + (size_t)bg * S * 64; const bf16_t* Vw = VWT + (size_t)bg * 64 * LDV;
                float m = -1e30f, l = 0.f;
                const int kb0 = s0 >= 512 ? s0 - 512 : 0;
                const WinF wf{kb0, tq, kq, s0};
                window_lds(lds + 65536, Kw, Vw, kb0, (s0 + 16 - kb0 + 63) >> 6, wave, lane, lc, kq, krow0, wf, q0, q1, m, l, ow);
                l += __shfl_xor(l, 16); l += __shfl_xor(l, 32);
                const float inv = l > 0.f ? g2 / l : 0.f;
#pragma unroll
                for (int dt = 0; dt < 4; ++dt) { const f32x4 o = oc[dt] * g0 + ow[dt] * inv; *(LAS f32x4*)(obuf + lc * 512 + h * 64 + 16 * dt + 4 * kq) = o; }
            }
        }
        __syncthreads();
#pragma unroll 1
        for (int rr = 0; rr < 4; ++rr) {
            const int row = wave * 4 + rr, q = row >> 1, g = row & 1, tq = s0 + q, cur = tq >> 6;
            LAS unsigned long long* kbuf = (LAS unsigned long long*)(lds + 100352 + wave * 1024);
            unsigned long long key[2];
#pragma unroll
            for (int hf = 0; hf < 2; ++hf) { const int n = lane + 64 * hf;
                float v = ((imp[((4 * g + 0) * 16 + q) * 128 + n] + imp[((4 * g + 1) * 16 + q) * 128 + n]) + imp[((4 * g + 2) * 16 + q) * 128 + n]) + imp[((4 * g + 3) * 16 + q) * 128 + n];
                if (n == 0 || n == cur) v = 1e4f; else if (64 * n > tq) v = -1.f;
                unsigned u = __builtin_bit_cast(unsigned, v); u = (u & 0x80000000u) ? ~u : (u | 0x80000000u);
                key[hf] = ((unsigned long long)u << 32) | (unsigned)(127 - n); }
            LDS_WAIT();
            kbuf[lane] = key[0]; kbuf[lane + 64] = key[1];
            LDS_WAIT();
            int r0 = 0, r1 = 0;
#pragma unroll 16
            for (int mI = 0; mI < 128; ++mI) { const unsigned long long k = kbuf[mI]; r0 += k > key[0] ? 1 : 0; r1 += k > key[1] ? 1 : 0; }
            if (r0 < 16) { sel[row * 16 + r0] = lane; SELG[((size_t)tile * 32 + row) * 16 + r0] = lane; }
            if (r1 < 16) { sel[row * 16 + r1] = lane + 64; SELG[((size_t)tile * 32 + row) * 16 + r1] = lane + 64; }
        }
        __syncthreads();
        {
            int l2_ = lane; asm volatile("" : "+v"(l2_)); const int lc = l2_ & 15, kq = l2_ >> 4, krow0 = 8 * (lc >> 2) + (lc & 3);
            const size_t tgA = (size_t)tg0 + wave * 2, tgB = tgA + 1;
            const bf16_t* qrA = QA + tgA * 512 + (lc & 7) * 64 + 8 * kq; const bf16_t* qrB = qrA + 512;
            const bf16x8 qA0 = *(const bf16x8*)qrA, qA1 = *(const bf16x8*)(qrA + 32), qB0 = *(const bf16x8*)qrB, qB1 = *(const bf16x8*)(qrB + 32);
            const int cntA = CNT[tgA], cntB = CNT[tgB], cmaxq = cntA > cntB ? cntA : cntB;
            const unsigned short* idxA = IDX + tgA * 256; const unsigned short* idxB = IDX + tgB * 256;
            const bf16_t* Kb = KA + (size_t)b * S * 64; const bf16_t* Vb = VA + (size_t)b * S * 64;
            LAS unsigned char* vregA = lds + 108544 + wave * 4608; LAS unsigned char* vregB = lds + wave * 4608;
            f32x4 oA[4], oB[4];
#pragma unroll
            for (int dt = 0; dt < 4; ++dt) { oA[dt] = (f32x4){0.f, 0.f, 0.f, 0.f}; oB[dt] = oA[dt]; }
            float mA = -1e30f, lA = 0.f, mB = -1e30f, lB = 0.f;
#pragma unroll 1
            for (int sb = 0; sb < 256; sb += 32) {
                if (sb >= cmaxq) break;
                DsaL LA, LB;
                dsa_load(idxA, sb, krow0, kq, lane, Kb, Vb, LA); dsa_load(idxB, sb, krow0, kq, lane, Kb, Vb, LB);
                __builtin_amdgcn_sched_barrier(0);
                dsa_compute(LA, qA0, qA1, cntA - sb - 8 * kq, mA, lA, oA, vregA, lane, lc, kq);
                dsa_compute(LB, qB0, qB1, cntB - sb - 8 * kq, mB, lB, oB, vregB, lane, lc, kq);
            }
            lA += __shfl_xor(lA, 16); lA += __shfl_xor(lA, 32); lB += __shfl_xor(lB, 16); lB += __shfl_xor(lB, 32);
            const float invA = lA > 0.f ? 1.f / lA : 0.f, invB = lB > 0.f ? 1.f / lB : 0.f;
            if (lc < 8) {
#pragma unroll
                for (int dt = 0; dt < 4; ++dt) { const f32x4 va = oA[dt] * invA, vb = oB[dt] * invB; u32x2 wa, wb; wa.x = pk2(va[0], va[1]); wa.y = pk2(va[2], va[3]); wb.x = pk2(vb[0], vb[1]); wb.y = pk2(vb[2], vb[3]);
                    *(u32x2*)(OA + tgA * 1024 + lc * 64 + 16 * dt + 4 * kq) = wa; *(u32x2*)(OA + tgB * 1024 + lc * 64 + 16 * dt + 4 * kq) = wb; }
            }
        }
        __syncthreads();
#pragma unroll
        for (int i = 0; i < 2; ++i) { const int e = (i * 512 + tid) * 8;
            const f32x4 a = *(const LAS f32x4*)(obuf + e), c = *(const LAS f32x4*)(obuf + e + 4);
            u32x4 w; w.x = pk2(a[0], a[1]); w.y = pk2(a[2], a[3]); w.z = pk2(c[0], c[1]); w.w = pk2(c[2], c[3]);
            *(u32x4*)(OA + (size_t)(tg0 + (e >> 9)) * 1024 + 512 + (e & 511)) = w; }
    }
}

struct SetSt { bf16x8 q0, q1; float m, l; f32x4 o[4]; unsigned long long mlo, mhi; int tq, tqmin; };
__device__ __forceinline__ void set_step(SetSt& st, const bf16x8 (&KC)[8], const bf16x8 (&vA)[8], int kbc, int kq) {
    const int n = kbc >> 6; const unsigned long long mw = n < 64 ? st.mlo : st.mhi; const bool mem = (mw >> (n & 63)) & 1ull;
    const unsigned long long bm = __ballot(mem);
    if (bm != 0ull) {
        float s[16]; qk64(KC, st.q0, st.q1, s); bf16x8 pf0, pf1;
        if (bm == ~0ull && kbc + 63 <= st.tqmin) sm64<true>(s, 0, 0u, st.m, st.l, st.o, pf0, pf1);
        else sm64<false>(s, mem ? st.tq - kbc - 8 * kq : -1, 0x80000000u, st.m, st.l, st.o, pf0, pf1);
        pv64(vA, pf0, pf1, st.o);
    }
}
__device__ __forceinline__ void attn_sel_phase_walk(KP p, LAS unsigned char* lds, int wv, const bool dummy, const bool nowrite = false) {
    int tid_ = mk_tid(wv); asm volatile("" : "+v"(tid_)); const int lane = tid_ & 63; int wave = wv; asm volatile("" : "+s"(wave));
    const bf16_t* QB = (const bf16_t*)(p->ws + WS_QB); const bf16_t* KS = (const bf16_t*)(p->ws + WS_KS); const bf16_t* VST = (const bf16_t*)(p->ws + WS_VST);
    const float* GATES = (const float*)(p->ws + WS_GATES); const int* SELG = (const int*)(p->ws + WS_SEL); bf16_t* OB = (bf16_t*)(p->ws + WS_OA);
    LAS int* list = (LAS int*)(lds + wave * 512);
    const int G_ = mk_grid(), bid_ = mk_bid();
    const bool aff2 = (G_ & 3) == 0 && ((T / 32) % (G_ >> 2)) == 0 && (((T / 32) / (G_ >> 2)) & 3) == 0;
    const int npass = aff2 ? ((T / 32) / (G_ >> 2)) / 4 : (T / 32 + G_ - 1) / G_;
#pragma unroll 1
    for (int ps = 0; ps < npass; ++ps) {
        int l2_ = lane; asm volatile("" : "+v"(l2_)); const int lc = l2_ & 15, kq = l2_ >> 4, krow0 = 8 * (lc >> 2) + (lc & 3);
        int tile, g, half;
        if (aff2) { const int nb = G_ >> 2, jb = bid_ >> 2, k = 4 * ps + (wave >> 1);
            tile = (bid_ & 1) * (T / 32) + nb * k + ((k & 1) ? (nb - 1 - jb) : jb); g = (bid_ >> 1) & 1; half = wave & 1; }
        else { const int tp = ps * G_ + ((ps & 1) ? (G_ - 1 - bid_) : bid_); if (tp >= T / 32) continue;
            tile = 2 * tp + (wave >> 2); g = (wave >> 1) & 1; half = wave & 1; }
        const int tg0 = tile * 16, b = tg0 >> 13, s0 = tg0 & (S - 1), bg = b * 2 + g, hh = 4 * g + (lc & 3);
        SetSt st[2];
#pragma unroll
        for (int si = 0; si < 2; ++si) {
            const int q = 8 * half + 4 * si + (lc >> 2), row = q * 2 + g;
            unsigned mk0 = 0u, mk1 = 0u, mk2 = 0u, mk3 = 0u;
            const int* sp = SELG + ((size_t)tile * 32 + row) * 16;
#pragma unroll
            for (int c4 = 0; c4 < 4; ++c4) { const u32x4 v = *(const u32x4*)(sp + 4 * c4); const unsigned va[4] = {v.x, v.y, v.z, v.w};
#pragma unroll
                for (int j = 0; j < 4; ++j) { const unsigned n = dummy ? 0u : va[j], bit = 1u << (n & 31u), w = n >> 5;
                    mk0 |= w == 0u ? bit : 0u; mk1 |= w == 1u ? bit : 0u; mk2 |= w == 2u ? bit : 0u; mk3 |= w == 3u ? bit : 0u; } }
            st[si].mlo = (unsigned long long)mk0 | ((unsigned long long)mk1 << 32); st[si].mhi = (unsigned long long)mk2 | ((unsigned long long)mk3 << 32);
            st[si].tq = s0 + q; st[si].tqmin = s0 + 8 * half + 4 * si;
            const bf16_t* qrow = QB + (size_t)(tg0 + q) * 512 + hh * 64 + 8 * kq;
            st[si].q0 = *(const bf16x8*)qrow; st[si].q1 = *(const bf16x8*)(qrow + 32);
            st[si].m = -1e30f; st[si].l = 0.f;
#pragma unroll
            for (int dt = 0; dt < 4; ++dt) st[si].o[dt] = (f32x4){0.f, 0.f, 0.f, 0.f};
        }
        unsigned long long Ulo = 0ull, Uhi = 0ull;
#pragma unroll
        for (int si = 0; si < 2; ++si)
#pragma unroll
            for (int j = 0; j < 4; ++j) {
                Ulo |= (unsigned long long)(unsigned)__builtin_amdgcn_readlane((int)(unsigned)st[si].mlo, 4 * j) | ((unsigned long long)(unsigned)__builtin_amdgcn_readlane((int)(unsigned)(st[si].mlo >> 32), 4 * j) << 32);
                Uhi |= (unsigned long long)(unsigned)__builtin_amdgcn_readlane((int)(unsigned)st[si].mhi, 4 * j) | ((unsigned long long)(unsigned)__builtin_amdgcn_readlane((int)(unsigned)(st[si].mhi >> 32), 4 * j) << 32);
            }
        LDS_WAIT();
        const unsigned long long ltm = (1ull << lane) - 1ull;
        const int c0 = __popcll(Ulo), cntu = c0 + __popcll(Uhi);
        if ((Ulo >> lane) & 1ull) list[__popcll(Ulo & ltm)] = lane;
        if ((Uhi >> lane) & 1ull) list[c0 + __popcll(Uhi & ltm)] = 64 + lane;
        LDS_WAIT();
        const int listv = list[lane], listv2 = list[64 + lane];
        LDS_WAIT();
        const bf16_t* Ks = KS + (size_t)bg * S * 64; const bf16_t* Vs = VST + (size_t)bg * 64 * LDV;
        {
            bf16x8 kA[8], kB[8], vA[8];
#define LISTKB(i) (64 * ((i) < 64 ? __builtin_amdgcn_readlane(listv, (i)) : __builtin_amdgcn_readlane(listv2, (i) - 64)))
            int kbc = LISTKB(0);
            load_k64(Ks, kbc, krow0, kq, kA);
#define SEL_STEP(KC, KN, idx) { \
            int kbn = kbc; const bool more = (idx) + 1 < cntu; \
            load_v64(Vs, LDV, kbc, lc, kq, vA); \
            if (more) { kbn = LISTKB((idx) + 1); load_k64(Ks, kbn, krow0, kq, KN); } \
            __builtin_amdgcn_sched_barrier(0); \
            set_step(st[0], KC, vA, kbc, kq); set_step(st[1], KC, vA, kbc, kq); \
            kbc = kbn; __builtin_amdgcn_sched_barrier(0); }
#pragma unroll 1
            for (int i = 0; i < cntu; i += 2) {
                SEL_STEP(kA, kB, i)
                if (i + 1 < cntu) SEL_STEP(kB, kA, i + 1)
            }
#undef SEL_STEP
#undef LISTKB
        }
#pragma unroll
        for (int si = 0; si < 2; ++si) {
            const int q = 8 * half + 4 * si + (lc >> 2);
            float l = st[si].l; l += __shfl_xor(l, 16); l += __shfl_xor(l, 32);
            const float g1 = GATES[(size_t)(tg0 + q) * 24 + hh * 3 + 1];
            const float inv = l > 0.f ? g1 / l : 0.f;
            if ((!dummy && !nowrite) || l == -1.f) {
#pragma unroll
                for (int dt = 0; dt < 4; ++dt) { bf16_t* dst = OB + (size_t)(tg0 + q) * 1024 + 512 + hh * 64 + 16 * dt + 4 * kq; const u32x2 ow = *(const u32x2*)dst;
                    const f32x4 v = st[si].o[dt] * inv; u32x2 w; w.x = pk2(bflo(ow.x) + v[0], bfhi(ow.x) + v[1]); w.y = pk2(bflo(ow.y) + v[2], bfhi(ow.y) + v[3]); *(u32x2*)dst = w; }
            }
        }
    }
}

__device__ __forceinline__ void attn_sel_phase(KP p, LAS unsigned char* lds, int wv, const bool dummy, const bool nowrite = false) {
    const int G_ = mk_grid(), bid_ = mk_bid();
    const bool aff2 = (G_ & 3) == 0 && ((T / 32) % (G_ >> 2)) == 0 && (((T / 32) / (G_ >> 2)) & 3) == 0;
    if (!aff2 || dummy) { attn_sel_phase_walk(p, lds, wv, dummy, nowrite); return; }
    int tid_ = mk_tid(wv); asm volatile("" : "+v"(tid_)); const int lane = tid_ & 63; int wave = wv; asm volatile("" : "+s"(wave));
    const bf16_t* QB = (const bf16_t*)(p->ws + WS_QB); const bf16_t* KS = (const bf16_t*)(p->ws + WS_KS); const bf16_t* VST = (const bf16_t*)(p->ws + WS_VST);
    const float* GATES = (const float*)(p->ws + WS_GATES); const int* SELG = (const int*)(p->ws + WS_SEL); bf16_t* OB = (bf16_t*)(p->ws + WS_OA);
    const int nb = G_ >> 2, jb = bid_ >> 2, b = bid_ & 1, g = (bid_ >> 1) & 1, bg = b * 2 + g;
    const int npass = ((T / 32) / nb) / 4;
    const bf16_t* Ks = KS + (size_t)bg * S * 64; const bf16_t* Vs = VST + (size_t)bg * 64 * LDV;
    const int srow = 8 * wave + (lane >> 3), sch = lane & 7;
    const bf16_t* kgp = Ks + (size_t)srow * 64 + 8 * sch;
    const bf16_t* vgp = Vs + (size_t)srow * LDV + 8 * sch;
    const int wofs = srow * 144 + 16 * sch;
#pragma unroll 1
    for (int ps = 0; ps < npass; ++ps) {
        int l2_ = lane; asm volatile("" : "+v"(l2_)); const int lc = l2_ & 15, kq = l2_ >> 4, krow0 = 8 * (lc >> 2) + (lc & 3);
        const int k = 4 * ps + (wave >> 1), half = wave & 1;
        const int tile = b * (T / 32) + nb * k + ((k & 1) ? (nb - 1 - jb) : jb);
        const int tg0 = tile * 16, s0 = tg0 & (S - 1), hh = 4 * g + (lc & 3);
        const int k3 = 4 * ps + 3, s0max = 16 * (nb * k3 + ((k3 & 1) ? (nb - 1 - jb) : jb));
        const int nsteps = ((s0max + 15) >> 6) + 1;
        SetSt st[2];
#pragma unroll
        for (int si = 0; si < 2; ++si) {
            const int q = 8 * half + 4 * si + (lc >> 2), row = q * 2 + g;
            unsigned mk0 = 0u, mk1 = 0u, mk2 = 0u, mk3 = 0u;
            const int* sp = SELG + ((size_t)tile * 32 + row) * 16;
#pragma unroll
            for (int c4 = 0; c4 < 4; ++c4) { const u32x4 v = *(const u32x4*)(sp + 4 * c4); const unsigned va[4] = {v.x, v.y, v.z, v.w};
#pragma unroll
                for (int j = 0; j < 4; ++j) { const unsigned n = va[j], bit = 1u << (n & 31u), w = n >> 5;
                    mk0 |= w == 0u ? bit : 0u; mk1 |= w == 1u ? bit : 0u; mk2 |= w == 2u ? bit : 0u; mk3 |= w == 3u ? bit : 0u; } }
            st[si].mlo = (unsigned long long)mk0 | ((unsigned long long)mk1 << 32); st[si].mhi = (unsigned long long)mk2 | ((unsigned long long)mk3 << 32);
            st[si].tq = s0 + q; st[si].tqmin = s0 + 8 * half + 4 * si;
            const bf16_t* qrow = QB + (size_t)(tg0 + q) * 512 + hh * 64 + 8 * kq;
            st[si].q0 = *(const bf16x8*)qrow; st[si].q1 = *(const bf16x8*)(qrow + 32);
            st[si].m = -1e30f; st[si].l = 0.f;
#pragma unroll
            for (int dt = 0; dt < 4; ++dt) st[si].o[dt] = (f32x4){0.f, 0.f, 0.f, 0.f};
        }
        unsigned long long Ulo = 0ull, Uhi = 0ull;
#pragma unroll
        for (int si = 0; si < 2; ++si)
#pragma unroll
            for (int j = 0; j < 4; ++j) {
                Ulo |= (unsigned long long)(unsigned)__builtin_amdgcn_readlane((int)(unsigned)st[si].mlo, 4 * j) | ((unsigned long long)(unsigned)__builtin_amdgcn_readlane((int)(unsigned)(st[si].mlo >> 32), 4 * j) << 32);
                Uhi |= (unsigned long long)(unsigned)__builtin_amdgcn_readlane((int)(unsigned)st[si].mhi, 4 * j) | ((unsigned long long)(unsigned)__builtin_amdgcn_readlane((int)(unsigned)(st[si].mhi >> 32), 4 * j) << 32);
            }
        u32x4 pk, pv;
        __syncthreads();
        pk = *(const u32x4*)kgp; pv = *(const u32x4*)vgp;
        *(LAS u32x4*)(lds + wofs) = pk; *(LAS u32x4*)(lds + 9216 + wofs) = pv;
        __syncthreads();
#pragma unroll 1
        for (int n = 0; n < nsteps; ++n) {
            const int kbc = 64 * n; const bool more = n + 1 < nsteps;
            if (more) { pk = *(const u32x4*)(kgp + (size_t)(kbc + 64) * 64); pv = *(const u32x4*)(vgp + kbc + 64); }
            const bool mine = ((n < 64 ? Ulo : Uhi) >> (n & 63)) & 1ull;
            if (mine) {
                const LAS unsigned char* bb = lds + (n & 1) * 18432;
                bf16x8 kf[8], vf[8]; stg_rdk(bb, krow0, kq, kf); stg_rdv(bb, lc, kq, vf);
                set_step(st[0], kf, vf, kbc, kq); set_step(st[1], kf, vf, kbc, kq);
            }
            if (more) { LAS unsigned char* nbuf = lds + ((n + 1) & 1) * 18432; *(LAS u32x4*)(nbuf + wofs) = pk; *(LAS u32x4*)(nbuf + 9216 + wofs) = pv; }
            __syncthreads();
        }
#pragma unroll
        for (int si = 0; si < 2; ++si) {
            const int q = 8 * half + 4 * si + (lc >> 2);
            float l = st[si].l; l += __shfl_xor(l, 16); l += __shfl_xor(l, 32);
            const float g1 = GATES[(size_t)(tg0 + q) * 24 + hh * 3 + 1];
            const float inv = l > 0.f ? g1 / l : 0.f;
            if (!nowrite || l == -1.f) {
#pragma unroll
                for (int dt = 0; dt < 4; ++dt) { bf16_t* dst = OB + (size_t)(tg0 + q) * 1024 + 512 + hh * 64 + 16 * dt + 4 * kq; const u32x2 ow = *(const u32x2*)dst;
                    const f32x4 v = st[si].o[dt] * inv; u32x2 w; w.x = pk2(bflo(ow.x) + v[0], bfhi(ow.x) + v[1]); w.y = pk2(bflo(ow.y) + v[2], bfhi(ow.y) + v[3]); *(u32x2*)dst = w; }
            }
        }
    }
}

#define XB_TMO      128
#define XB_XCNT(j)  (256  + 64 * (j))
#define XB_XSUB(j)  (1280 + 64 * (j))
#define XB_XGEN(j)  (2304 + 64 * (j))
#define XB_TOP      3328
#define XB_TOPGEN   3392
#define XCD_BAR_WORDS 3456
#define XB_SPIN_CAP (1u << 18)

__device__ __forceinline__ unsigned xb_ld(unsigned* p)              { return __hip_atomic_load(p, __ATOMIC_RELAXED, __HIP_MEMORY_SCOPE_AGENT); }
__device__ __forceinline__ unsigned xb_add(unsigned* p, unsigned v) { return __hip_atomic_fetch_add(p, v, __ATOMIC_RELAXED, __HIP_MEMORY_SCOPE_AGENT); }
__device__ __forceinline__ unsigned xb_xcc_id() { return (unsigned)__builtin_amdgcn_s_getreg((3 << 11) | 20) & 0xFu; }
#define XB_SPIN(cond, bar) do { unsigned _sp = 0; while (cond) { __builtin_amdgcn_s_sleep(1); \
    if ((++_sp & 255u) == 0u) { if (xb_ld(&(bar)[XB_TMO])) break; if (_sp > XB_SPIN_CAP) { atomicAdd(&(bar)[XB_TMO], 1u); break; } } } } while (0)

struct XcdBarrier {
    unsigned* bar; unsigned x;
    volatile LAS unsigned* st;
};

__device__ __forceinline__ XcdBarrier xcd_barrier_post(unsigned* bar, volatile LAS unsigned* st, int tid) {
    XcdBarrier b; b.bar = bar; b.x = xb_xcc_id(); b.st = st;
    if (tid == 0) (void)xb_add(&bar[XB_XCNT(b.x)], 1u);
    return b;
}
__device__ __forceinline__ void xcd_barrier_complete(unsigned* bar, unsigned x, unsigned& nloc, unsigned& nx) {
    const unsigned G = gridDim.x * gridDim.y * gridDim.z;
    unsigned sum, cnt, mine, sp = 0u;
    for (;;) {
        sum = 0u; cnt = 0u; mine = 0u;
#pragma unroll
        for (unsigned j = 0; j < 16; ++j) { const unsigned c = xb_ld(&bar[XB_XCNT(j)]); sum += c; cnt += (c > 0u) ? 1u : 0u; mine = (j == x) ? c : mine; }
        if (sum == G) break;
        __builtin_amdgcn_s_sleep(1);
        if ((++sp & 255u) == 0u) { if (xb_ld(&bar[XB_TMO])) break; if (sp > XB_SPIN_CAP) { atomicAdd(&bar[XB_TMO], 1u); break; } }
    }
    nloc = mine > 0u ? mine : 1u; nx = cnt > 0u ? cnt : 1u;
}

__device__ __forceinline__ void xcd_barrier(const XcdBarrier& b, int tid) {
    asm volatile("s_waitcnt vmcnt(0)" ::: "memory");
    __syncthreads();
    if (tid == 0) {
        unsigned* bar = b.bar;
        __builtin_amdgcn_s_waitcnt(0);
        unsigned nloc = b.st[0], nx = b.st[1];
        if (nloc == 0u) { xcd_barrier_complete(bar, b.x, nloc, nx); b.st[0] = nloc; b.st[1] = nx; }
        const unsigned old = xb_add(&bar[XB_XSUB(b.x)], 1u);
        const unsigned gen = old / nloc;
        if (old + 1u == (gen + 1u) * nloc) {
            __builtin_amdgcn_fence(__ATOMIC_RELEASE, "agent");
            asm volatile("s_waitcnt vmcnt(0)" ::: "memory");
            const unsigned og = xb_add(&bar[XB_TOP], 1u);
            const unsigned tg = og / nx;
            if (og + 1u == (tg + 1u) * nx) xb_add(&bar[XB_TOPGEN], 1u);
            else XB_SPIN(xb_ld(&bar[XB_TOPGEN]) == tg, bar);
            __builtin_amdgcn_fence(__ATOMIC_ACQUIRE, "agent");
            xb_add(&bar[XB_XGEN(b.x)], 1u);
            asm volatile("s_waitcnt vmcnt(0)" ::: "memory");
        } else {
            XB_SPIN(xb_ld(&bar[XB_XGEN(b.x)]) == gen, bar);
            __builtin_amdgcn_fence(__ATOMIC_ACQUIRE, "agent");
            asm volatile("s_waitcnt vmcnt(0)" ::: "memory");
        }
    }
    __syncthreads();
}

__global__ void __launch_bounds__(512, 2) mk_fwd(P pv) {
    extern __shared__ __attribute__((aligned(16))) unsigned char lds_raw[];
    LAS unsigned char* lds = (LAS unsigned char*)lds_raw;
    cg::grid_group grid = cg::this_grid();
    const int wv = __builtin_amdgcn_readfirstlane((int)(threadIdx.x >> 6));
    if (threadIdx.x < 2) ((LAS unsigned*)(lds + LDS_BARST))[threadIdx.x] = 0u;
    __syncthreads();
    (void)xcd_barrier_post((unsigned*)(pv.ws + WS_BAR), (volatile LAS unsigned*)(lds + LDS_BARST), (int)threadIdx.x);
#define GRID_BAR() do { KP pb_ = (KP)__builtin_amdgcn_kernarg_segment_ptr(); asm volatile("" : "+s"(pb_)); XcdBarrier xb_; xb_.bar = (unsigned*)(pb_->ws + WS_BAR); xb_.x = xb_xcc_id(); xb_.st = (volatile LAS unsigned*)(lds + LDS_BARST); xcd_barrier(xb_, mk_tid(wv)); } while (0)
    for (int ph = pv.ph_lo; ph < pv.ph_hi; ++ph) {
        if (ph > pv.ph_lo) { if (ph == 1) grid.sync(); else GRID_BAR(); }
        KP p = (KP)__builtin_amdgcn_kernarg_segment_ptr();
        asm volatile("" : "+s"(p));
        unsigned char* ws = p->ws;
        float* X = (float*)(ws + WS_X); float* SS = (float*)(ws + WS_SSP);
        bf16_t* XG = (bf16_t*)(ws + WS_XG); bf16_t* XGB = (bf16_t*)(ws + WS_XGB);
        bf16_t* Z = (bf16_t*)(ws + WS_Z); bf16_t* U = (bf16_t*)(ws + WS_U); bf16_t* PP = (bf16_t*)(ws + WS_PP); bf16_t* MERGED = (bf16_t*)(ws + WS_MERGED);
        const float* BIAS = (const float*)(ws + WS_BIAS);
#if defined(PROBE_SYNC)
        if (ph == 1) { for (int i_ = 0; i_ < 50; ++i_) GRID_BAR(); }
#endif
        if (ph == 0) { prologue_phase(p, lds, wv);
#if defined(PROBE_PRO2)
            prologue_phase(p, lds, wv);
#endif
            continue; }
        if (ph == NPH - 1) {
            const float* ssf = SS + (size_t)16 * T * 16; const float* gf = p->in[25];
            for (int o = mk_bid() * 512 + mk_tid(wv); o < T * D / 4; o += mk_grid() * 512) {
                const int r = o >> 8, c = (o & 255) * 4; const float rs = row_rs(ssf, r);
                const f32x4 v = *(const f32x4*)(X + (size_t)o * 4), g = *(const f32x4*)(gf + c);
                *(f32x4*)(p->out + (size_t)o * 4) = v * rs * g;
            }
            continue;
        }
        const int L = (ph - 1) / 12, j = (ph - 1) % 12;
        const bf16_t* WB = (const bf16_t*)(ws + ((L & 1) ? WS_WB1 : WS_WB0));
        switch (j) {
        case 0: {
            EpiSwiglu E{U, SS + (size_t)(4 * L + 0) * T * 16};
            run_gemm(lds, L == 0 ? XG : XGB, D, WB + WO_13A, T, 2 * FF, D, 0, E, wv);
#if defined(PROBE_GEMM2)
            run_gemm(lds, L == 0 ? XG : XGB, D, WB + WO_13A, T, 2 * FF, D, 0, E, wv);
#endif
        } break;
        case 1: {
            EpiResid<0> E{L == 0 ? p->in[0] : X, X, XG, p->in[6] + L * D, SS + (size_t)(4 * L + 1) * T * 16, 0.5f, nullptr, nullptr};
            run_gemm(lds, U, FF, WB + WO_2A, T, D, FF, 0, E, wv);
        } break;
        case 2: {
            EpiRow<0> E{Z, NZ, SS + (size_t)(4 * L + 1) * T * 16, nullptr, nullptr, 0};
            run_gemm(lds, XG, D, WB + WO_IN, T, NZ, D, 0, E, wv);
#if defined(PROBE_G_IN)
            run_gemm(lds, XG, D, WB + WO_IN, T, NZ, D, 0, E, wv);
#endif
        } break;
        case 3: post_phase(p, lds, wv);
#if defined(PROBE_MISC2)
            post_phase(p, lds, wv);
#endif
            break;
        case 4: {
            EpiRow<1> Ek{(bf16_t*)(ws + WS_HIDK), 256, nullptr, BIAS, nullptr, 0};
            run_gemm(lds, (const bf16_t*)(ws + WS_KCMP), 1024, WB + WO_CK, 2048, 256, 2048, 0, Ek, wv);
            EpiRow<1> Ev{(bf16_t*)(ws + WS_HIDV), 256, nullptr, BIAS + 256, nullptr, 0};
            run_gemm(lds, (const bf16_t*)(ws + WS_VCMP), 1024, WB + WO_CV, 2048, 256, 2048, 8, Ev, wv);
            indexer_phase(p, lds, L, wv, 0);
#if defined(PROBE_IDX2)
            indexer_phase(p, lds, L, wv, 32);
#endif
#if defined(PROBE_IDXSCORE)
            indexer_phase(p, lds, L, wv, 32, true);
#endif
        } break;
        case 5: {
            cmp2_phase(p, L, wv);
            if (L + 1 < DEPTH) convert_layer(p, L + 1, (bf16_t*)(ws + (((L + 1) & 1) ? WS_WB1 : WS_WB0)), lds, wv);
#if defined(PROBE_MISC2)
            cmp2_phase(p, L, wv);
            if (L + 1 < DEPTH) convert_layer(p, L + 1, (bf16_t*)(ws + (((L + 1) & 1) ? WS_WB1 : WS_WB0)), lds, wv);
#endif
        } break;
        case 6: attn_phase(p, lds, wv);
#if defined(PROBE_ATTNA2)
            attn_phase(p, lds, wv);
#endif
            GRID_BAR();
            attn_sel_phase(p, lds, wv, false);
#if defined(PROBE_SELDUMMY)
            attn_sel_phase(p, lds, wv, true);
#endif
#if defined(PROBE_SEL2)
            attn_sel_phase(p, lds, wv, false, true);
#endif
            break;
        case 7: {
            EpiMerge E{MERGED, Z};
            run_gemm(lds, (const bf16_t*)(ws + WS_OA), 1024, WB + WO_PA, T, 2048, 1024, 0, E, wv);
        } break;
        case 8: {
            EpiResid<0> E{X, X, XG, p->in[18] + L * D, SS + (size_t)(4 * L + 2) * T * 16, 1.0f, nullptr, nullptr};
            run_gemm(lds, MERGED, D, WB + WO_WO, T, D, D, 0, E, wv);
        } break;
        case 9: {
            EpiSwiglu E{U, SS + (size_t)(4 * L + 2) * T * 16};
            run_gemm(lds, XG, D, WB + WO_13B, T, 2 * FF, D, 0, E, wv);
            EpiRow<2> Ep{PP, D, nullptr, nullptr, nullptr, 0};
            run_gemm(lds, (const bf16_t*)(ws + WS_PBF) + (size_t)(L & 1) * T * PLE, PLE, WB + WO_PP, T, D, PLE, 0, Ep, wv);
        } break;
        case 10: {
            EpiResid<0> E{X, X, XG, p->in[22] + L * D, SS + (size_t)(4 * L + 3) * T * 16, 0.5f, nullptr, nullptr};
            run_gemm(lds, U, FF, WB + WO_2B, T, D, FF, 0, E, wv);
        } break;
        case 11: {
            EpiResid<1> E{X, X, XGB, L + 1 < DEPTH ? p->in[2] + (L + 1) * D : p->in[25], SS + (size_t)(4 * L + 4) * T * 16, 1.0f, SS + (size_t)(4 * L + 3) * T * 16, PP};
            run_gemm(lds, XG, D, WB + WO_PG, T, D, D, 0, E, wv);
        } break;
        }
    }
}

extern "C" void kernel_launch(void* const* d_in, const int* in_sizes, int n_in, void* d_out, int out_size, void* d_ws, size_t ws_size, hipStream_t stream) {
    static int grid = 0;
    if (grid == 0) {
        if (n_in != 26 || ws_size < WS_END) { fprintf(stderr, "kernel_launch: unexpected n_in %d / ws %zu\n", n_in, ws_size); grid = -1; return; }
        int dev = 0, cus = 0, per_cu = 0;
        hipGetDevice(&dev); hipDeviceGetAttribute(&cus, hipDeviceAttributeMultiprocessorCount, dev);
        if (hipFuncSetAttribute((const void*)mk_fwd, hipFuncAttributeMaxDynamicSharedMemorySize, LDS_BYTES) != hipSuccess) { fprintf(stderr, "hipFuncSetAttribute failed\n"); grid = -1; return; }
        if (hipOccupancyMaxActiveBlocksPerMultiprocessor(&per_cu, (const void*)mk_fwd, 512, LDS_BYTES) != hipSuccess || per_cu < 1) { fprintf(stderr, "occupancy query: %d\n", per_cu); per_cu = 1; }
        (void)hipGetLastError();
        grid = cus * 1;
    }
    if (grid < 0) return;
    hipMemsetAsync((char*)d_ws + WS_CTL, 0, CTL_BYTES, stream);
    P a{};
    for (int i = 0; i < 26; ++i) a.in[i] = (const float*)d_in[i];
    a.out = (float*)d_out; a.ws = (unsigned char*)d_ws;
#if MK_MULTI
    for (int ph = 0; ph < NPH; ++ph) { a.ph_lo = ph; a.ph_hi = ph + 1; hipLaunchKernelGGL(mk_fwd, dim3(grid), dim3(512), LDS_BYTES, stream, a); }
#else
    a.ph_lo = 0; a.ph_hi = NPH;
    void* args[] = {&a};
    hipError_t e = hipLaunchCooperativeKernel((const void*)mk_fwd, dim3(grid), dim3(512), args, LDS_BYTES, stream);
    if (e != hipSuccess) fprintf(stderr, "cooperative launch failed: %s (grid %d)\n", hipGetErrorString(e), grid);
#endif
}
```

```cpp
#include <hip/hip_runtime.h>
#include <hip/hip_cooperative_groups.h>
#include <cstdio>
#include <cstdint>
namespace cg = cooperative_groups;
#ifndef MK_MULTI
#define MK_MULTI 0
#endif
__device__ __forceinline__ int mk_tid(int wv) { int lane; asm volatile("v_mbcnt_lo_u32_b32 %0, -1, 0\n\tv_mbcnt_hi_u32_b32 %0, -1, %0" : "=v"(lane)); return lane + 64 * wv; }
__device__ __forceinline__ int mk_bid() { int b = blockIdx.x; asm volatile("" : "+s"(b)); return b; }
__device__ __forceinline__ int mk_grid() { int g = gridDim.x; asm volatile("" : "+s"(g)); return g; }
namespace pg8 {
#define PG8_LAS __attribute__((address_space(3)))
typedef unsigned short bf16_t;
typedef short bf16x8 __attribute__((ext_vector_type(8)));
typedef float f32x4 __attribute__((ext_vector_type(4)));
typedef unsigned u32x4 __attribute__((ext_vector_type(4)));
constexpr int BM = 256, BK = 64, HALF = 128, HTB = HALF * BK * 2  , STAGE_BYTES = 8 * HTB, NXCD = 8, WGM = 8;

__host__ __device__ __forceinline__ int lds_byte(int r, int c) { const int st = (r >> 4) * 2 + (c >> 5), rr = r & 15, cc = c & 31, ob = rr * 64 + cc * 2; return st * 1024 + (ob ^ (((ob >> 9) & 1) << 5)); }
__host__ __device__ __forceinline__ void stage_rc(int b, int& R, int& C) { const int st = b / 1024, sb = b % 1024, swz = sb ^ (((sb >> 9) & 1) << 5); R = (st >> 1) * 16 + swz / 64; C = (st & 1) * 32 + (swz % 64) / 2; }
__host__ __device__ __forceinline__ int perm32(int rho) { const int n = rho >> 4, i = rho & 15; return 8 * (i >> 2) + 4 * n + (i & 3); }

struct Unit { int pm, pn; };
struct Gemm { const bf16_t* A; const bf16_t* Bt; int M, N, K, lda; };

struct StaticOrder {
    int nM, nN, nwg, G, c;
    __host__ __device__ void init(int M, int N, int G_, int c_) { nM = M / BM; nN = N / BM; nwg = nM * nN; G = G_; c = c_; }
    __host__ __device__ bool next(int i, Unit& u) const {
        const long L = (long)i * G + c; if (L >= nwg) return false;
        int wgid = (int)L; { const int q = nwg / NXCD, r = nwg % NXCD, xcd = wgid % NXCD, off = wgid / NXCD; wgid = (xcd < r ? xcd * (q + 1) : r * (q + 1) + (xcd - r) * q) + off; }
        const int nig = WGM * nN, gid = wgid / nig, fm = gid * WGM, gsz = (nM - fm) < WGM ? (nM - fm) : WGM;
        u.pm = fm + ((wgid % nig) % gsz); u.pn = (wgid % nig) / gsz; return true;
    }
    __device__ __forceinline__ void a_ready(const Unit&) const {}
    __device__ __forceinline__ void done(const Unit&) const {}
};

__device__ __forceinline__ unsigned cvt_pk_bf16(float lo, float hi) { unsigned r; asm volatile("v_cvt_pk_bf16_f32 %0, %1, %2" : "=v"(r) : "v"(lo), "v"(hi)); return r; }
typedef float f32x2 __attribute__((ext_vector_type(2)));
template <class Epi, class Sched, bool ALIGN_EPI = false, bool SP2 = false>
__device__ __forceinline__ void gemm_phase(PG8_LAS unsigned char* lds, const Gemm g, const Sched& S, const Epi& E, int wv) {
    int wv_ = wv; asm volatile("" : "+s"(wv_)); int tid_ = mk_tid(wv_); asm volatile("" : "+v"(tid_)); const int tid = tid_, wid = wv_, lane = tid & 63, wr = wid >> 2, wc = wid & 3, fr = lane & 15, fq = lane >> 4;
    const int K = g.K, nt = K / BK;
    unsigned voffA[2], voffB[2];
#pragma unroll
    for (int i = 0; i < 2; ++i) { int R, C; stage_rc(tid * 16 + i * 8192, R, C); const int Rb = Epi::PERM ? ((R & ~31) + perm32(R & 31)) : R;
        voffA[i] = (unsigned)(R * g.lda + C) * 2u; voffB[i] = (unsigned)(Rb * K + C) * 2u; }
    const size_t kstep = (size_t)(BK * 2);
    const size_t hstepB = (size_t)HALF * K * 2, hstepA = (size_t)HALF * g.lda * 2;
    const size_t tstepA = 2 * hstepA, tstepB = 2 * hstepB;
    const unsigned ldsw = (unsigned)wid * 1024u;
    const int aoff = lds_byte(wr * 64 + fr, fq * 8), boff = lds_byte(wc * 32 + fr, fq * 8);
#define PG8_SA(b, h) (((b) * 2 + (h)) * HTB)
#define PG8_SB(b, h) ((4 + (b) * 2 + (h)) * HTB)
#define PG8_STAGE(bufoff, gbase, voff) do { _Pragma("unroll") for (int _i = 0; _i < 2; ++_i) \
        __builtin_amdgcn_global_load_lds((const unsigned*)((const char*)(gbase) + (voff)[_i]), (PG8_LAS unsigned*)(lds + (bufoff) + ldsw + _i * 8192), 16, 0, 0); } while (0)
#define PG8_LDA(dst, b, h) do { _Pragma("unroll") for (int m = 0; m < 4; ++m) _Pragma("unroll") for (int k = 0; k < 2; ++k) dst[m][k] = *(const PG8_LAS bf16x8*)(lds + PG8_SA(b, h) + aoff + m * 2048 + k * 1024); } while (0)
#define PG8_LDB(dst, b, h) do { _Pragma("unroll") for (int n = 0; n < 2; ++n) _Pragma("unroll") for (int k = 0; k < 2; ++k) dst[n][k] = *(const PG8_LAS bf16x8*)(lds + PG8_SB(b, h) + boff + n * 2048 + k * 1024); } while (0)
#define PG8_MMA(ai, bj, At, Bt) do { __builtin_amdgcn_s_setprio(1); _Pragma("unroll") for (int m = 0; m < 4; ++m) _Pragma("unroll") for (int n = 0; n < 2; ++n) _Pragma("unroll") for (int k = 0; k < 2; ++k) \
        acc[ai][bj][m][n] = __builtin_amdgcn_mfma_f32_16x16x32_bf16(Bt[n][k], At[m][k], acc[ai][bj][m][n], 0, 0, 0); __builtin_amdgcn_s_setprio(0); } while (0)
#define PG8_WAIT_V(n) asm volatile("s_waitcnt vmcnt(" #n ")" ::: "memory")
#define PG8_WAIT_L(n) asm volatile("s_waitcnt lgkmcnt(" #n ")" ::: "memory")
#define PG8_BAR __builtin_amdgcn_s_barrier()
#define PG8_SCHED __builtin_amdgcn_sched_barrier(0)
    Unit cur, nxt; int ui = 0;
    if (!S.next(0, cur)) return;
    f32x4 acc[2][2][4][2];
#pragma unroll
    for (int a = 0; a < 2; ++a)
#pragma unroll
        for (int b = 0; b < 2; ++b)
#pragma unroll
            for (int m = 0; m < 4; ++m)
#pragma unroll
                for (int n = 0; n < 2; ++n) acc[a][b][m][n] = (f32x4){0.f, 0.f, 0.f, 0.f};
    bf16x8 At[4][2], B0[2][2], B1[2][2];
    const char* cA = (const char*)g.A + (size_t)cur.pm * tstepA; const char* cB = (const char*)g.Bt + (size_t)cur.pn * tstepB;
    S.a_ready(cur);
    if constexpr (SP2) {
        PG8_STAGE(PG8_SB(0, 0), cB, voffB); PG8_STAGE(PG8_SB(0, 1), cB + hstepB, voffB); PG8_STAGE(PG8_SA(0, 0), cA, voffA); PG8_STAGE(PG8_SA(0, 1), cA + hstepA, voffA);
        if (wr == 1) PG8_BAR;
        PG8_WAIT_V(2); PG8_BAR;
        PG8_STAGE(PG8_SB(1, 0), cB + kstep, voffB); PG8_STAGE(PG8_SA(1, 0), cA + kstep, voffA); PG8_STAGE(PG8_SB(1, 1), cB + hstepB + kstep, voffB);
        PG8_WAIT_V(6); PG8_BAR;
    } else {
        PG8_STAGE(PG8_SB(0, 0), cB, voffB); PG8_STAGE(PG8_SA(0, 0), cA, voffA); PG8_STAGE(PG8_SB(0, 1), cB + hstepB, voffB); PG8_STAGE(PG8_SA(0, 1), cA + hstepA, voffA);
        if (wr == 1) PG8_BAR;
        PG8_WAIT_V(4); PG8_BAR;
        PG8_STAGE(PG8_SB(1, 0), cB + kstep, voffB); PG8_STAGE(PG8_SA(1, 0), cA + kstep, voffA); PG8_STAGE(PG8_SB(1, 1), cB + hstepB + kstep, voffB);
        PG8_WAIT_V(6); PG8_BAR;
    }
    for (;;) {
        const bool has_next = S.next(ui + 1, nxt);
        const char* nA = has_next ? (const char*)g.A + (size_t)nxt.pm * tstepA : cA; const char* nB = has_next ? (const char*)g.Bt + (size_t)nxt.pn * tstepB : cB;
        for (int t = 0; t < nt; t += 2) {
            const bool last = (t == nt - 2);
            const char* a1 = cA + (size_t)(t + 1) * kstep;
            const char* a2 = last ? nA : cA + (size_t)(t + 2) * kstep; const char* b2 = last ? nB : cB + (size_t)(t + 2) * kstep;
            const char* a3 = a2 + kstep; const char* b3 = b2 + kstep;
            if (last && has_next) S.a_ready(nxt);
            if constexpr (SP2) {
            PG8_LDB(B0, 0, 0); PG8_LDB(B1, 0, 1); PG8_SCHED; PG8_LDA(At, 0, 0); PG8_STAGE(PG8_SA(1, 1), a1 + hstepA, voffA);
            PG8_WAIT_V(8); PG8_WAIT_L(0); PG8_BAR; PG8_MMA(0, 0, At, B0); PG8_MMA(0, 1, At, B1); PG8_BAR; PG8_SCHED;
            PG8_LDA(At, 0, 1); PG8_STAGE(PG8_SB(0, 0), b2, voffB); PG8_STAGE(PG8_SB(0, 1), b2 + hstepB, voffB); PG8_STAGE(PG8_SA(0, 0), a2, voffA);
            PG8_WAIT_V(8); PG8_WAIT_L(0); PG8_BAR; PG8_MMA(1, 0, At, B0); PG8_MMA(1, 1, At, B1); PG8_BAR; PG8_SCHED;
            PG8_LDB(B0, 1, 0); PG8_LDB(B1, 1, 1); PG8_SCHED; PG8_LDA(At, 1, 0); PG8_STAGE(PG8_SA(0, 1), a2 + hstepA, voffA);
            PG8_WAIT_V(8); PG8_WAIT_L(0); PG8_BAR; PG8_MMA(0, 0, At, B0); PG8_MMA(0, 1, At, B1); PG8_BAR; PG8_SCHED;
            PG8_LDA(At, 1, 1); PG8_STAGE(PG8_SB(1, 0), b3, voffB); PG8_STAGE(PG8_SB(1, 1), b3 + hstepB, voffB); PG8_STAGE(PG8_SA(1, 0), a3, voffA);
            PG8_WAIT_V(8); PG8_WAIT_L(0); PG8_BAR; PG8_MMA(1, 0, At, B0); PG8_MMA(1, 1, At, B1); PG8_BAR; PG8_SCHED;
            } else {
            PG8_LDB(B0, 0, 0); PG8_SCHED; PG8_LDA(At, 0, 0); PG8_STAGE(PG8_SA(1, 1), a1 + hstepA, voffA);
            PG8_WAIT_L(8); PG8_BAR; PG8_WAIT_L(0); PG8_MMA(0, 0, At, B0); PG8_BAR; PG8_SCHED;
            PG8_LDB(B1, 0, 1); PG8_STAGE(PG8_SB(0, 0), b2, voffB);
            PG8_BAR; PG8_WAIT_L(0); PG8_MMA(0, 1, At, B1); PG8_BAR;
            PG8_LDA(At, 0, 1); PG8_STAGE(PG8_SA(0, 0), a2, voffA);
            PG8_BAR; PG8_WAIT_L(0); PG8_MMA(1, 0, At, B0); PG8_BAR; PG8_SCHED;
            PG8_STAGE(PG8_SB(0, 1), b2 + hstepB, voffB);
            PG8_WAIT_V(6); PG8_BAR; PG8_MMA(1, 1, At, B1); PG8_BAR;
            PG8_LDB(B0, 1, 0); PG8_SCHED; PG8_LDA(At, 1, 0); PG8_STAGE(PG8_SA(0, 1), a2 + hstepA, voffA);
            PG8_WAIT_L(8); PG8_BAR; PG8_WAIT_L(0); PG8_MMA(0, 0, At, B0); PG8_BAR; PG8_SCHED;
            PG8_LDB(B1, 1, 1); PG8_STAGE(PG8_SB(1, 0), b3, voffB);
            PG8_BAR; PG8_WAIT_L(0); PG8_MMA(0, 1, At, B1); PG8_BAR;
            PG8_LDA(At, 1, 1); PG8_STAGE(PG8_SA(1, 0), a3, voffA);
            PG8_BAR; PG8_WAIT_L(0); PG8_MMA(1, 0, At, B0); PG8_BAR; PG8_SCHED;
            PG8_STAGE(PG8_SB(1, 1), b3 + hstepB, voffB);
            PG8_WAIT_V(6); PG8_BAR; PG8_MMA(1, 1, At, B1); PG8_BAR;
            }
        }
        if constexpr (ALIGN_EPI) { if (wr == 0) PG8_BAR; }
        if constexpr (!Epi::AFTER_DRAIN) { const int l2_ = mk_tid(wv_) & 63; E(acc, cur, wr, wc, l2_ & 15, l2_ >> 4); S.done(cur); }
        if (!has_next) break;
#pragma unroll
        for (int a = 0; a < 2; ++a)
#pragma unroll
            for (int b = 0; b < 2; ++b)
#pragma unroll
                for (int m = 0; m < 4; ++m)
#pragma unroll
                    for (int n = 0; n < 2; ++n) acc[a][b][m][n] = (f32x4){0.f, 0.f, 0.f, 0.f};
        cur = nxt; cA = nA; cB = nB; ++ui;
        if constexpr (ALIGN_EPI) { if (wr == 1) PG8_BAR; }
    }
    PG8_WAIT_V(0);
    if constexpr (!ALIGN_EPI) { if (wr == 0) PG8_BAR; }
    PG8_BAR;
    if constexpr (Epi::AFTER_DRAIN) { E.fused(acc, cur, wr, wc, fr, fq, lds, wid, lane); S.done(cur); }
#undef PG8_SA
#undef PG8_SB
#undef PG8_STAGE
#undef PG8_LDA
#undef PG8_LDB
#undef PG8_MMA
#undef PG8_WAIT_V
#undef PG8_WAIT_L
#undef PG8_BAR
#undef PG8_SCHED
}
}

#define LAS __attribute__((address_space(3)))
typedef unsigned short bf16_t;
typedef short bf16x8 __attribute__((ext_vector_type(8)));
typedef float f32x4 __attribute__((ext_vector_type(4)));
typedef float f32x16 __attribute__((ext_vector_type(16)));
typedef unsigned u32x4 __attribute__((ext_vector_type(4)));
typedef unsigned u32x2 __attribute__((ext_vector_type(2)));

constexpr int T = 16384, S = 8192, D = 1024, FF = 2816, NZ = 4608, DEPTH = 4, PLE = 256;
constexpr float EPS = 1e-6f;
constexpr int LDV = S + 64;
constexpr int Z_QA = 0, Z_CKV = 512, Z_QI = 640, Z_KI = 896, Z_WI = 928, Z_QB = 936, Z_KVB = 1448, Z_GB = 2216, Z_GM = 2240, Z_KV = 4288;
constexpr int NPH = 50;

constexpr size_t MiB = 1u << 20;
constexpr size_t WS_CTL = 0, CTL_BYTES = 2 * MiB, WS_SS = 64 * 1024;
constexpr size_t WS_ROPE = 2 * MiB, WS_BIAS = 3 * MiB;
constexpr size_t WS_BAR = 16 * 1024;
constexpr int LDS_BARST = 147456 - 64;
constexpr size_t WS_X = 4 * MiB, WS_XG = 68 * MiB, WS_WB0 = 100 * MiB, WS_WB1 = 154 * MiB, WS_Z = 208 * MiB;
constexpr size_t WS_QA = 352 * MiB, WS_QB = 368 * MiB, WS_KA = 384 * MiB, WS_VA = 386 * MiB, WS_QI = 388 * MiB, WS_KI = 396 * MiB, WS_WI = 397 * MiB;
constexpr size_t WS_KCMP = 398 * MiB, WS_VCMP = 403 * MiB, WS_KS = 408 * MiB, WS_KW = 413 * MiB, WS_VST = 418 * MiB, WS_VWT = 423 * MiB;
constexpr size_t WS_GATES = 428 * MiB, WS_HIDK = 430 * MiB, WS_HIDV = 431 * MiB, WS_KC = 432 * MiB, WS_VCT = 433 * MiB, WS_IDX = 434 * MiB, WS_CNT = 442 * MiB;
constexpr size_t WS_OA = 443 * MiB, WS_OB = 459 * MiB, WS_PBF = 475 * MiB  , WS_SSP = 491 * MiB  , WS_SEL = 509 * MiB  , WS_END = 511 * MiB;
constexpr size_t WS_U = WS_Z, WS_PP = WS_Z + 96 * MiB, WS_MERGED = WS_QA, WS_XGB = WS_QA;
constexpr size_t WO_13A = 0, WO_2A = WO_13A + (size_t)2 * FF * D, WO_IN = WO_2A + (size_t)D * FF, WO_CK = WO_IN + (size_t)NZ * D, WO_CV = WO_CK + 256 * 2048,
                 WO_PA = WO_CV + 256 * 2048  , WO_WO = WO_PA + 2048 * 1024, WO_13B = WO_WO + 1024 * 1024, WO_2B = WO_13B + (size_t)2 * FF * D,
                 WO_PG = WO_2B + (size_t)D * FF, WO_PP = WO_PG + 1024 * 1024, WO_END = WO_PP + 1024 * 256;
static_assert(WO_END * 2 <= 54 * MiB, "weight buffer");
constexpr int LDS_BYTES = 147456;

__device__ __forceinline__ unsigned f2bf(float f) { unsigned u = __builtin_bit_cast(unsigned, f); return (u + 0x7fffu + ((u >> 16) & 1u)) >> 16; }
__device__ __forceinline__ unsigned pk2(float lo, float hi) { return f2bf(lo) | (f2bf(hi) << 16); }
__device__ __forceinline__ float bf2f(unsigned h) { return __builtin_bit_cast(float, (h & 0xffffu) << 16); }
__device__ __forceinline__ float bflo(unsigned w) { return __builtin_bit_cast(float, w << 16); }
__device__ __forceinline__ float bfhi(unsigned w) { return __builtin_bit_cast(float, w & 0xffff0000u); }
__device__ __forceinline__ float row_rs(const float* ssp, int r) {
    const f32x4 a = *(const f32x4*)(ssp + (size_t)r * 16), b = *(const f32x4*)(ssp + (size_t)r * 16 + 4), c = *(const f32x4*)(ssp + (size_t)r * 16 + 8), d = *(const f32x4*)(ssp + (size_t)r * 16 + 12);
    const float t = (((a[0] + a[1]) + (a[2] + a[3])) + ((b[0] + b[1]) + (b[2] + b[3]))) + (((c[0] + c[1]) + (c[2] + c[3])) + ((d[0] + d[1]) + (d[2] + d[3])));
    return rsqrtf(t * (1.f / 1024.f) + 1e-6f);
}
__device__ __forceinline__ float sigmoidf_(float v) { return __builtin_amdgcn_rcpf(1.f + __expf(-v)); }
__device__ __forceinline__ float wave_sum(float v) {
#pragma unroll
    for (int o = 1; o < 64; o <<= 1) v += __shfl_xor(v, o);
    return v;
}
#define LDS_WAIT() asm volatile("s_waitcnt lgkmcnt(0)" ::: "memory")

using pg8::Unit;
struct EpiSwiglu {
    static constexpr bool PERM = true, AFTER_DRAIN = false;
    bf16_t* U; const float* ss;
    __device__ __forceinline__ void operator()(const f32x4 (&acc)[2][2][4][2], const Unit& u, int wr, int wc, int fr_, int fq_) const {
        int fr = fr_, fq = fq_; asm volatile("" : "+v"(fr), "+v"(fq));
#pragma unroll
        for (int ai = 0; ai < 2; ++ai)
#pragma unroll
            for (int m = 0; m < 4; ++m) {
                const int r = u.pm * 256 + ai * 128 + wr * 64 + m * 16 + fr;
                const float rs = row_rs(ss, r);
#pragma unroll
                for (int bj = 0; bj < 2; ++bj) {
                    const f32x4 a = acc[ai][bj][m][0] * rs, b = acc[ai][bj][m][1] * rs;
                    float o[4];
#pragma unroll
                    for (int i = 0; i < 4; ++i) o[i] = a[i] * __builtin_amdgcn_rcpf(1.f + __expf(-a[i])) * b[i];
                    u32x2 w; w.x = pk2(o[0], o[1]); w.y = pk2(o[2], o[3]);
                    *(u32x2*)(U + (size_t)r * FF + u.pn * 128 + bj * 64 + wc * 16 + fq * 4) = w;
                }
            }
    }
};
template <int MODE> struct EpiResid {
    static constexpr bool PERM = false, AFTER_DRAIN = false;
    const float* xin; float* xout; bf16_t* xg; const float* gnext; float* ssnext; float alpha; const float* sscur; const bf16_t* pp;
    __device__ __forceinline__ void operator()(const f32x4 (&acc)[2][2][4][2], const Unit& u, int wr, int wc, int fr_, int fq_) const {
        int fr = fr_, fq = fq_; asm volatile("" : "+v"(fr), "+v"(fq));
#pragma unroll
        for (int ai = 0; ai < 2; ++ai)
#pragma unroll
            for (int m = 0; m < 4; ++m) {
                const int r = u.pm * 256 + ai * 128 + wr * 64 + m * 16 + fr;
                float rs = 1.f; if (MODE == 1) rs = row_rs(sscur, r);
                float sq = 0.f;
#pragma unroll
                for (int bj = 0; bj < 2; ++bj)
#pragma unroll
                    for (int n = 0; n < 2; ++n) {
                        const int c = u.pn * 256 + bj * 128 + wc * 32 + n * 16 + fq * 4;
                        const size_t off = (size_t)r * D + c;
                        const f32x4 xi = *(const f32x4*)(xin + off), v = acc[ai][bj][m][n];
                        f32x4 xn;
                        if (MODE == 0) xn = xi + v * alpha;
                        else { const u32x2 pw = *(const u32x2*)(pp + off);
                            xn[0] = xi[0] + sigmoidf_(v[0] * rs) * bflo(pw.x); xn[1] = xi[1] + sigmoidf_(v[1] * rs) * bfhi(pw.x);
                            xn[2] = xi[2] + sigmoidf_(v[2] * rs) * bflo(pw.y); xn[3] = xi[3] + sigmoidf_(v[3] * rs) * bfhi(pw.y); }
                        *(f32x4*)(xout + off) = xn;
                        const f32x4 g = *(const f32x4*)(gnext + c);
                        u32x2 w; w.x = pk2(xn[0] * g[0], xn[1] * g[1]); w.y = pk2(xn[2] * g[2], xn[3] * g[3]);
                        *(u32x2*)(xg + off) = w;
                        sq += (xn[0] * xn[0] + xn[1] * xn[1]) + (xn[2] * xn[2] + xn[3] * xn[3]);
                    }
                sq += __shfl_xor(sq, 16); sq += __shfl_xor(sq, 32);
                if (fq == 0) ssnext[(size_t)r * 16 + u.pn * 4 + wc] = sq;
            }
    }
};
template <int MODE> struct EpiRow {
    static constexpr bool PERM = true, AFTER_DRAIN = false;
    bf16_t* O; int ldc; const float* ss; const float* bias; const bf16_t* gate; int ldg;
    __device__ __forceinline__ void operator()(const f32x4 (&acc)[2][2][4][2], const Unit& u, int wr, int wc, int fr_, int fq_) const {
        int fr = fr_, fq = fq_; asm volatile("" : "+v"(fr), "+v"(fq));
#pragma unroll
        for (int ai = 0; ai < 2; ++ai)
#pragma unroll
            for (int m = 0; m < 4; ++m) {
                const int r = u.pm * 256 + ai * 128 + wr * 64 + m * 16 + fr;
                float rs = 1.f; if (MODE == 0) rs = row_rs(ss, r);
#pragma unroll
                for (int bj = 0; bj < 2; ++bj) {
                    const int c = u.pn * 256 + bj * 128 + wc * 32 + fq * 8;
                    float v[8];
#pragma unroll
                    for (int i = 0; i < 4; ++i) { v[i] = acc[ai][bj][m][0][i]; v[4 + i] = acc[ai][bj][m][1][i]; }
                    if (MODE == 0) {
#pragma unroll
                        for (int i = 0; i < 8; ++i) v[i] *= rs;
                    }
                    if (MODE == 1) {
#pragma unroll
                        for (int i = 0; i < 8; ++i) { const float a = v[i] + bias[c + i]; v[i] = a * __builtin_amdgcn_rcpf(1.f + __expf(-a)); }
                    }
                    if (MODE == 3 || MODE == 4) {
                        const u32x4 gw = *(const u32x4*)(gate + (size_t)r * ldg + c);
                        const unsigned gwa[4] = {gw.x, gw.y, gw.z, gw.w};
#pragma unroll
                        for (int i = 0; i < 4; ++i) { v[2 * i] *= sigmoidf_(bflo(gwa[i])); v[2 * i + 1] *= sigmoidf_(bfhi(gwa[i])); }
                    }
                    bf16_t* op = O + (size_t)r * ldc + c;
                    if (MODE == 4) {
                        const u32x4 ow = *(const u32x4*)op; const unsigned owa[4] = {ow.x, ow.y, ow.z, ow.w};
#pragma unroll
                        for (int i = 0; i < 4; ++i) { v[2 * i] += bflo(owa[i]); v[2 * i + 1] += bfhi(owa[i]); }
                    }
                    u32x4 w; w.x = pk2(v[0], v[1]); w.y = pk2(v[2], v[3]); w.z = pk2(v[4], v[5]); w.w = pk2(v[6], v[7]);
                    *(u32x4*)op = w;
                }
            }
    }
};

struct EpiMerge {
    static constexpr bool PERM = true, AFTER_DRAIN = false;
    bf16_t* O; const bf16_t* z;
    __device__ __forceinline__ void operator()(const f32x4 (&acc)[2][2][4][2], const Unit& u, int wr, int wc, int fr_, int fq_) const {
        int fr = fr_, fq = fq_; asm volatile("" : "+v"(fr), "+v"(fq));
#pragma unroll
        for (int ai = 0; ai < 2; ++ai)
#pragma unroll
            for (int m = 0; m < 4; ++m) {
                const int r = u.pm * 256 + ai * 128 + wr * 64 + m * 16 + fr;
#pragma unroll
                for (int bj = 0; bj < 2; ++bj) {
                    const int c = u.pn * 128 + bj * 64 + wc * 16 + fq * 4;
                    const u32x2 ga = *(const u32x2*)(z + (size_t)r * NZ + Z_GM + c), gb = *(const u32x2*)(z + (size_t)r * NZ + Z_GM + 1024 + c);
                    const f32x4 a = acc[ai][bj][m][0], b = acc[ai][bj][m][1];
                    u32x2 w;
                    w.x = pk2(sigmoidf_(bflo(ga.x)) * a[0] + sigmoidf_(bflo(gb.x)) * b[0], sigmoidf_(bfhi(ga.x)) * a[1] + sigmoidf_(bfhi(gb.x)) * b[1]);
                    w.y = pk2(sigmoidf_(bflo(ga.y)) * a[2] + sigmoidf_(bflo(gb.y)) * b[2], sigmoidf_(bfhi(ga.y)) * a[3] + sigmoidf_(bfhi(gb.y)) * b[3]);
                    *(u32x2*)(O + (size_t)r * D + c) = w;
                }
            }
    }
};
template <class Epi> __device__ __forceinline__ void run_gemm(LAS unsigned char* lds, const bf16_t* A, int lda, const bf16_t* Bt, int M, int N, int K, int cshift, const Epi& E, int wv) {
    pg8::Gemm g{A, Bt, M, N, K, lda};
    pg8::StaticOrder So; So.init(M, N, mk_grid(), (int)((mk_bid() + mk_grid() - cshift) % mk_grid()));
    pg8::gemm_phase<Epi, pg8::StaticOrder, true, true>(lds, g, So, E, wv);
}

__device__ __forceinline__ void transpose_item(const float* W, int K, int N, bf16_t* WT, int row_off, int mode, LAS float* scr, int item, int lane, int ldw = 0, int koff = 0) {
    if (ldw == 0) ldw = K;
    const int nblk = N / 32, kb = item / nblk, nb = item % nblk, k0 = 64 * kb, n0 = 32 * nb;
    const int kr = lane >> 3, n4 = (lane & 7) * 4;
#pragma unroll
    for (int i = 0; i < 8; ++i) { const int kk = 8 * i + kr; const f32x4 v = *(const f32x4*)(W + (size_t)(k0 + kk) * N + n0 + n4);
        LAS float* d = scr + kk * 33 + n4; d[0] = v[0]; d[1] = v[1]; d[2] = v[2]; d[3] = v[3]; }
    LDS_WAIT();
    const int c = lane & 7;
#pragma unroll
    for (int j = 0; j < 4; ++j) { const int nl = (lane >> 3) + 8 * j; const LAS float* s = scr + (8 * c) * 33 + nl;
        u32x4 o; o.x = pk2(s[0 * 33], s[1 * 33]); o.y = pk2(s[2 * 33], s[3 * 33]); o.z = pk2(s[4 * 33], s[5 * 33]); o.w = pk2(s[6 * 33], s[7 * 33]);
        const int n = n0 + nl; const int dr = mode == 0 ? row_off + n : (8 * (n >> 2) + (n & 3) + (mode == 2 ? 4 : 0));
        *(u32x4*)(WT + (size_t)dr * ldw + koff + k0 + 8 * c) = o; }
    LDS_WAIT();
}

struct P {
    const float* in[26];
    float* out; unsigned char* ws;
    int ph_lo, ph_hi;
};
typedef const __attribute__((address_space(4))) P* KP;

__device__ __forceinline__ void convert_layer(KP p, int L, bf16_t* WB, LAS unsigned char* lds, int wv) {
    int tid_ = mk_tid(wv); asm volatile("" : "+v"(tid_)); const int tid = tid_, lane = tid & 63; int wave = wv; asm volatile("" : "+s"(wave));
    LAS float* scr = (LAS float*)(lds + wave * 16384);
    const int gw = mk_bid() * 8 + wave, NGW = mk_grid() * 8;
    constexpr int I_13 = 16 * 88, I_2 = 44 * 32, I_IN = 16 * 134, I_C = 32 * 8, I_PR = 8 * 32, I_SQ = 16 * 32, I_PP = 4 * 32;
    constexpr int NIT = 4 * I_13 + 2 * I_2 + I_IN + 2 * I_C + 2 * I_PR + 2 * I_SQ + I_PP;
    const size_t l13 = (size_t)L * D * FF, lsq = (size_t)L * D * D;
    for (int it = gw; it < NIT; it += NGW) {
        int r = it;
        if (r < I_13) { transpose_item(p->in[3] + l13, D, FF, WB + WO_13A, 0, 1, scr, r, lane); continue; } r -= I_13;
        if (r < I_13) { transpose_item(p->in[4] + l13, D, FF, WB + WO_13A, 0, 2, scr, r, lane); continue; } r -= I_13;
        if (r < I_2) { transpose_item(p->in[5] + l13, FF, D, WB + WO_2A, 0, 0, scr, r, lane); continue; } r -= I_2;
        if (r < I_IN) { transpose_item(p->in[7] + (size_t)L * D * 4288, D, 4288, WB + WO_IN, 0, 0, scr, r, lane); continue; } r -= I_IN;
        if (r < I_C) { transpose_item(p->in[11] + (size_t)L * 2048 * 256, 2048, 256, WB + WO_CK, 0, 0, scr, r, lane); continue; } r -= I_C;
        if (r < I_C) { transpose_item(p->in[13] + (size_t)L * 2048 * 256, 2048, 256, WB + WO_CV, 0, 0, scr, r, lane); continue; } r -= I_C;
        if (r < I_PR) { transpose_item(p->in[15] + (size_t)L * 512 * D, 512, D, WB + WO_PA, 0, 1, scr, r, lane, 1024, 0); continue; } r -= I_PR;
        if (r < I_PR) { transpose_item(p->in[16] + (size_t)L * 512 * D, 512, D, WB + WO_PA, 0, 2, scr, r, lane, 1024, 512); continue; } r -= I_PR;
        if (r < I_SQ) { transpose_item(p->in[17] + lsq, D, D, WB + WO_WO, 0, 0, scr, r, lane); continue; } r -= I_SQ;
        if (r < I_13) { transpose_item(p->in[19] + l13, D, FF, WB + WO_13B, 0, 1, scr, r, lane); continue; } r -= I_13;
        if (r < I_13) { transpose_item(p->in[20] + l13, D, FF, WB + WO_13B, 0, 2, scr, r, lane); continue; } r -= I_13;
        if (r < I_2) { transpose_item(p->in[21] + l13, FF, D, WB + WO_2B, 0, 0, scr, r, lane); continue; } r -= I_2;
        if (r < I_SQ) { transpose_item(p->in[23] + lsq, D, D, WB + WO_PG, 0, 0, scr, r, lane); continue; } r -= I_SQ;
        transpose_item(p->in[24] + (size_t)L * PLE * D, PLE, D, WB + WO_PP, 0, 0, scr, r, lane);
    }
    const int gt = mk_bid() * 512 + tid, NGT = mk_grid() * 512;
    const float* win = p->in[7] + (size_t)L * D * 4288; const float* gkv = p->in[8] + L * 128; const float* ukv = p->in[9] + (size_t)L * 128 * 128;
    for (int o = gt; o < 128 * 1024; o += NGT) {
        const int n = o & 127, k = o >> 7; float a = 0.f;
        for (int j = 0; j < 128; ++j) a += win[(size_t)k * 4288 + 512 + j] * gkv[j] * ukv[j * 128 + n];
        WB[WO_IN + (size_t)(4288 + n) * D + k] = (bf16_t)f2bf(a);
    }
    for (int o = gt; o < 2048 * 64; o += NGT) { const int row = o >> 6, ch = o & 63; unsigned zz; asm volatile("v_mov_b32 %0, 0" : "=v"(zz));
        *(u32x4*)(WB + WO_PA + (size_t)row * 1024 + ((row & 4) ? 0 : 512) + ch * 8) = (u32x4){zz, zz, zz, zz}; }
    for (int o = gt; o < 192 * 1024 / 8; o += NGT) { unsigned zz; asm volatile("v_mov_b32 %0, 0" : "=v"(zz)); *(u32x4*)(WB + WO_IN + (size_t)4416 * D + (size_t)o * 8) = (u32x4){zz, zz, zz, zz}; }
    float* bias = (float*)(p->ws + WS_BIAS);
    for (int o = gw; o < 512; o += NGW) {
        const int n = o & 255, kv = o >> 8; const float* w1 = p->in[kv ? 13 : 11] + (size_t)L * 2048 * 256; const float* pos = p->in[10] + L * 2048; float a = 0.f;
#pragma unroll 8
        for (int k = lane; k < 2048; k += 64) a += pos[k] * w1[(size_t)k * 256 + n];
        a = wave_sum(a);
        if (lane == 0) bias[o] = a;
    }
    const float* pl = p->in[1] + (size_t)L * T * PLE; bf16_t* pb = (bf16_t*)(p->ws + WS_PBF) + (size_t)(L & 1) * T * PLE;
    for (int o = gt; o < T * PLE / 8; o += NGT) { const f32x4 a = *(const f32x4*)(pl + (size_t)o * 8), b = *(const f32x4*)(pl + (size_t)o * 8 + 4);
        u32x4 w; w.x = pk2(a[0], a[1]); w.y = pk2(a[2], a[3]); w.z = pk2(b[0], b[1]); w.w = pk2(b[2], b[3]); *(u32x4*)(pb + (size_t)o * 8) = w; }
}

__device__ __forceinline__ void prologue_phase(KP p, LAS unsigned char* lds, int wv) {
    int tid_ = mk_tid(wv); asm volatile("" : "+v"(tid_)); const int tid = tid_, lane = tid & 63; int wave = wv; asm volatile("" : "+s"(wave));
    const int gt = mk_bid() * 512 + tid, NGT = mk_grid() * 512;
    float* rope = (float*)(p->ws + WS_ROPE);
    for (int o = gt; o < S * 12; o += NGT) {
        int pos, j; float inv;
        if (o < S * 8) { pos = o >> 3; j = o & 7;
            inv = j == 0 ? 1.0f : j == 1 ? 0.19392274f : j == 2 ? 0.037606031f : j == 3 ? 0.0072926646f : j == 4 ? 0.0014142136f : j == 5 ? 0.00027424819f : j == 6 ? 5.3182957e-05f : 1.0313385e-05f; }
        else { const int o2 = o - S * 8; pos = o2 >> 2; j = o2 & 3;
            inv = j == 0 ? 1.0f : j == 1 ? 0.037606031f : j == 2 ? 0.0014142136f : 5.3182957e-05f; }
        const float ang = (float)pos * inv;
        const double rev = (double)ang * 0.15915494309189533577;
        const float fr = (float)(rev - __builtin_floor(rev));
        const float c = __builtin_amdgcn_cosf(fr), s = __builtin_amdgcn_sinf(fr);
        if (o < S * 8) { rope[o] = c; rope[S * 8 + o] = s; } else { rope[S * 16 + (o - S * 8)] = c; rope[S * 20 + (o - S * 8)] = s; }
    }
    convert_layer(p, 0, (bf16_t*)(p->ws + WS_WB0), lds, wv);
    const float* x = p->in[0]; const float* g = p->in[2]; bf16_t* xg = (bf16_t*)(p->ws + WS_XG); float* ss = (float*)(p->ws + WS_SSP);
    const int gw = mk_bid() * 8 + wave, NGW = mk_grid() * 8;
    for (int r = gw; r < T; r += NGW) {
        float sq = 0.f;
#pragma unroll
        for (int j = 0; j < 4; ++j) { const int c = (j * 64 + lane) * 4; const f32x4 v = *(const f32x4*)(x + (size_t)r * D + c), gg = *(const f32x4*)(g + c);
            sq += (v[0] * v[0] + v[1] * v[1]) + (v[2] * v[2] + v[3] * v[3]);
            u32x2 w; w.x = pk2(v[0] * gg[0], v[1] * gg[1]); w.y = pk2(v[2] * gg[2], v[3] * gg[3]); *(u32x2*)(xg + (size_t)r * D + c) = w; }
        sq = wave_sum(sq);
        if (lane < 16) ss[(size_t)r * 16 + lane] = lane == 0 ? sq : 0.f;
    }
}

__device__ __forceinline__ float rope_at(const LAS bf16_t* base, int d, int half, const float* cs, const float* sn) {
    const int j = d < half ? d : d - half;
    const float x1 = bf2f(base[j]), x2 = bf2f(base[j + half]);
    return d < half ? x1 * cs[j] - x2 * sn[j] : x2 * cs[j] + x1 * sn[j];
}
__device__ __forceinline__ void post_phase(KP p, LAS unsigned char* lds, int wv) {
    int tid_ = mk_tid(wv); asm volatile("" : "+v"(tid_)); const int tid = tid_, lane = tid & 63; int wave = wv; asm volatile("" : "+s"(wave));
    LAS bf16_t* zr = (LAS bf16_t*)(lds + wave * 16384);
    LAS bf16_t* vt = (LAS bf16_t*)(lds + wave * 16384 + 9216);
    const bf16_t* Z = (const bf16_t*)(p->ws + WS_Z);
    const float* rope = (const float*)(p->ws + WS_ROPE);
    bf16_t* QA = (bf16_t*)(p->ws + WS_QA); bf16_t* QB = (bf16_t*)(p->ws + WS_QB); bf16_t* KA = (bf16_t*)(p->ws + WS_KA); bf16_t* VA = (bf16_t*)(p->ws + WS_VA);
    bf16_t* QI = (bf16_t*)(p->ws + WS_QI); bf16_t* KI = (bf16_t*)(p->ws + WS_KI); float* WI = (float*)(p->ws + WS_WI); float* GATES = (float*)(p->ws + WS_GATES);
    bf16_t* KCMP = (bf16_t*)(p->ws + WS_KCMP); bf16_t* VCMP = (bf16_t*)(p->ws + WS_VCMP); bf16_t* KS = (bf16_t*)(p->ws + WS_KS); bf16_t* KW = (bf16_t*)(p->ws + WS_KW);
    bf16_t* VST = (bf16_t*)(p->ws + WS_VST); bf16_t* VWT = (bf16_t*)(p->ws + WS_VWT);
    const int gw = mk_bid() * 8 + wave, NGW = mk_grid() * 8;
    for (int grp = gw; grp < T / 8; grp += NGW) {
        const int tg0 = grp * 8, b = tg0 >> 13, s0 = tg0 & (S - 1);
        u32x4 zp[9];
#pragma unroll
        for (int i = 0; i < 9; ++i) zp[i] = *(const u32x4*)(Z + (size_t)tg0 * NZ + (i * 64 + lane) * 8);
#pragma unroll 1
        for (int tt = 0; tt < 8; ++tt) {
            const int tg = tg0 + tt, s = s0 + tt;
            LDS_WAIT();
#pragma unroll
            for (int i = 0; i < 9; ++i) *(LAS u32x4*)(zr + (i * 64 + lane) * 8) = zp[i];
            if (tt + 1 < 8) {
#pragma unroll
                for (int i = 0; i < 9; ++i) zp[i] = *(const u32x4*)(Z + (size_t)(tg + 1) * NZ + (i * 64 + lane) * 8);
            }
            LDS_WAIT();
            const float* c16 = rope + s * 8; const float* s16 = rope + S * 8 + s * 8; const float* c8 = rope + S * 16 + s * 4; const float* s8 = rope + S * 20 + s * 4;
#pragma unroll
            for (int i = 0; i < 8; ++i) { const int e = lane + 64 * i, d = e & 63;
                float va = d < 16 ? rope_at(zr + Z_QA + (e & ~63), d, 8, c16, s16) : bf2f(zr[Z_QA + e]);
                float vb = d < 16 ? rope_at(zr + Z_QB + (e & ~63), d, 8, c16, s16) : bf2f(zr[Z_QB + e]);
                QA[(size_t)tg * 512 + e] = (bf16_t)f2bf(va * 0.18033688011112042f); QB[(size_t)tg * 512 + e] = (bf16_t)f2bf(vb * 0.18033688011112042f); }
#pragma unroll
            for (int i = 0; i < 4; ++i) { const int e = lane + 64 * i, d = e & 31;
                float v = d < 8 ? rope_at(zr + Z_QI + (e & ~31), d, 4, c8, s8) : bf2f(zr[Z_QI + e]);
                QI[(size_t)tg * 256 + e] = (bf16_t)f2bf(v); }
            if (lane < 32) { const int d = lane; float v = d < 8 ? rope_at(zr + Z_KI, d, 4, c8, s8) : bf2f(zr[Z_KI + d]); KI[(size_t)tg * 32 + d] = (bf16_t)f2bf(v); }
            if (lane < 8) WI[(size_t)tg * 8 + lane] = bf2f(zr[Z_WI + lane]) * 0.35355339059327373f;
            if (lane < 24) GATES[(size_t)tg * 24 + lane] = sigmoidf_(bf2f(zr[Z_GB + lane]));
            { const float a = bf2f(zr[Z_CKV + lane]), c = bf2f(zr[Z_CKV + 64 + lane]);
              const float rs = rsqrtf(wave_sum(a * a + c * c) * (1.f / 128.f) + EPS);
              const int d = lane;
              float kv = d < 16 ? rope_at(zr + Z_KV, d, 8, c16, s16) : bf2f(zr[Z_KV + d]);
              KA[(size_t)tg * 64 + d] = (bf16_t)f2bf(kv * rs);
              VA[(size_t)tg * 64 + d] = (bf16_t)f2bf(bf2f(zr[Z_KV + 64 + d]) * rs); }
#pragma unroll
            for (int i = 0; i < 2; ++i) { const int e = lane + 64 * i, g = i, d = lane;
                const size_t dst = ((size_t)(b * 2 + g) * S + s) * 64 + d;
                float kc = d < 16 ? rope_at(zr + Z_KVB + 0 + g * 64, d, 8, c16, s16) : bf2f(zr[Z_KVB + 0 + e]);
                float ks = d < 16 ? rope_at(zr + Z_KVB + 256 + g * 64, d, 8, c16, s16) : bf2f(zr[Z_KVB + 256 + e]);
                float kw = d < 16 ? rope_at(zr + Z_KVB + 512 + g * 64, d, 8, c16, s16) : bf2f(zr[Z_KVB + 512 + e]);
                KCMP[dst] = (bf16_t)f2bf(kc); KS[dst] = (bf16_t)f2bf(ks); KW[dst] = (bf16_t)f2bf(kw);
                VCMP[dst] = zr[Z_KVB + 128 + e];
                vt[(e) * 8 + tt] = zr[Z_KVB + 384 + e];
                vt[(128 + e) * 8 + tt] = zr[Z_KVB + 640 + e]; }
        }
        LDS_WAIT();
#pragma unroll
        for (int i = 0; i < 4; ++i) { const int rr = lane + 64 * i, e = rr & 127, g = e >> 6, d = e & 63;
            bf16_t* dst = (rr >> 7 ? VWT : VST) + ((size_t)(b * 2 + g) * 64 + d) * LDV + s0;
            *(u32x4*)dst = *(const LAS u32x4*)(vt + rr * 8); }
        LDS_WAIT();
    }
}

__device__ __forceinline__ void cmp2_phase(KP p, int L, int wv) {
    int tid_ = mk_tid(wv); asm volatile("" : "+v"(tid_)); const int gt = mk_bid() * 512 + tid_, NGT = mk_grid() * 512;
    bf16_t* KC = (bf16_t*)(p->ws + WS_KC); bf16_t* VCT = (bf16_t*)(p->ws + WS_VCT);
    for (int o = gt; o < 2 * 2048 * 64; o += NGT) {
        const int n = o & 63, r = (o >> 6) & 2047, kv = o >> 17;
        const bf16_t* hid = (const bf16_t*)(p->ws + (kv ? WS_HIDV : WS_HIDK)) + (size_t)r * 256;
        const float* w2 = p->in[kv ? 14 : 12] + (size_t)L * 256 * 64;
        float a = 0.f;
        for (int j = 0; j < 256; ++j) a += bf2f(hid[j]) * w2[j * 64 + n];
        if (kv == 0) KC[(size_t)r * 64 + n] = (bf16_t)f2bf(a);
        else VCT[((size_t)(r >> 9) * 64 + n) * 512 + (r & 511)] = (bf16_t)f2bf(a);
    }
}

__device__ __forceinline__ unsigned quant16(float v, float lo, float scale) { const float q = (v - lo) * scale; return min(65535u, (unsigned)q); }
__device__ __forceinline__ void scan_bins(const LAS unsigned* h, unsigned need, int lane, LAS int* outb, LAS int* outneed) {
    const unsigned h0 = h[4 * lane], h1 = h[4 * lane + 1], h2 = h[4 * lane + 2], h3 = h[4 * lane + 3];
    const unsigned tot = h0 + h1 + h2 + h3;
    unsigned suf = tot;
#pragma unroll
    for (int o = 1; o < 64; o <<= 1) { const unsigned t = __shfl_down(suf, o); if (lane + o < 64) suf += t; }
    unsigned cum = suf - tot;
    const unsigned hh[4] = {h0, h1, h2, h3};
#pragma unroll
    for (int b = 3; b >= 0; --b) { if (cum < need && cum + hh[b] >= need) { *outb = 4 * lane + b; *outneed = (int)(need - cum); } cum += hh[b]; }
}
__device__ __forceinline__ void indexer_phase(KP p, LAS unsigned char* lds, int L, int wv, int cslot, const bool score_only = false) {
    int tid_ = mk_tid(wv); asm volatile("" : "+v"(tid_)); const int tid = tid_, lane = tid & 63; int wave = wv; asm volatile("" : "+s"(wave));
    LAS float* sc = (LAS float*)lds;
    LAS unsigned* hist = (LAS unsigned*)(lds + 131072);
    LAS float* mm = (LAS float*)(lds + 131072 + 4096);
    LAS int* ctl = (LAS int*)(lds + 131072 + 4096 + 256);
    const bf16_t* QI = (const bf16_t*)(p->ws + WS_QI); const bf16_t* KI = (const bf16_t*)(p->ws + WS_KI); const float* WI = (const float*)(p->ws + WS_WI);
    unsigned short* IDX = (unsigned short*)(p->ws + WS_IDX); int* CNT = (int*)(p->ws + WS_CNT);
    unsigned* ctr = (unsigned*)(p->ws + WS_CTL) + 64 * L + cslot;
    const int r = lane & 31, hi = lane >> 5;
    int cur_item = 0;
    if (tid == 0) cur_item = (int)atomicAdd(ctr, 1u);
    for (;;) {
        __syncthreads();
        int nxt_item = 0;
        if (tid == 0) { ctl[0] = cur_item; nxt_item = (int)atomicAdd(ctr, 1u); }
        for (int i = tid; i < 1024; i += 512) hist[i] = 0u;
        __syncthreads();
        const int item = ctl[0];
        if (item >= T / 4) break;
        const int tg0 = (T / 4 - 1 - item) * 4, b = tg0 >> 13, s0 = tg0 & (S - 1);
        const int ntile = (s0 + 4 + 31) >> 5;
        const int i16 = (r & 3) + 4 * (r >> 3), aq = 2 * ((r >> 2) & 1) + (i16 >> 3), ah = i16 & 7;
        const bf16_t* qp = QI + (size_t)(tg0 + aq) * 256 + ah * 32 + 8 * hi;
        const bf16x8 a0 = *(const bf16x8*)qp, a1 = *(const bf16x8*)(qp + 16);
        float w[16];
#pragma unroll
        for (int i = 0; i < 16; ++i) w[i] = WI[(size_t)(tg0 + 2 * hi + (i >> 3)) * 8 + (i & 7)];
        float mn2[2] = {3.0e38f, 3.0e38f}, mx2[2] = {-3.0e38f, -3.0e38f};
        for (int kt = wave; kt < ntile; kt += 8) {
            const int key = kt * 32 + r;
            const bf16_t* kp = KI + ((size_t)b * S + key) * 32 + 8 * hi;
            const bf16x8 b0 = *(const bf16x8*)kp, b1 = *(const bf16x8*)(kp + 16);
            f32x16 acc;
#pragma unroll
            for (int i = 0; i < 16; ++i) acc[i] = 0.f;
            acc = __builtin_amdgcn_mfma_f32_32x32x16_bf16(a0, b0, acc, 0, 0, 0);
            acc = __builtin_amdgcn_mfma_f32_32x32x16_bf16(a1, b1, acc, 0, 0, 0);
#pragma unroll
            for (int ql = 0; ql < 2; ++ql) {
                float pq = 0.f;
#pragma unroll
                for (int i = 0; i < 8; ++i) pq += w[ql * 8 + i] * fmaxf(acc[8 * ql + i], 0.f);
                const int q = 2 * hi + ql;
                const bool valid = key <= s0 + q;
                const float plo = valid ? pq : -3.0e38f;
                mn2[ql] = fminf(mn2[ql], valid ? pq : 3.0e38f); mx2[ql] = fmaxf(mx2[ql], plo);
                sc[q * 8192 + key] = plo;
            }
        }
        float mn[4], mx[4];
#pragma unroll
        for (int q = 0; q < 4; ++q) { const bool own = hi == (q >> 1); mn[q] = own ? mn2[q & 1] : 3.0e38f; mx[q] = own ? mx2[q & 1] : -3.0e38f; }
#pragma unroll
        for (int q = 0; q < 4; ++q)
#pragma unroll
            for (int o = 1; o < 64; o <<= 1) { mn[q] = fminf(mn[q], __shfl_xor(mn[q], o)); mx[q] = fmaxf(mx[q], __shfl_xor(mx[q], o)); }
        if (lane == 0) {
#pragma unroll
            for (int q = 0; q < 4; ++q) { mm[wave * 8 + q] = mn[q]; mm[wave * 8 + 4 + q] = mx[q]; }
        }
        __syncthreads();
        if (score_only) { cur_item = nxt_item; continue; }
        {
            const int row = tid >> 7, j = tid & 127, nrow = s0 + row + 1;
            float lo = 3.0e38f, hv = -3.0e38f;
#pragma unroll
            for (int w8 = 0; w8 < 8; ++w8) { lo = fminf(lo, mm[w8 * 8 + row]); hv = fmaxf(hv, mm[w8 * 8 + 4 + row]); }
            const float scale = hv > lo ? 65535.f / (hv - lo) : 0.f;
            if (nrow > 256) for (int i = j; i < nrow; i += 128) __hip_atomic_fetch_add(&hist[row * 256 + (quant16(sc[row * 8192 + i], lo, scale) >> 8)], 1u, __ATOMIC_RELAXED, __HIP_MEMORY_SCOPE_WORKGROUP);
            __syncthreads();
            if (wave < 4 && s0 + wave + 1 > 256) scan_bins(hist + wave * 256, 256u, lane, ctl + 4 + wave, ctl + 8 + wave);
            __syncthreads();
            for (int i = tid; i < 1024; i += 512) hist[i] = 0u;
            __syncthreads();
            if (nrow > 256) { const unsigned B1 = (unsigned)ctl[4 + row];
                for (int i = j; i < nrow; i += 128) { const unsigned k16 = quant16(sc[row * 8192 + i], lo, scale); if ((k16 >> 8) == B1) __hip_atomic_fetch_add(&hist[row * 256 + (k16 & 255u)], 1u, __ATOMIC_RELAXED, __HIP_MEMORY_SCOPE_WORKGROUP); } }
            __syncthreads();
            if (wave < 4 && s0 + wave + 1 > 256) scan_bins(hist + wave * 256, (unsigned)ctl[8 + wave], lane, ctl + 12 + wave, ctl + 16 + wave);
            __syncthreads();
        }
        {
            const int row = tid >> 7, j = tid & 127, nrow = s0 + row + 1; const size_t tg = (size_t)tg0 + row;
            const bool big = nrow > 256;
            float lo = 3.0e38f, hv = -3.0e38f;
#pragma unroll
            for (int w8 = 0; w8 < 8; ++w8) { lo = fminf(lo, mm[w8 * 8 + row]); hv = fmaxf(hv, mm[w8 * 8 + 4 + row]); }
            const float scale = hv > lo ? 65535.f / (hv - lo) : 0.f;
            const unsigned T16 = ((unsigned)ctl[4 + row] << 8) | (unsigned)ctl[12 + row]; const int need2 = ctl[16 + row];
            const int chunk = ((nrow + 127) >> 7) | 1, beg = j * chunk, end = min(beg + chunk, nrow);
            int cg = 0, ce = 0;
            if (big) for (int i = beg; i < end; ++i) { const unsigned k16 = quant16(sc[row * 8192 + i], lo, scale); cg += k16 > T16 ? 1 : 0; ce += k16 == T16 ? 1 : 0; }
            const unsigned v = (unsigned)cg | ((unsigned)ce << 16);
            unsigned incl = v;
#pragma unroll
            for (int o = 1; o < 64; o <<= 1) { const unsigned t = __shfl_up(incl, o); if (lane >= o) incl += t; }
            LAS unsigned* wsum = (LAS unsigned*)(ctl + 32);
            if (lane == 63) wsum[wave] = incl;
            __syncthreads();
            const unsigned pre = incl - v + ((wave & 1) ? wsum[wave - 1] : 0u);
            if (big) {
                int eb = (int)(pre >> 16); int pos = (int)(pre & 0xffffu) + min(eb, need2);
                for (int i = beg; i < end; ++i) { const unsigned k16 = quant16(sc[row * 8192 + i], lo, scale);
                    if (k16 > T16) { if (pos < 256) IDX[tg * 256 + pos] = (unsigned short)i; ++pos; }
                    else if (k16 == T16) { if (eb < need2) { if (pos < 256) IDX[tg * 256 + pos] = (unsigned short)i; ++pos; } ++eb; } }
                if (j == 0) CNT[tg] = 256;
            } else {
#pragma unroll
                for (int i = 0; i < 2; ++i) { const int e = j + 128 * i; IDX[tg * 256 + e] = (unsigned short)(e < nrow ? e : 0); }
                if (j == 0) CNT[tg] = nrow;
            }
        }
        cur_item = nxt_item;
    }
}

__device__ __forceinline__ f32x4 mfma16(bf16x8 a, bf16x8 b, f32x4 c) { return __builtin_amdgcn_mfma_f32_16x16x32_bf16(a, b, c, 0, 0, 0); }
__device__ __forceinline__ float ex2(float v) { return __builtin_amdgcn_exp2f(v); }
__device__ __forceinline__ float fmax2(float a, float b) { return __builtin_amdgcn_fmed3f(a, b, __builtin_inff()); }
__device__ __forceinline__ float fmax3(float a, float b, float c) { return fmax2(fmax2(a, b), c); }
__device__ __forceinline__ unsigned cvtpk(float lo, float hi) { unsigned r; asm("v_cvt_pk_bf16_f32 %0, %1, %2" : "=v"(r) : "v"(lo), "v"(hi)); return r; }
__device__ __forceinline__ void load_k64(const bf16_t* Kb, int kb, int krow0, int kq, bf16x8 (&k)[8]) {
#pragma unroll
    for (int j = 0; j < 4; ++j) { const bf16_t* p = Kb + (size_t)(kb + 32 * (j >> 1) + 4 * (j & 1) + krow0) * 64 + 8 * kq; k[2 * j] = *(const bf16x8*)p; k[2 * j + 1] = *(const bf16x8*)(p + 32); }
}
__device__ __forceinline__ void load_v64(const bf16_t* Vt, int ldv, int kb, int lc, int kq, bf16x8 (&v)[8]) {
#pragma unroll
    for (int dt = 0; dt < 4; ++dt) { const bf16_t* p = Vt + (size_t)(16 * dt + lc) * ldv + kb + 8 * kq; v[2 * dt] = *(const bf16x8*)p; v[2 * dt + 1] = *(const bf16x8*)(p + 32); }
}
__device__ __forceinline__ void qk64(const bf16x8 (&k)[8], bf16x8 q0, bf16x8 q1, float (&s)[16]) {
#pragma unroll
    for (int j = 0; j < 4; ++j) { f32x4 a = (f32x4){0.f, 0.f, 0.f, 0.f}; a = mfma16(k[2 * j], q0, a); a = mfma16(k[2 * j + 1], q1, a);
#pragma unroll
        for (int i = 0; i < 4; ++i) s[(j >> 1) * 8 + (j & 1) * 4 + i] = a[i]; }
}
#define VAL64(d, lim, i) ((unsigned)((d) - (32 * ((i) >> 3) + ((i) & 7))) < (lim))
template <bool FULL> __device__ __forceinline__ void sm64(const float (&s)[16], int d, unsigned lim, float& m, float& l, f32x4 (&o)[4], bf16x8& pf0, bf16x8& pf1) {
    float mx = -1e30f;
#pragma unroll
    for (int i = 0; i < 16; i += 2) mx = fmax3(mx, (FULL || VAL64(d, lim, i)) ? s[i] : -1e30f, (FULL || VAL64(d, lim, i + 1)) ? s[i + 1] : -1e30f);
    mx = fmax2(mx, __shfl_xor(mx, 16)); mx = fmax2(mx, __shfl_xor(mx, 32));
    const float mn = fmax2(m, mx), alpha = ex2(m - mn);
    float pr[16], sum = 0.f;
#pragma unroll
    for (int i = 0; i < 16; ++i) { pr[i] = (FULL || VAL64(d, lim, i)) ? ex2(s[i] - mn) : 0.f; sum += pr[i]; }
    l = l * alpha + sum; m = mn;
#pragma unroll
    for (int dt = 0; dt < 4; ++dt) o[dt] = o[dt] * alpha;
    u32x4 w0, w1;
    w0.x = cvtpk(pr[0], pr[1]); w0.y = cvtpk(pr[2], pr[3]); w0.z = cvtpk(pr[4], pr[5]); w0.w = cvtpk(pr[6], pr[7]);
    w1.x = cvtpk(pr[8], pr[9]); w1.y = cvtpk(pr[10], pr[11]); w1.z = cvtpk(pr[12], pr[13]); w1.w = cvtpk(pr[14], pr[15]);
    pf0 = __builtin_bit_cast(bf16x8, w0); pf1 = __builtin_bit_cast(bf16x8, w1);
}
__device__ __forceinline__ void pv64(const bf16x8 (&v)[8], bf16x8 pf0, bf16x8 pf1, f32x4 (&o)[4]) {
#pragma unroll
    for (int dt = 0; dt < 4; ++dt) { o[dt] = mfma16(v[2 * dt], pf0, o[dt]); o[dt] = mfma16(v[2 * dt + 1], pf1, o[dt]); }
}
struct WinF { int kb0, tq, kq, s0; static constexpr unsigned LIM = 512u;
    __device__ __forceinline__ int kb(int i) const { return kb0 + 64 * i; }
    __device__ __forceinline__ bool full(int kbv) const { return kbv + 63 <= s0 && kbv > s0 + 15 - 512; }
    __device__ __forceinline__ int d(int kbv) const { return tq - kbv - 8 * kq; } };
struct SelF { int selv; int tq, kq, tqu; static constexpr unsigned LIM = 0x80000000u;
    __device__ __forceinline__ int kb(int i) const { return 64 * __builtin_amdgcn_readlane(selv, i); }
    __device__ __forceinline__ bool full(int kbv) const { return kbv + 63 <= tqu; }
    __device__ __forceinline__ int d(int kbv) const { return tq - kbv - 8 * kq; } };
template <class F> __device__ __forceinline__ void attn_blocks(const bf16_t* Kb, const bf16_t* Vt, int ldv, int n, const F& f, bf16x8 q0, bf16x8 q1, float& m, float& l, f32x4 (&o)[4], int lc, int kq, int krow0) {
    bf16x8 kA[8], kB[8], vA[8];
    int kbc = f.kb(0);
    load_k64(Kb, kbc, krow0, kq, kA);
#define ATT_STEP(KC, KN, idx) { \
        int kbn = kbc; const bool more = (idx) + 1 < n; \
        load_v64(Vt, ldv, kbc, lc, kq, vA); \
        if (more) { kbn = f.kb((idx) + 1); load_k64(Kb, kbn, krow0, kq, KN); } \
        __builtin_amdgcn_sched_barrier(0); \
        float s[16]; qk64(KC, q0, q1, s); bf16x8 pf0, pf1; if (f.full(kbc)) sm64<true>(s, 0, 0u, m, l, o, pf0, pf1); else sm64<false>(s, f.d(kbc), F::LIM, m, l, o, pf0, pf1); pv64(vA, pf0, pf1, o); kbc = kbn; __builtin_amdgcn_sched_barrier(0); }
#pragma unroll 1
    for (int i = 0; i < n; i += 2) {
        ATT_STEP(kA, kB, i)
        if (i + 1 < n) ATT_STEP(kB, kA, i + 1)
    }
#undef ATT_STEP
}
struct StgW { LAS unsigned char* gb; const bf16_t* kg; const bf16_t* vg; int wofs; };
__device__ __forceinline__ StgW stg_make(LAS unsigned char* stg, const bf16_t* Kb, const bf16_t* Vt, int ldv, int wave, int lane) {
    const int w4 = wave & 3, lr = lane >> 2, lcn = lane & 3; StgW w;
    w.gb = stg + (wave >> 2) * 36864; w.kg = Kb + (size_t)(16 * w4 + lr) * 64 + 16 * lcn; w.vg = Vt + (size_t)(16 * w4 + lr) * ldv + 16 * lcn; w.wofs = (16 * w4 + lr) * 144 + 32 * lcn; return w; }
__device__ __forceinline__ void stg_ldk(const StgW& w, int kb, u32x4& a, u32x4& b) { const bf16_t* kp = w.kg + (size_t)kb * 64; a = *(const u32x4*)kp; b = *(const u32x4*)(kp + 8); }
__device__ __forceinline__ void stg_ldv(const StgW& w, int kb, u32x4& a, u32x4& b) { const bf16_t* vp = w.vg + kb; a = *(const u32x4*)vp; b = *(const u32x4*)(vp + 8); }
__device__ __forceinline__ void stg_stk(const StgW& w, int buf, u32x4 a, u32x4 b) { LAS unsigned char* d = w.gb + buf * 18432 + w.wofs; *(LAS u32x4*)d = a; *(LAS u32x4*)(d + 16) = b; }
__device__ __forceinline__ void stg_stv(const StgW& w, int buf, u32x4 a, u32x4 b) { LAS unsigned char* d = w.gb + buf * 18432 + 9216 + w.wofs; *(LAS u32x4*)d = a; *(LAS u32x4*)(d + 16) = b; }
__device__ __forceinline__ void stg_rdk(const LAS unsigned char* b, int krow0, int kq, bf16x8 (&kf)[8]) {
#pragma unroll
    for (int j = 0; j < 4; ++j) { const LAS unsigned char* rp = b + (32 * (j >> 1) + 4 * (j & 1) + krow0) * 144 + 16 * kq; kf[2 * j] = *(const LAS bf16x8*)rp; kf[2 * j + 1] = *(const LAS bf16x8*)(rp + 64); }
}
__device__ __forceinline__ void stg_rdv(const LAS unsigned char* b, int lc, int kq, bf16x8 (&vf)[8]) {
#pragma unroll
    for (int dt = 0; dt < 4; ++dt) { const LAS unsigned char* rp = b + 9216 + (16 * dt + lc) * 144 + 16 * kq; vf[2 * dt] = *(const LAS bf16x8*)rp; vf[2 * dt + 1] = *(const LAS bf16x8*)(rp + 64); }
}
__device__ __forceinline__ void window_lds(LAS unsigned char* stg, const bf16_t* Kw, const bf16_t* Vw, int kb0, int n, int wave, int lane, int lc, int kq, int krow0, const WinF& wf,
                                           bf16x8 q0, bf16x8 q1, float& m, float& l, f32x4 (&o)[4]) {
    const int w4 = wave & 3;
    LAS unsigned char* gb = stg + (wave >> 2) * 36864;
    const int lr = lane >> 2, lcn = lane & 3;
    const bf16_t* kg = Kw + (size_t)(16 * w4 + lr) * 64 + 16 * lcn;
    const bf16_t* vg = Vw + (size_t)(16 * w4 + lr) * LDV + 16 * lcn;
    const int wofs = (16 * w4 + lr) * 144 + 32 * lcn;
    u32x4 pk0, pk1, pv0, pv1;
    { const bf16_t* kp = kg + (size_t)kb0 * 64; const bf16_t* vp = vg + kb0;
      pk0 = *(const u32x4*)kp; pk1 = *(const u32x4*)(kp + 8); pv0 = *(const u32x4*)vp; pv1 = *(const u32x4*)(vp + 8); }
    *(LAS u32x4*)(gb + wofs) = pk0; *(LAS u32x4*)(gb + wofs + 16) = pk1; *(LAS u32x4*)(gb + 9216 + wofs) = pv0; *(LAS u32x4*)(gb + 9216 + wofs + 16) = pv1;
    __syncthreads();
#pragma unroll 1
    for (int i = 0; i < n; ++i) {
        const int kbc = kb0 + 64 * i; const bool more = i + 1 < n;
        if (more) { const bf16_t* kp = kg + (size_t)(kbc + 64) * 64; const bf16_t* vp = vg + kbc + 64;
            pk0 = *(const u32x4*)kp; pk1 = *(const u32x4*)(kp + 8); pv0 = *(const u32x4*)vp; pv1 = *(const u32x4*)(vp + 8); }
        const LAS unsigned char* b = gb + (i & 1) * 18432;
        bf16x8 kf[8], vf[8];
#pragma unroll
        for (int j = 0; j < 4; ++j) { const LAS unsigned char* rp = b + (32 * (j >> 1) + 4 * (j & 1) + krow0) * 144 + 16 * kq; kf[2 * j] = *(const LAS bf16x8*)rp; kf[2 * j + 1] = *(const LAS bf16x8*)(rp + 64); }
#pragma unroll
        for (int dt = 0; dt < 4; ++dt) { const LAS unsigned char* rp = b + 9216 + (16 * dt + lc) * 144 + 16 * kq; vf[2 * dt] = *(const LAS bf16x8*)rp; vf[2 * dt + 1] = *(const LAS bf16x8*)(rp + 64); }
        float s[16]; qk64(kf, q0, q1, s); bf16x8 pf0, pf1;
        if (wf.full(kbc)) sm64<true>(s, 0, 0u, m, l, o, pf0, pf1); else sm64<false>(s, wf.d(kbc), WinF::LIM, m, l, o, pf0, pf1);
        pv64(vf, pf0, pf1, o);
        if (more) { LAS unsigned char* nb = gb + ((i + 1) & 1) * 18432;
            *(LAS u32x4*)(nb + wofs) = pk0; *(LAS u32x4*)(nb + wofs + 16) = pk1; *(LAS u32x4*)(nb + 9216 + wofs) = pv0; *(LAS u32x4*)(nb + 9216 + wofs + 16) = pv1; }
        __syncthreads();
    }
}
__device__ __forceinline__ void qk32(const bf16_t* k0p, const bf16_t* k1p, bf16x8 q0, bf16x8 q1, float (&s)[8]) {
    const bf16x8 ka = *(const bf16x8*)k0p, kb = *(const bf16x8*)(k0p + 32), kc = *(const bf16x8*)k1p, kd = *(const bf16x8*)(k1p + 32);
    f32x4 s0 = (f32x4){0.f, 0.f, 0.f, 0.f}, s1 = s0;
    s0 = mfma16(ka, q0, s0); s0 = mfma16(kb, q1, s0); s1 = mfma16(kc, q0, s1); s1 = mfma16(kd, q1, s1);
#pragma unroll
    for (int i = 0; i < 4; ++i) { s[i] = s0[i]; s[4 + i] = s1[i]; }
}
__device__ __forceinline__ bf16x8 sm_step(const float (&s)[8], int d2, float& m, float& l, f32x4 (&o)[4]) {
    float mx = -1e30f;
#pragma unroll
    for (int i = 0; i < 8; i += 2) mx = fmax3(mx, (i < d2) ? s[i] : -1e30f, (i + 1 < d2) ? s[i + 1] : -1e30f);
    mx = fmax2(mx, __shfl_xor(mx, 16)); mx = fmax2(mx, __shfl_xor(mx, 32));
    const float mn = fmax2(m, mx), alpha = ex2(m - mn);
    float pr[8], sum = 0.f;
#pragma unroll
    for (int i = 0; i < 8; ++i) { pr[i] = (i < d2) ? ex2(s[i] - mn) : 0.f; sum += pr[i]; }
    l = l * alpha + sum; m = mn;
#pragma unroll
    for (int dt = 0; dt < 4; ++dt) o[dt] = o[dt] * alpha;
    u32x4 w; w.x = cvtpk(pr[0], pr[1]); w.y = cvtpk(pr[2], pr[3]); w.z = cvtpk(pr[4], pr[5]); w.w = cvtpk(pr[6], pr[7]);
    return __builtin_bit_cast(bf16x8, w);
}
struct DsaL { bf16x8 ka, kb, kc, kd; u32x4 v0, v1, v2, v3; };
__device__ __forceinline__ void dsa_load(const unsigned short* idx, int sb, int krow0, int kq, int lane, const bf16_t* Kb, const bf16_t* Vb, DsaL& L) {
    const int i0 = idx[sb + krow0], i1 = idx[sb + krow0 + 4], vkey = idx[sb + (lane >> 1)];
    const bf16_t* k0p = Kb + (size_t)i0 * 64 + 8 * kq; const bf16_t* k1p = Kb + (size_t)i1 * 64 + 8 * kq;
    L.ka = *(const bf16x8*)k0p; L.kb = *(const bf16x8*)(k0p + 32); L.kc = *(const bf16x8*)k1p; L.kd = *(const bf16x8*)(k1p + 32);
    const bf16_t* vp = Vb + (size_t)vkey * 64 + (lane & 1) * 32;
    L.v0 = *(const u32x4*)vp; L.v1 = *(const u32x4*)(vp + 8); L.v2 = *(const u32x4*)(vp + 16); L.v3 = *(const u32x4*)(vp + 24);
}
__device__ __forceinline__ void dsa_compute(const DsaL& L, bf16x8 q0, bf16x8 q1, int d2, float& m, float& l, f32x4 (&o)[4], LAS unsigned char* vreg, int lane, int lc, int kq) {
    f32x4 s0 = (f32x4){0.f, 0.f, 0.f, 0.f}, s1 = s0;
    s0 = mfma16(L.ka, q0, s0); s0 = mfma16(L.kb, q1, s0); s1 = mfma16(L.kc, q0, s1); s1 = mfma16(L.kd, q1, s1);
    float s[8];
#pragma unroll
    for (int i = 0; i < 4; ++i) { s[i] = s0[i]; s[4 + i] = s1[i]; }
    const bf16x8 pf = sm_step(s, d2, m, l, o);
    LAS u32x4* wdst = (LAS u32x4*)(vreg + (lane >> 1) * 144 + (lane & 1) * 64);
    wdst[0] = L.v0; wdst[1] = L.v1; wdst[2] = L.v2; wdst[3] = L.v3;
    LDS_WAIT();
    const unsigned taddr = (unsigned)(size_t)vreg + (unsigned)((8 * kq + (lc >> 2)) * 144 + 8 * (lc & 3));
    u32x2 t0, t1, t2, t3, t4, t5, t6, t7;
    asm volatile("ds_read_b64_tr_b16 %0, %8\n\tds_read_b64_tr_b16 %1, %8 offset:576\n\tds_read_b64_tr_b16 %2, %8 offset:32\n\tds_read_b64_tr_b16 %3, %8 offset:608\n\t"
                 "ds_read_b64_tr_b16 %4, %8 offset:64\n\tds_read_b64_tr_b16 %5, %8 offset:640\n\tds_read_b64_tr_b16 %6, %8 offset:96\n\tds_read_b64_tr_b16 %7, %8 offset:672\n\ts_waitcnt lgkmcnt(0)"
                 : "=&v"(t0), "=&v"(t1), "=&v"(t2), "=&v"(t3), "=&v"(t4), "=&v"(t5), "=&v"(t6), "=&v"(t7) : "v"(taddr) : "memory");
    o[0] = mfma16(__builtin_bit_cast(bf16x8, (u32x4){t0.x, t0.y, t1.x, t1.y}), pf, o[0]);
    o[1] = mfma16(__builtin_bit_cast(bf16x8, (u32x4){t2.x, t2.y, t3.x, t3.y}), pf, o[1]);
    o[2] = mfma16(__builtin_bit_cast(bf16x8, (u32x4){t4.x, t4.y, t5.x, t5.y}), pf, o[2]);
    o[3] = mfma16(__builtin_bit_cast(bf16x8, (u32x4){t6.x, t6.y, t7.x, t7.y}), pf, o[3]);
}
__device__ __forceinline__ void attn_phase(KP p, LAS unsigned char* lds, int wv) {
    int tid_ = mk_tid(wv); asm volatile("" : "+v"(tid_)); const int tid = tid_, lane = tid & 63; int wave = wv; asm volatile("" : "+s"(wave));
    LAS float* imp = (LAS float*)lds;
    LAS float* obuf = (LAS float*)(lds + 65536);
    LAS int* sel = (LAS int*)(lds + 98304);
    const bf16_t* QA = (const bf16_t*)(p->ws + WS_QA); const bf16_t* QB = (const bf16_t*)(p->ws + WS_QB);
    const bf16_t* KA = (const bf16_t*)(p->ws + WS_KA); const bf16_t* VA = (const bf16_t*)(p->ws + WS_VA);
    const bf16_t* KS = (const bf16_t*)(p->ws + WS_KS); const bf16_t* KW = (const bf16_t*)(p->ws + WS_KW);
    const bf16_t* VST = (const bf16_t*)(p->ws + WS_VST); const bf16_t* VWT = (const bf16_t*)(p->ws + WS_VWT);
    const bf16_t* KC = (const bf16_t*)(p->ws + WS_KC); const bf16_t* VCT = (const bf16_t*)(p->ws + WS_VCT);
    const float* GATES = (const float*)(p->ws + WS_GATES);
    const unsigned short* IDX = (const unsigned short*)(p->ws + WS_IDX); const int* CNT = (const int*)(p->ws + WS_CNT);
    bf16_t* OA = (bf16_t*)(p->ws + WS_OA); bf16_t* OB = (bf16_t*)(p->ws + WS_OB);
    const int G_ = mk_grid(), bid_ = mk_bid();
    const bool aff = (G_ & 1) == 0;
    int* SELG = (int*)(p->ws + WS_SEL);
#pragma unroll 1
    for (int it_ = 0; ; ++it_) {
        int tile;
        if (aff) { const int hw = G_ >> 1, li = bid_ >> 1; if (it_ * hw >= T / 32) break; tile = (bid_ & 1) * (T / 32) + hw * it_ + ((it_ & 1) ? (hw - 1 - li) : li); }
        else { tile = bid_ + G_ * it_; if (tile >= T / 16) break; }
        const int tg0 = tile * 16, b = tg0 >> 13, s0 = tg0 & (S - 1);
        __syncthreads();
        for (int i = tid; i < 8 * 16 * 128; i += 512) imp[i] = 0.f;
        __syncthreads();
        {
            int l2_ = lane; asm volatile("" : "+v"(l2_)); const int lc = l2_ & 15, kq = l2_ >> 4, krow0 = 8 * (lc >> 2) + (lc & 3);
            const int h = wave, g = h >> 2, bg = b * 2 + g;
            const int tq = s0 + lc;
            const bf16_t* qrow = QB + (size_t)(tg0 + lc) * 512 + h * 64 + 8 * kq;
            const bf16x8 q0 = *(const bf16x8*)qrow, q1 = *(const bf16x8*)(qrow + 32);
            const float g0 = GATES[(size_t)(tg0 + lc) * 24 + h * 3 + 0], g2 = GATES[(size_t)(tg0 + lc) * 24 + h * 3 + 2];
            f32x4 oc[4], ow[4];
#pragma unroll
            for (int dt = 0; dt < 4; ++dt) { oc[dt] = (f32x4){0.f, 0.f, 0.f, 0.f}; ow[dt] = oc[dt]; }
            if (s0 + 15 >= 31) {
                const int cmax = (s0 + 15 - 31) >> 4;
                const bf16_t* Kc = KC + (size_t)bg * 512 * 64; const bf16_t* Vc = VCT + (size_t)bg * 64 * 512;
                const int cq = tq >= 31 ? (tq - 31) >> 4 : -1;
                const int nst = cmax / 64 + 1;
                float m = -1e30f, l = 0.f;
                const StgW sw = stg_make(lds + 65536, Kc, Vc, 512, wave, lane);
                {
                    u32x4 pk0, pk1;
                    stg_ldk(sw, 0, pk0, pk1); stg_stk(sw, 0, pk0, pk1);
                    __syncthreads();
#pragma unroll 1
                    for (int st = 0; st < nst; ++st) {
                        const bool more = st + 1 < nst;
                        if (more) stg_ldk(sw, 64 * (st + 1), pk0, pk1);
                        bf16x8 kf[8]; stg_rdk(sw.gb + (st & 1) * 18432, krow0, kq, kf);
                        float s[16]; qk64(kf, q0, q1, s); const int kb = 64 * st; float mx = -1e30f;
                        const int dd = cq - kb - 8 * kq;
#pragma unroll
                        for (int i = 0; i < 16; i += 2) mx = fmax3(mx, VAL64(dd, 0x80000000u, i) ? s[i] : -1e30f, VAL64(dd, 0x80000000u, i + 1) ? s[i + 1] : -1e30f);
                        mx = fmax2(mx, __shfl_xor(mx, 16)); mx = fmax2(mx, __shfl_xor(mx, 32));
                        const float mn = fmax2(m, mx); float sum = 0.f;
#pragma unroll
                        for (int i = 0; i < 16; ++i) sum += VAL64(dd, 0x80000000u, i) ? ex2(s[i] - mn) : 0.f;
                        l = l * ex2(m - mn) + sum; m = mn;
                        if (more) stg_stk(sw, (st + 1) & 1, pk0, pk1);
                        __syncthreads();
                    }
                }
                l += __shfl_xor(l, 16); l += __shfl_xor(l, 32);
                const float inv = l > 0.f ? 1.f / l : 0.f;
                float carry = 0.f;
                u32x4 pk0, pk1, pv0, pv1;
                stg_ldk(sw, 0, pk0, pk1); stg_ldv(sw, 0, pv0, pv1); stg_stk(sw, 0, pk0, pk1); stg_stv(sw, 0, pv0, pv1);
                __syncthreads();
#pragma unroll 1
                for (int st = 0; st < nst; ++st) {
                    const int kb = 64 * st; bf16x8 kA[8], vA[8]; float s[16], pr[16];
                    const bool more = st + 1 < nst;
                    if (more) { stg_ldk(sw, kb + 64, pk0, pk1); stg_ldv(sw, kb + 64, pv0, pv1); }
                    stg_rdk(sw.gb + (st & 1) * 18432, krow0, kq, kA); stg_rdv(sw.gb + (st & 1) * 18432, lc, kq, vA);
                    qk64(kA, q0, q1, s);
#pragma unroll
                    for (int i = 0; i < 16; ++i) pr[i] = VAL64(cq - kb - 8 * kq, 0x80000000u, i) ? ex2(s[i] - m) * inv : 0.f;
                    u32x4 w0, w1;
                    w0.x = cvtpk(pr[0], pr[1]); w0.y = cvtpk(pr[2], pr[3]); w0.z = cvtpk(pr[4], pr[5]); w0.w = cvtpk(pr[6], pr[7]);
                    w1.x = cvtpk(pr[8], pr[9]); w1.y = cvtpk(pr[10], pr[11]); w1.z = cvtpk(pr[12], pr[13]); w1.w = cvtpk(pr[14], pr[15]);
                    pv64(vA, __builtin_bit_cast(bf16x8, w0), __builtin_bit_cast(bf16x8, w1), oc);
#pragma unroll
                    for (int gr = 0; gr < 2; ++gr) {
                        const float p7 = pr[8 * gr + 7];
                        const float up = __shfl_up(p7, 16);
                        const float wrap = __shfl_down(p7, 48);
                        const float prev = kq == 0 ? carry : up;
                        carry = wrap;
                        const float e0 = (pr[8 * gr + 0] + pr[8 * gr + 1]) + (pr[8 * gr + 2] + pr[8 * gr + 3]) + prev;
                        const float e1 = (pr[8 * gr + 4] + pr[8 * gr + 5]) + (pr[8 * gr + 6] + pr[8 * gr + 7]) + pr[8 * gr + 3];
                        const int n0 = (kb + 32 * gr) / 4 + 2 * kq;
                        imp[(h * 16 + lc) * 128 + n0] = e0; imp[(h * 16 + lc) * 128 + n0 + 1] = e1;
                    }
                    if (more) { stg_stk(sw, (st + 1) & 1, pk0, pk1); stg_stv(sw, (st + 1) & 1, pv0, pv1); }
                    __syncthreads();
                }
            }
            {
                const bf16_t* Kw = KW + (size_t)bg * S * 64; const bf16_t* Vw = VWT + (size_t)bg * 64 * LDV;
                float m = -1e30f, l = 0.f;
                const int kb0 = s0 >= 512 ? s0 - 512 : 0;
                const WinF wf{kb0, tq, kq, s0};
                window_lds(lds + 65536, Kw, Vw, kb0, (s0 + 16 - kb0 + 63) >> 6, wave, lane, lc, kq, krow0, wf, q0, q1, m, l, ow);
                l += __shfl_xor(l, 16); l += __shfl_xor(l, 32);
                const float inv = l > 0.f ? g2 / l : 0.f;
#pragma unroll
                for (int dt = 0; dt < 4; ++dt) { const f32x4 o = oc[dt] * g0 + ow[dt] * inv; *(LAS f32x4*)(obuf + lc * 512 + h * 64 + 16 * dt + 4 * kq) = o; }
            }
        }
        __syncthreads();
#pragma unroll 1
        for (int rr = 0; rr < 4; ++rr) {
            const int row = wave * 4 + rr, q = row >> 1, g = row & 1, tq = s0 + q, cur = tq >> 6;
            LAS unsigned long long* kbuf = (LAS unsigned long long*)(lds + 100352 + wave * 1024);
            unsigned long long key[2];
#pragma unroll
            for (int hf = 0; hf < 2; ++hf) { const int n = lane + 64 * hf;
                float v = ((imp[((4 * g + 0) * 16 + q) * 128 + n] + imp[((4 * g + 1) * 16 + q) * 128 + n]) + imp[((4 * g + 2) * 16 + q) * 128 + n]) + imp[((4 * g + 3) * 16 + q) * 128 + n];
                if (n == 0 || n == cur) v = 1e4f; else if (64 * n > tq) v = -1.f;
                unsigned u = __builtin_bit_cast(unsigned, v); u = (u & 0x80000000u) ? ~u : (u | 0x80000000u);
                key[hf] = ((unsigned long long)u << 32) | (unsigned)(127 - n); }
            LDS_WAIT();
            kbuf[lane] = key[0]; kbuf[lane + 64] = key[1];
            LDS_WAIT();
            int r0 = 0, r1 = 0;
#pragma unroll 16
            for (int mI = 0; mI < 128; ++mI) { const unsigned long long k = kbuf[mI]; r0 += k > key[0] ? 1 : 0; r1 += k > key[1] ? 1 : 0; }
            if (r0 < 16) { sel[row * 16 + r0] = lane; SELG[((size_t)tile * 32 + row) * 16 + r0] = lane; }
            if (r1 < 16) { sel[row * 16 + r1] = lane + 64; SELG[((size_t)tile * 32 + row) * 16 + r1] = lane + 64; }
        }
        __syncthreads();
        {
            int l2_ = lane; asm volatile("" : "+v"(l2_)); const int lc = l2_ & 15, kq = l2_ >> 4, krow0 = 8 * (lc >> 2) + (lc & 3);
            const size_t tgA = (size_t)tg0 + wave * 2, tgB = tgA + 1;
            const bf16_t* qrA = QA + tgA * 512 + (lc & 7) * 64 + 8 * kq; const bf16_t* qrB = qrA + 512;
            const bf16x8 qA0 = *(const bf16x8*)qrA, qA1 = *(const bf16x8*)(qrA + 32), qB0 = *(const bf16x8*)qrB, qB1 = *(const bf16x8*)(qrB + 32);
            const int cntA = CNT[tgA], cntB = CNT[tgB], cmaxq = cntA > cntB ? cntA : cntB;
            const unsigned short* idxA = IDX + tgA * 256; const unsigned short* idxB = IDX + tgB * 256;
            const bf16_t* Kb = KA + (size_t)b * S * 64; const bf16_t* Vb = VA + (size_t)b * S * 64;
            LAS unsigned char* vregA = lds + 108544 + wave * 4608; LAS unsigned char* vregB = lds + wave * 4608;
            f32x4 oA[4], oB[4];
#pragma unroll
            for (int dt = 0; dt < 4; ++dt) { oA[dt] = (f32x4){0.f, 0.f, 0.f, 0.f}; oB[dt] = oA[dt]; }
            float mA = -1e30f, lA = 0.f, mB = -1e30f, lB = 0.f;
#pragma unroll 1
            for (int sb = 0; sb < 256; sb += 32) {
                if (sb >= cmaxq) break;
                DsaL LA, LB;
                dsa_load(idxA, sb, krow0, kq, lane, Kb, Vb, LA); dsa_load(idxB, sb, krow0, kq, lane, Kb, Vb, LB);
                __builtin_amdgcn_sched_barrier(0);
                dsa_compute(LA, qA0, qA1, cntA - sb - 8 * kq, mA, lA, oA, vregA, lane, lc, kq);
                dsa_compute(LB, qB0, qB1, cntB - sb - 8 * kq, mB, lB, oB, vregB, lane, lc, kq);
            }
            lA += __shfl_xor(lA, 16); lA += __shfl_xor(lA, 32); lB += __shfl_xor(lB, 16); lB += __shfl_xor(lB, 32);
            const float invA = lA > 0.f ? 1.f / lA : 0.f, invB = lB > 0.f ? 1.f / lB : 0.f;
            if (lc < 8) {
#pragma unroll
                for (int dt = 0; dt < 4; ++dt) { const f32x4 va = oA[dt] * invA, vb = oB[dt] * invB; u32x2 wa, wb; wa.x = pk2(va[0], va[1]); wa.y = pk2(va[2], va[3]); wb.x = pk2(vb[0], vb[1]); wb.y = pk2(vb[2], vb[3]);
                    *(u32x2*)(OA + tgA * 1024 + lc * 64 + 16 * dt + 4 * kq) = wa; *(u32x2*)(OA + tgB * 1024 + lc * 64 + 16 * dt + 4 * kq) = wb; }
            }
        }
        __syncthreads();
#pragma unroll
        for (int i = 0; i < 2; ++i) { const int e = (i * 512 + tid) * 8;
            const f32x4 a = *(const LAS f32x4*)(obuf + e), c = *(const LAS f32x4*)(obuf + e + 4);
            u32x4 w; w.x = pk2(a[0], a[1]); w.y = pk2(a[2], a[3]); w.z = pk2(c[0], c[1]); w.w = pk2(c[2], c[3]);
            *(u32x4*)(OA + (size_t)(tg0 + (e >> 9)) * 1024 + 512 + (e & 511)) = w; }
    }
}

struct SetSt { bf16x8 q0, q1; float m, l; f32x4 o[4]; unsigned long long mlo, mhi; int tq, tqmin; };
__device__ __forceinline__ void set_step(SetSt& st, const bf16x8 (&KC)[8], const bf16x8 (&vA)[8], int kbc, int kq) {
    const int n = kbc >> 6; const unsigned long long mw = n < 64 ? st.mlo : st.mhi; const bool mem = (mw >> (n & 63)) & 1ull;
    const unsigned long long bm = __ballot(mem);
    if (bm != 0ull) {
        float s[16]; qk64(KC, st.q0, st.q1, s); bf16x8 pf0, pf1;
        if (bm == ~0ull && kbc + 63 <= st.tqmin) sm64<true>(s, 0, 0u, st.m, st.l, st.o, pf0, pf1);
        else sm64<false>(s, mem ? st.tq - kbc - 8 * kq : -1, 0x80000000u, st.m, st.l, st.o, pf0, pf1);
        pv64(vA, pf0, pf1, st.o);
    }
}
__device__ __forceinline__ void attn_sel_phase_walk(KP p, LAS unsigned char* lds, int wv, const bool dummy, const bool nowrite = false) {
    int tid_ = mk_tid(wv); asm volatile("" : "+v"(tid_)); const int lane = tid_ & 63; int wave = wv; asm volatile("" : "+s"(wave));
    const bf16_t* QB = (const bf16_t*)(p->ws + WS_QB); const bf16_t* KS = (const bf16_t*)(p->ws + WS_KS); const bf16_t* VST = (const bf16_t*)(p->ws + WS_VST);
    const float* GATES = (const float*)(p->ws + WS_GATES); const int* SELG = (const int*)(p->ws + WS_SEL); bf16_t* OB = (bf16_t*)(p->ws + WS_OA);
    LAS int* list = (LAS int*)(lds + wave * 512);
    const int G_ = mk_grid(), bid_ = mk_bid();
    const bool aff2 = (G_ & 3) == 0 && ((T / 32) % (G_ >> 2)) == 0 && (((T / 32) / (G_ >> 2)) & 3) == 0;
    const int npass = aff2 ? ((T / 32) / (G_ >> 2)) / 4 : (T / 32 + G_ - 1) / G_;
#pragma unroll 1
    for (int ps = 0; ps < npass; ++ps) {
        int l2_ = lane; asm volatile("" : "+v"(l2_)); const int lc = l2_ & 15, kq = l2_ >> 4, krow0 = 8 * (lc >> 2) + (lc & 3);
        int tile, g, half;
        if (aff2) { const int nb = G_ >> 2, jb = bid_ >> 2, k = 4 * ps + (wave >> 1);
            tile = (bid_ & 1) * (T / 32) + nb * k + ((k & 1) ? (nb - 1 - jb) : jb); g = (bid_ >> 1) & 1; half = wave & 1; }
        else { const int tp = ps * G_ + ((ps & 1) ? (G_ - 1 - bid_) : bid_); if (tp >= T / 32) continue;
            tile = 2 * tp + (wave >> 2); g = (wave >> 1) & 1; half = wave & 1; }
        const int tg0 = tile * 16, b = tg0 >> 13, s0 = tg0 & (S - 1), bg = b * 2 + g, hh = 4 * g + (lc & 3);
        SetSt st[2];
#pragma unroll
        for (int si = 0; si < 2; ++si) {
            const int q = 8 * half + 4 * si + (lc >> 2), row = q * 2 + g;
            unsigned mk0 = 0u, mk1 = 0u, mk2 = 0u, mk3 = 0u;
            const int* sp = SELG + ((size_t)tile * 32 + row) * 16;
#pragma unroll
            for (int c4 = 0; c4 < 4; ++c4) { const u32x4 v = *(const u32x4*)(sp + 4 * c4); const unsigned va[4] = {v.x, v.y, v.z, v.w};
#pragma unroll
                for (int j = 0; j < 4; ++j) { const unsigned n = dummy ? 0u : va[j], bit = 1u << (n & 31u), w = n >> 5;
                    mk0 |= w == 0u ? bit : 0u; mk1 |= w == 1u ? bit : 0u; mk2 |= w == 2u ? bit : 0u; mk3 |= w == 3u ? bit : 0u; } }
            st[si].mlo = (unsigned long long)mk0 | ((unsigned long long)mk1 << 32); st[si].mhi = (unsigned long long)mk2 | ((unsigned long long)mk3 << 32);
            st[si].tq = s0 + q; st[si].tqmin = s0 + 8 * half + 4 * si;
            const bf16_t* qrow = QB + (size_t)(tg0 + q) * 512 + hh * 64 + 8 * kq;
            st[si].q0 = *(const bf16x8*)qrow; st[si].q1 = *(const bf16x8*)(qrow + 32);
            st[si].m = -1e30f; st[si].l = 0.f;
#pragma unroll
            for (int dt = 0; dt < 4; ++dt) st[si].o[dt] = (f32x4){0.f, 0.f, 0.f, 0.f};
        }
        unsigned long long Ulo = 0ull, Uhi = 0ull;
#pragma unroll
        for (int si = 0; si < 2; ++si)
#pragma unroll
            for (int j = 0; j < 4; ++j) {
                Ulo |= (unsigned long long)(unsigned)__builtin_amdgcn_readlane((int)(unsigned)st[si].mlo, 4 * j) | ((unsigned long long)(unsigned)__builtin_amdgcn_readlane((int)(unsigned)(st[si].mlo >> 32), 4 * j) << 32);
                Uhi |= (unsigned long long)(unsigned)__builtin_amdgcn_readlane((int)(unsigned)st[si].mhi, 4 * j) | ((unsigned long long)(unsigned)__builtin_amdgcn_readlane((int)(unsigned)(st[si].mhi >> 32), 4 * j) << 32);
            }
        LDS_WAIT();
        const unsigned long long ltm = (1ull << lane) - 1ull;
        const int c0 = __popcll(Ulo), cntu = c0 + __popcll(Uhi);
        if ((Ulo >> lane) & 1ull) list[__popcll(Ulo & ltm)] = lane;
        if ((Uhi >> lane) & 1ull) list[c0 + __popcll(Uhi & ltm)] = 64 + lane;
        LDS_WAIT();
        const int listv = list[lane], listv2 = list[64 + lane];
        LDS_WAIT();
        const bf16_t* Ks = KS + (size_t)bg * S * 64; const bf16_t* Vs = VST + (size_t)bg * 64 * LDV;
        {
            bf16x8 kA[8], kB[8], vA[8];
#define LISTKB(i) (64 * ((i) < 64 ? __builtin_amdgcn_readlane(listv, (i)) : __builtin_amdgcn_readlane(listv2, (i) - 64)))
            int kbc = LISTKB(0);
            load_k64(Ks, kbc, krow0, kq, kA);
#define SEL_STEP(KC, KN, idx) { \
            int kbn = kbc; const bool more = (idx) + 1 < cntu; \
            load_v64(Vs, LDV, kbc, lc, kq, vA); \
            if (more) { kbn = LISTKB((idx) + 1); load_k64(Ks, kbn, krow0, kq, KN); } \
            __builtin_amdgcn_sched_barrier(0); \
            set_step(st[0], KC, vA, kbc, kq); set_step(st[1], KC, vA, kbc, kq); \
            kbc = kbn; __builtin_amdgcn_sched_barrier(0); }
#pragma unroll 1
            for (int i = 0; i < cntu; i += 2) {
                SEL_STEP(kA, kB, i)
                if (i + 1 < cntu) SEL_STEP(kB, kA, i + 1)
            }
#undef SEL_STEP
#undef LISTKB
        }
#pragma unroll
        for (int si = 0; si < 2; ++si) {
            const int q = 8 * half + 4 * si + (lc >> 2);
            float l = st[si].l; l += __shfl_xor(l, 16); l += __shfl_xor(l, 32);
            const float g1 = GATES[(size_t)(tg0 + q) * 24 + hh * 3 + 1];
            const float inv = l > 0.f ? g1 / l : 0.f;
            if ((!dummy && !nowrite) || l == -1.f) {
#pragma unroll
                for (int dt = 0; dt < 4; ++dt) { bf16_t* dst = OB + (size_t)(tg0 + q) * 1024 + 512 + hh * 64 + 16 * dt + 4 * kq; const u32x2 ow = *(const u32x2*)dst;
                    const f32x4 v = st[si].o[dt] * inv; u32x2 w; w.x = pk2(bflo(ow.x) + v[0], bfhi(ow.x) + v[1]); w.y = pk2(bflo(ow.y) + v[2], bfhi(ow.y) + v[3]); *(u32x2*)dst = w; }
            }
        }
    }
}

__device__ __forceinline__ void attn_sel_phase(KP p, LAS unsigned char* lds, int wv, const bool dummy, const bool nowrite = false) {
    const int G_ = mk_grid(), bid_ = mk_bid();
    const bool aff2 = (G_ & 3) == 0 && ((T / 32) % (G_ >> 2)) == 0 && (((T / 32) / (G_ >> 2)) & 3) == 0;
    if (!aff2 || dummy) { attn_sel_phase_walk(p, lds, wv, dummy, nowrite); return; }
    int tid_ = mk_tid(wv); asm volatile("" : "+v"(tid_)); const int lane = tid_ & 63; int wave = wv; asm volatile("" : "+s"(wave));
    const bf16_t* QB = (const bf16_t*)(p->ws + WS_QB); const bf16_t* KS = (const bf16_t*)(p->ws + WS_KS); const bf16_t* VST = (const bf16_t*)(p->ws + WS_VST);
    const float* GATES = (const float*)(p->ws + WS_GATES); const int* SELG = (const int*)(p->ws + WS_SEL); bf16_t* OB = (bf16_t*)(p->ws + WS_OA);
    const int nb = G_ >> 2, jb = bid_ >> 2, b = bid_ & 1, g = (bid_ >> 1) & 1, bg = b * 2 + g;
    const int npass = ((T / 32) / nb) / 4;
    const bf16_t* Ks = KS + (size_t)bg * S * 64; const bf16_t* Vs = VST + (size_t)bg * 64 * LDV;
    const int srow = 8 * wave + (lane >> 3), sch = lane & 7;
    const bf16_t* kgp = Ks + (size_t)srow * 64 + 8 * sch;
    const bf16_t* vgp = Vs + (size_t)srow * LDV + 8 * sch;
    const int wofs = srow * 144 + 16 * sch;
#pragma unroll 1
    for (int ps = 0; ps < npass; ++ps) {
        int l2_ = lane; asm volatile("" : "+v"(l2_)); const int lc = l2_ & 15, kq = l2_ >> 4, krow0 = 8 * (lc >> 2) + (lc & 3);
        const int k = 4 * ps + (wave >> 1), half = wave & 1;
        const int tile = b * (T / 32) + nb * k + ((k & 1) ? (nb - 1 - jb) : jb);
        const int tg0 = tile * 16, s0 = tg0 & (S - 1), hh = 4 * g + (lc & 3);
        const int k3 = 4 * ps + 3, s0max = 16 * (nb * k3 + ((k3 & 1) ? (nb - 1 - jb) : jb));
        const int nsteps = ((s0max + 15) >> 6) + 1;
        SetSt st[2];
#pragma unroll
        for (int si = 0; si < 2; ++si) {
            const int q = 8 * half + 4 * si + (lc >> 2), row = q * 2 + g;
            unsigned mk0 = 0u, mk1 = 0u, mk2 = 0u, mk3 = 0u;
            const int* sp = SELG + ((size_t)tile * 32 + row) * 16;
#pragma unroll
            for (int c4 = 0; c4 < 4; ++c4) { const u32x4 v = *(const u32x4*)(sp + 4 * c4); const unsigned va[4] = {v.x, v.y, v.z, v.w};
#pragma unroll
                for (int j = 0; j < 4; ++j) { const unsigned n = va[j], bit = 1u << (n & 31u), w = n >> 5;
                    mk0 |= w == 0u ? bit : 0u; mk1 |= w == 1u ? bit : 0u; mk2 |= w == 2u ? bit : 0u; mk3 |= w == 3u ? bit : 0u; } }
            st[si].mlo = (unsigned long long)mk0 | ((unsigned long long)mk1 << 32); st[si].mhi = (unsigned long long)mk2 | ((unsigned long long)mk3 << 32);
            st[si].tq = s0 + q; st[si].tqmin = s0 + 8 * half + 4 * si;
            const bf16_t* qrow = QB + (size_t)(tg0 + q) * 512 + hh * 64 + 8 * kq;
            st[si].q0 = *(const bf16x8*)qrow; st[si].q1 = *(const bf16x8*)(qrow + 32);
            st[si].m = -1e30f; st[si].l = 0.f;
#pragma unroll
            for (int dt = 0; dt < 4; ++dt) st[si].o[dt] = (f32x4){0.f, 0.f, 0.f, 0.f};
        }
        unsigned long long Ulo = 0ull, Uhi = 0ull;
#pragma unroll
        for (int si = 0; si < 2; ++si)
#pragma unroll
            for (int j = 0; j < 4; ++j) {
                Ulo |= (unsigned long long)(unsigned)__builtin_amdgcn_readlane((int)(unsigned)st[si].mlo, 4 * j) | ((unsigned long long)(unsigned)__builtin_amdgcn_readlane((int)(unsigned)(st[si].mlo >> 32), 4 * j) << 32);
                Uhi |= (unsigned long long)(unsigned)__builtin_amdgcn_readlane((int)(unsigned)st[si].mhi, 4 * j) | ((unsigned long long)(unsigned)__builtin_amdgcn_readlane((int)(unsigned)(st[si].mhi >> 32), 4 * j) << 32);
            }
        u32x4 pk, pv;
        __syncthreads();
        pk = *(const u32x4*)kgp; pv = *(const u32x4*)vgp;
        *(LAS u32x4*)(lds + wofs) = pk; *(LAS u32x4*)(lds + 9216 + wofs) = pv;
        __syncthreads();
#pragma unroll 1
        for (int n = 0; n < nsteps; ++n) {
            const int kbc = 64 * n; const bool more = n + 1 < nsteps;
            if (more) { pk = *(const u32x4*)(kgp + (size_t)(kbc + 64) * 64); pv = *(const u32x4*)(vgp + kbc + 64); }
            const bool mine = ((n < 64 ? Ulo : Uhi) >> (n & 63)) & 1ull;
            if (mine) {
                const LAS unsigned char* bb = lds + (n & 1) * 18432;
                bf16x8 kf[8], vf[8]; stg_rdk(bb, krow0, kq, kf); stg_rdv(bb, lc, kq, vf);
                set_step(st[0], kf, vf, kbc, kq); set_step(st[1], kf, vf, kbc, kq);
            }
            if (more) { LAS unsigned char* nbuf = lds + ((n + 1) & 1) * 18432; *(LAS u32x4*)(nbuf + wofs) = pk; *(LAS u32x4*)(nbuf + 9216 + wofs) = pv; }
            __syncthreads();
        }
#pragma unroll
        for (int si = 0; si < 2; ++si) {
            const int q = 8 * half + 4 * si + (lc >> 2);
            float l = st[si].l; l += __shfl_xor(l, 16); l += __shfl_xor(l, 32);
            const float g1 = GATES[(size_t)(tg0 + q) * 24 + hh * 3 + 1];
            const float inv = l > 0.f ? g1 / l : 0.f;
            if (!nowrite || l == -1.f) {
#pragma unroll
                for (int dt = 0; dt < 4; ++dt) { bf16_t* dst = OB + (size_t)(tg0 + q) * 1024 + 512 + hh * 64 + 16 * dt + 4 * kq; const u32x2 ow = *(const u32x2*)dst;
                    const f32x4 v = st[si].o[dt] * inv; u32x2 w; w.x = pk2(bflo(ow.x) + v[0], bfhi(ow.x) + v[1]); w.y = pk2(bflo(ow.y) + v[2], bfhi(ow.y) + v[3]); *(u32x2*)dst = w; }
            }
        }
    }
}

#define XB_TMO      128
#define XB_XCNT(j)  (256  + 64 * (j))
#define XB_XSUB(j)  (1280 + 64 * (j))
#define XB_XGEN(j)  (2304 + 64 * (j))
#define XB_TOP      3328
#define XB_TOPGEN   3392
#define XCD_BAR_WORDS 3456
#define XB_SPIN_CAP (1u << 18)

__device__ __forceinline__ unsigned xb_ld(unsigned* p)              { return __hip_atomic_load(p, __ATOMIC_RELAXED, __HIP_MEMORY_SCOPE_AGENT); }
__device__ __forceinline__ unsigned xb_add(unsigned* p, unsigned v) { return __hip_atomic_fetch_add(p, v, __ATOMIC_RELAXED, __HIP_MEMORY_SCOPE_AGENT); }
__device__ __forceinline__ unsigned xb_xcc_id() { return (unsigned)__builtin_amdgcn_s_getreg((3 << 11) | 20) & 0xFu; }
#define XB_SPIN(cond, bar) do { unsigned _sp = 0; while (cond) { __builtin_amdgcn_s_sleep(1); \
    if ((++_sp & 255u) == 0u) { if (xb_ld(&(bar)[XB_TMO])) break; if (_sp > XB_SPIN_CAP) { atomicAdd(&(bar)[XB_TMO], 1u); break; } } } } while (0)

struct XcdBarrier {
    unsigned* bar; unsigned x;
    volatile LAS unsigned* st;
};

__device__ __forceinline__ XcdBarrier xcd_barrier_post(unsigned* bar, volatile LAS unsigned* st, int tid) {
    XcdBarrier b; b.bar = bar; b.x = xb_xcc_id(); b.st = st;
    if (tid == 0) (void)xb_add(&bar[XB_XCNT(b.x)], 1u);
    return b;
}
__device__ __forceinline__ void xcd_barrier_complete(unsigned* bar, unsigned x, unsigned& nloc, unsigned& nx) {
    const unsigned G = gridDim.x * gridDim.y * gridDim.z;
    unsigned sum, cnt, mine, sp = 0u;
    for (;;) {
        sum = 0u; cnt = 0u; mine = 0u;
#pragma unroll
        for (unsigned j = 0; j < 16; ++j) { const unsigned c = xb_ld(&bar[XB_XCNT(j)]); sum += c; cnt += (c > 0u) ? 1u : 0u; mine = (j == x) ? c : mine; }
        if (sum == G) break;
        __builtin_amdgcn_s_sleep(1);
        if ((++sp & 255u) == 0u) { if (xb_ld(&bar[XB_TMO])) break; if (sp > XB_SPIN_CAP) { atomicAdd(&bar[XB_TMO], 1u); break; } }
    }
    nloc = mine > 0u ? mine : 1u; nx = cnt > 0u ? cnt : 1u;
}

__device__ __forceinline__ void xcd_barrier(const XcdBarrier& b, int tid) {
    asm volatile("s_waitcnt vmcnt(0)" ::: "memory");
    __syncthreads();
    if (tid == 0) {
        unsigned* bar = b.bar;
        __builtin_amdgcn_s_waitcnt(0);
        unsigned nloc = b.st[0], nx = b.st[1];
        if (nloc == 0u) { xcd_barrier_complete(bar, b.x, nloc, nx); b.st[0] = nloc; b.st[1] = nx; }
        const unsigned old = xb_add(&bar[XB_XSUB(b.x)], 1u);
        const unsigned gen = old / nloc;
        if (old + 1u == (gen + 1u) * nloc) {
            __builtin_amdgcn_fence(__ATOMIC_RELEASE, "agent");
            asm volatile("s_waitcnt vmcnt(0)" ::: "memory");
            const unsigned og = xb_add(&bar[XB_TOP], 1u);
            const unsigned tg = og / nx;
            if (og + 1u == (tg + 1u) * nx) xb_add(&bar[XB_TOPGEN], 1u);
            else XB_SPIN(xb_ld(&bar[XB_TOPGEN]) == tg, bar);
            __builtin_amdgcn_fence(__ATOMIC_ACQUIRE, "agent");
            xb_add(&bar[XB_XGEN(b.x)], 1u);
            asm volatile("s_waitcnt vmcnt(0)" ::: "memory");
        } else {
            XB_SPIN(xb_ld(&bar[XB_XGEN(b.x)]) == gen, bar);
            __builtin_amdgcn_fence(__ATOMIC_ACQUIRE, "agent");
            asm volatile("s_waitcnt vmcnt(0)" ::: "memory");
        }
    }
    __syncthreads();
}

__global__ void __launch_bounds__(512, 2) mk_fwd(P pv) {
    extern __shared__ __attribute__((aligned(16))) unsigned char lds_raw[];
    LAS unsigned char* lds = (LAS unsigned char*)lds_raw;
    cg::grid_group grid = cg::this_grid();
    const int wv = __builtin_amdgcn_readfirstlane((int)(threadIdx.x >> 6));
    if (threadIdx.x < 2) ((LAS unsigned*)(lds + LDS_BARST))[threadIdx.x] = 0u;
    __syncthreads();
    (void)xcd_barrier_post((unsigned*)(pv.ws + WS_BAR), (volatile LAS unsigned*)(lds + LDS_BARST), (int)threadIdx.x);
#define GRID_BAR() do { KP pb_ = (KP)__builtin_amdgcn_kernarg_segment_ptr(); asm volatile("" : "+s"(pb_)); XcdBarrier xb_; xb_.bar = (unsigned*)(pb_->ws + WS_BAR); xb_.x = xb_xcc_id(); xb_.st = (volatile LAS unsigned*)(lds + LDS_BARST); xcd_barrier(xb_, mk_tid(wv)); } while (0)
    for (int ph = pv.ph_lo; ph < pv.ph_hi; ++ph) {
        if (ph > pv.ph_lo) { if (ph == 1) grid.sync(); else GRID_BAR(); }
        KP p = (KP)__builtin_amdgcn_kernarg_segment_ptr();
        asm volatile("" : "+s"(p));
        unsigned char* ws = p->ws;
        float* X = (float*)(ws + WS_X); float* SS = (float*)(ws + WS_SSP);
        bf16_t* XG = (bf16_t*)(ws + WS_XG); bf16_t* XGB = (bf16_t*)(ws + WS_XGB);
        bf16_t* Z = (bf16_t*)(ws + WS_Z); bf16_t* U = (bf16_t*)(ws + WS_U); bf16_t* PP = (bf16_t*)(ws + WS_PP); bf16_t* MERGED = (bf16_t*)(ws + WS_MERGED);
        const float* BIAS = (const float*)(ws + WS_BIAS);
#if defined(PROBE_SYNC)
        if (ph == 1) { for (int i_ = 0; i_ < 50; ++i_) GRID_BAR(); }
#endif
        if (ph == 0) { prologue_phase(p, lds, wv);
#if defined(PROBE_PRO2)
            prologue_phase(p, lds, wv);
#endif
            continue; }
        if (ph == NPH - 1) {
            const float* ssf = SS + (size_t)16 * T * 16; const float* gf = p->in[25];
            for (int o = mk_bid() * 512 + mk_tid(wv); o < T * D / 4; o += mk_grid() * 512) {
                const int r = o >> 8, c = (o & 255) * 4; const float rs = row_rs(ssf, r);
                const f32x4 v = *(const f32x4*)(X + (size_t)o * 4), g = *(const f32x4*)(gf + c);
                *(f32x4*)(p->out + (size_t)o * 4) = v * rs * g;
            }
            continue;
        }
        const int L = (ph - 1) / 12, j = (ph - 1) % 12;
        const bf16_t* WB = (const bf16_t*)(ws + ((L & 1) ? WS_WB1 : WS_WB0));
        switch (j) {
        case 0: {
            EpiSwiglu E{U, SS + (size_t)(4 * L + 0) * T * 16};
            run_gemm(lds, L == 0 ? XG : XGB, D, WB + WO_13A, T, 2 * FF, D, 0, E, wv);
#if defined(PROBE_GEMM2)
            run_gemm(lds, L == 0 ? XG : XGB, D, WB + WO_13A, T, 2 * FF, D, 0, E, wv);
#endif
        } break;
        case 1: {
            EpiResid<0> E{L == 0 ? p->in[0] : X, X, XG, p->in[6] + L * D, SS + (size_t)(4 * L + 1) * T * 16, 0.5f, nullptr, nullptr};
            run_gemm(lds, U, FF, WB + WO_2A, T, D, FF, 0, E, wv);
        } break;
        case 2: {
            EpiRow<0> E{Z, NZ, SS + (size_t)(4 * L + 1) * T * 16, nullptr, nullptr, 0};
            run_gemm(lds, XG, D, WB + WO_IN, T, NZ, D, 0, E, wv);
#if defined(PROBE_G_IN)
            run_gemm(lds, XG, D, WB + WO_IN, T, NZ, D, 0, E, wv);
#endif
        } break;
        case 3: post_phase(p, lds, wv);
#if defined(PROBE_MISC2)
            post_phase(p, lds, wv);
#endif
            break;
        case 4: {
            EpiRow<1> Ek{(bf16_t*)(ws + WS_HIDK), 256, nullptr, BIAS, nullptr, 0};
            run_gemm(lds, (const bf16_t*)(ws + WS_KCMP), 1024, WB + WO_CK, 2048, 256, 2048, 0, Ek, wv);
            EpiRow<1> Ev{(bf16_t*)(ws + WS_HIDV), 256, nullptr, BIAS + 256, nullptr, 0};
            run_gemm(lds, (const bf16_t*)(ws + WS_VCMP), 1024, WB + WO_CV, 2048, 256, 2048, 8, Ev, wv);
            indexer_phase(p, lds, L, wv, 0);
#if defined(PROBE_IDX2)
            indexer_phase(p, lds, L, wv, 32);
#endif
#if defined(PROBE_IDXSCORE)
            indexer_phase(p, lds, L, wv, 32, true);
#endif
        } break;
        case 5: {
            cmp2_phase(p, L, wv);
            if (L + 1 < DEPTH) convert_layer(p, L + 1, (bf16_t*)(ws + (((L + 1) & 1) ? WS_WB1 : WS_WB0)), lds, wv);
#if defined(PROBE_MISC2)
            cmp2_phase(p, L, wv);
            if (L + 1 < DEPTH) convert_layer(p, L + 1, (bf16_t*)(ws + (((L + 1) & 1) ? WS_WB1 : WS_WB0)), lds, wv);
#endif
        } break;
        case 6: attn_phase(p, lds, wv);
#if defined(PROBE_ATTNA2)
            attn_phase(p, lds, wv);
#endif
            GRID_BAR();
            attn_sel_phase(p, lds, wv, false);
#if defined(PROBE_SELDUMMY)
            attn_sel_phase(p, lds, wv, true);
#endif
#if defined(PROBE_SEL2)
            attn_sel_phase(p, lds, wv, false, true);
#endif
            break;
        case 7: {
            EpiMerge E{MERGED, Z};
            run_gemm(lds, (const bf16_t*)(ws + WS_OA), 1024, WB + WO_PA, T, 2048, 1024, 0, E, wv);
        } break;
        case 8: {
            EpiResid<0> E{X, X, XG, p->in[18] + L * D, SS + (size_t)(4 * L + 2) * T * 16, 1.0f, nullptr, nullptr};
            run_gemm(lds, MERGED, D, WB + WO_WO, T, D, D, 0, E, wv);
        } break;
        case 9: {
            EpiSwiglu E{U, SS + (size_t)(4 * L + 2) * T * 16};
            run_gemm(lds, XG, D, WB + WO_13B, T, 2 * FF, D, 0, E, wv);
            EpiRow<2> Ep{PP, D, nullptr, nullptr, nullptr, 0};
            run_gemm(lds, (const bf16_t*)(ws + WS_PBF) + (size_t)(L & 1) * T * PLE, PLE, WB + WO_PP, T, D, PLE, 0, Ep, wv);
        } break;
        case 10: {
            EpiResid<0> E{X, X, XG, p->in[22] + L * D, SS + (size_t)(4 * L + 3) * T * 16, 0.5f, nullptr, nullptr};
            run_gemm(lds, U, FF, WB + WO_2B, T, D, FF, 0, E, wv);
        } break;
        case 11: {
            EpiResid<1> E{X, X, XGB, L + 1 < DEPTH ? p->in[2] + (L + 1) * D : p->in[25], SS + (size_t)(4 * L + 4) * T * 16, 1.0f, SS + (size_t)(4 * L + 3) * T * 16, PP};
            run_gemm(lds, XG, D, WB + WO_PG, T, D, D, 0, E, wv);
        } break;
        }
    }
}

extern "C" void kernel_launch(void* const* d_in, const int* in_sizes, int n_in, void* d_out, int out_size, void* d_ws, size_t ws_size, hipStream_t stream) {
    static int grid = 0;
    if (grid == 0) {
        if (n_in != 26 || ws_size < WS_END) { fprintf(stderr, "kernel_launch: unexpected n_in %d / ws %zu\n", n_in, ws_size); grid = -1; return; }
        int dev = 0, cus = 0, per_cu = 0;
        hipGetDevice(&dev); hipDeviceGetAttribute(&cus, hipDeviceAttributeMultiprocessorCount, dev);
        if (hipFuncSetAttribute((const void*)mk_fwd, hipFuncAttributeMaxDynamicSharedMemorySize, LDS_BYTES) != hipSuccess) { fprintf(stderr, "hipFuncSetAttribute failed\n"); grid = -1; return; }
        if (hipOccupancyMaxActiveBlocksPerMultiprocessor(&per_cu, (const void*)mk_fwd, 512, LDS_BYTES) != hipSuccess || per_cu < 1) { fprintf(stderr, "occupancy query: %d\n", per_cu); per_cu = 1; }
        (void)hipGetLastError();
        grid = cus * 1;
    }
    if (grid < 0) return;
    hipMemsetAsync((char*)d_ws + WS_CTL, 0, CTL_BYTES, stream);
    P a{};
    for (int i = 0; i < 26; ++i) a.in[i] = (const float*)d_in[i];
    a.out = (float*)d_out; a.ws = (unsigned char*)d_ws;
#if MK_MULTI
    for (int ph = 0; ph < NPH; ++ph) { a.ph_lo = ph; a.ph_hi = ph + 1; hipLaunchKernelGGL(mk_fwd, dim3(grid), dim3(512), LDS_BYTES, stream, a); }
#else
    a.ph_lo = 0; a.ph_hi = NPH;
    void* args[] = {&a};
    hipError_t e = hipLaunchCooperativeKernel((const void*)mk_fwd, dim3(grid), dim3(512), args, LDS_BYTES, stream);
    if (e != hipSuccess) fprintf(stderr, "cooperative launch failed: %s (grid %d)\n", hipGetErrorString(e), grid);
#endif
}
```

```cpp
#include <hip/hip_runtime.h>
#include <hip/hip_cooperative_groups.h>
#include <cstdio>
#include <cstdint>
namespace cg = cooperative_groups;
#ifndef MK_MULTI
#define MK_MULTI 0
#endif
__device__ __forceinline__ int mk_tid(int wv) { int lane; asm volatile("v_mbcnt_lo_u32_b32 %0, -1, 0\n\tv_mbcnt_hi_u32_b32 %0, -1, %0" : "=v"(lane)); return lane + 64 * wv; }
__device__ __forceinline__ int mk_bid() { int b = blockIdx.x; asm volatile("" : "+s"(b)); return b; }
__device__ __forceinline__ int mk_grid() { int g = gridDim.x; asm volatile("" : "+s"(g)); return g; }
namespace pg8 {
#define PG8_LAS __attribute__((address_space(3)))
typedef unsigned short bf16_t;
typedef short bf16x8 __attribute__((ext_vector_type(8)));
typedef float f32x4 __attribute__((ext_vector_type(4)));
typedef unsigned u32x4 __attribute__((ext_vector_type(4)));
constexpr int BM = 256, BK = 64, HALF = 128, HTB = HALF * BK * 2  , STAGE_BYTES = 8 * HTB, NXCD = 8, WGM = 8;

__host__ __device__ __forceinline__ int lds_byte(int r, int c) { const int st = (r >> 4) * 2 + (c >> 5), rr = r & 15, cc = c & 31, ob = rr * 64 + cc * 2; return st * 1024 + (ob ^ (((ob >> 9) & 1) << 5)); }
__host__ __device__ __forceinline__ void stage_rc(int b, int& R, int& C) { const int st = b / 1024, sb = b % 1024, swz = sb ^ (((sb >> 9) & 1) << 5); R = (st >> 1) * 16 + swz / 64; C = (st & 1) * 32 + (swz % 64) / 2; }
__host__ __device__ __forceinline__ int perm32(int rho) { const int n = rho >> 4, i = rho & 15; return 8 * (i >> 2) + 4 * n + (i & 3); }

struct Unit { int pm, pn; };
struct Gemm { const bf16_t* A; const bf16_t* Bt; int M, N, K, lda; };

struct StaticOrder {
    int nM, nN, nwg, G, c;
    __host__ __device__ void init(int M, int N, int G_, int c_) { nM = M / BM; nN = N / BM; nwg = nM * nN; G = G_; c = c_; }
    __host__ __device__ bool next(int i, Unit& u) const {
        const long L = (long)i * G + c; if (L >= nwg) return false;
        int wgid = (int)L; { const int q = nwg / NXCD, r = nwg % NXCD, xcd = wgid % NXCD, off = wgid / NXCD; wgid = (xcd < r ? xcd * (q + 1) : r * (q + 1) + (xcd - r) * q) + off; }
        const int nig = WGM * nN, gid = wgid / nig, fm = gid * WGM, gsz = (nM - fm) < WGM ? (nM - fm) : WGM;
        u.pm = fm + ((wgid % nig) % gsz); u.pn = (wgid % nig) / gsz; return true;
    }
    __device__ __forceinline__ void a_ready(const Unit&) const {}
    __device__ __forceinline__ void done(const Unit&) const {}
};

__device__ __forceinline__ unsigned cvt_pk_bf16(float lo, float hi) { unsigned r; asm volatile("v_cvt_pk_bf16_f32 %0, %1, %2" : "=v"(r) : "v"(lo), "v"(hi)); return r; }
typedef float f32x2 __attribute__((ext_vector_type(2)));
template <class Epi, class Sched, bool ALIGN_EPI = false, bool SP2 = false>
__device__ __forceinline__ void gemm_phase(PG8_LAS unsigned char* lds, const Gemm g, const Sched& S, const Epi& E, int wv) {
    int wv_ = wv; asm volatile("" : "+s"(wv_)); int tid_ = mk_tid(wv_); asm volatile("" : "+v"(tid_)); const int tid = tid_, wid = wv_, lane = tid & 63, wr = wid >> 2, wc = wid & 3, fr = lane & 15, fq = lane >> 4;
    const int K = g.K, nt = K / BK;
    unsigned voffA[2], voffB[2];
#pragma unroll
    for (int i = 0; i < 2; ++i) { int R, C; stage_rc(tid * 16 + i * 8192, R, C); const int Rb = Epi::PERM ? ((R & ~31) + perm32(R & 31)) : R;
        voffA[i] = (unsigned)(R * g.lda + C) * 2u; voffB[i] = (unsigned)(Rb * K + C) * 2u; }
    const size_t kstep = (size_t)(BK * 2);
    const size_t hstepB = (size_t)HALF * K * 2, hstepA = (size_t)HALF * g.lda * 2;
    const size_t tstepA = 2 * hstepA, tstepB = 2 * hstepB;
    const unsigned ldsw = (unsigned)wid * 1024u;
    const int aoff = lds_byte(wr * 64 + fr, fq * 8), boff = lds_byte(wc * 32 + fr, fq * 8);
#define PG8_SA(b, h) (((b) * 2 + (h)) * HTB)
#define PG8_SB(b, h) ((4 + (b) * 2 + (h)) * HTB)
#define PG8_STAGE(bufoff, gbase, voff) do { _Pragma("unroll") for (int _i = 0; _i < 2; ++_i) \
        __builtin_amdgcn_global_load_lds((const unsigned*)((const char*)(gbase) + (voff)[_i]), (PG8_LAS unsigned*)(lds + (bufoff) + ldsw + _i * 8192), 16, 0, 0); } while (0)
#define PG8_LDA(dst, b, h) do { _Pragma("unroll") for (int m = 0; m < 4; ++m) _Pragma("unroll") for (int k = 0; k < 2; ++k) dst[m][k] = *(const PG8_LAS bf16x8*)(lds + PG8_SA(b, h) + aoff + m * 2048 + k * 1024); } while (0)
#define PG8_LDB(dst, b, h) do { _Pragma("unroll") for (int n = 0; n < 2; ++n) _Pragma("unroll") for (int k = 0; k < 2; ++k) dst[n][k] = *(const PG8_LAS bf16x8*)(lds + PG8_SB(b, h) + boff + n * 2048 + k * 1024); } while (0)
#define PG8_MMA(ai, bj, At, Bt) do { __builtin_amdgcn_s_setprio(1); _Pragma("unroll") for (int m = 0; m < 4; ++m) _Pragma("unroll") for (int n = 0; n < 2; ++n) _Pragma("unroll") for (int k = 0; k < 2; ++k) \
        acc[ai][bj][m][n] = __builtin_amdgcn_mfma_f32_16x16x32_bf16(Bt[n][k], At[m][k], acc[ai][bj][m][n], 0, 0, 0); __builtin_amdgcn_s_setprio(0); } while (0)
#define PG8_WAIT_V(n) asm volatile("s_waitcnt vmcnt(" #n ")" ::: "memory")
#define PG8_WAIT_L(n) asm volatile("s_waitcnt lgkmcnt(" #n ")" ::: "memory")
#define PG8_BAR __builtin_amdgcn_s_barrier()
#define PG8_SCHED __builtin_amdgcn_sched_barrier(0)
    Unit cur, nxt; int ui = 0;
    if (!S.next(0, cur)) return;
    f32x4 acc[2][2][4][2];
#pragma unroll
    for (int a = 0; a < 2; ++a)
#pragma unroll
        for (int b = 0; b < 2; ++b)
#pragma unroll
            for (int m = 0; m < 4; ++m)
#pragma unroll
                for (int n = 0; n < 2; ++n) acc[a][b][m][n] = (f32x4){0.f, 0.f, 0.f, 0.f};
    bf16x8 At[4][2], B0[2][2], B1[2][2];
    const char* cA = (const char*)g.A + (size_t)cur.pm * tstepA; const char* cB = (const char*)g.Bt + (size_t)cur.pn * tstepB;
    S.a_ready(cur);
    if constexpr (SP2) {
        PG8_STAGE(PG8_SB(0, 0), cB, voffB); PG8_STAGE(PG8_SB(0, 1), cB + hstepB, voffB); PG8_STAGE(PG8_SA(0, 0), cA, voffA); PG8_STAGE(PG8_SA(0, 1), cA + hstepA, voffA);
        if (wr == 1) PG8_BAR;
        PG8_WAIT_V(2); PG8_BAR;
        PG8_STAGE(PG8_SB(1, 0), cB + kstep, voffB); PG8_STAGE(PG8_SA(1, 0), cA + kstep, voffA); PG8_STAGE(PG8_SB(1, 1), cB + hstepB + kstep, voffB);
        PG8_WAIT_V(6); PG8_BAR;
    } else {
        PG8_STAGE(PG8_SB(0, 0), cB, voffB); PG8_STAGE(PG8_SA(0, 0), cA, voffA); PG8_STAGE(PG8_SB(0, 1), cB + hstepB, voffB); PG8_STAGE(PG8_SA(0, 1), cA + hstepA, voffA);
        if (wr == 1) PG8_BAR;
        PG8_WAIT_V(4); PG8_BAR;
        PG8_STAGE(PG8_SB(1, 0), cB + kstep, voffB); PG8_STAGE(PG8_SA(1, 0), cA + kstep, voffA); PG8_STAGE(PG8_SB(1, 1), cB + hstepB + kstep, voffB);
        PG8_WAIT_V(6); PG8_BAR;
    }
    for (;;) {
        const bool has_next = S.next(ui + 1, nxt);
        const char* nA = has_next ? (const char*)g.A + (size_t)nxt.pm * tstepA : cA; const char* nB = has_next ? (const char*)g.Bt + (size_t)nxt.pn * tstepB : cB;
        for (int t = 0; t < nt; t += 2) {
            const bool last = (t == nt - 2);
            const char* a1 = cA + (size_t)(t + 1) * kstep;
            const char* a2 = last ? nA : cA + (size_t)(t + 2) * kstep; const char* b2 = last ? nB : cB + (size_t)(t + 2) * kstep;
            const char* a3 = a2 + kstep; const char* b3 = b2 + kstep;
            if (last && has_next) S.a_ready(nxt);
            if constexpr (SP2) {
            PG8_LDB(B0, 0, 0); PG8_LDB(B1, 0, 1); PG8_SCHED; PG8_LDA(At, 0, 0); PG8_STAGE(PG8_SA(1, 1), a1 + hstepA, voffA);
            PG8_WAIT_V(8); PG8_WAIT_L(0); PG8_BAR; PG8_MMA(0, 0, At, B0); PG8_MMA(0, 1, At, B1); PG8_BAR; PG8_SCHED;
            PG8_LDA(At, 0, 1); PG8_STAGE(PG8_SB(0, 0), b2, voffB); PG8_STAGE(PG8_SB(0, 1), b2 + hstepB, voffB); PG8_STAGE(PG8_SA(0, 0), a2, voffA);
            PG8_WAIT_V(8); PG8_WAIT_L(0); PG8_BAR; PG8_MMA(1, 0, At, B0); PG8_MMA(1, 1, At, B1); PG8_BAR; PG8_SCHED;
            PG8_LDB(B0, 1, 0); PG8_LDB(B1, 1, 1); PG8_SCHED; PG8_LDA(At, 1, 0); PG8_STAGE(PG8_SA(0, 1), a2 + hstepA, voffA);
            PG8_WAIT_V(8); PG8_WAIT_L(0); PG8_BAR; PG8_MMA(0, 0, At, B0); PG8_MMA(0, 1, At, B1); PG8_BAR; PG8_SCHED;
            PG8_LDA(At, 1, 1); PG8_STAGE(PG8_SB(1, 0), b3, voffB); PG8_STAGE(PG8_SB(1, 1), b3 + hstepB, voffB); PG8_STAGE(PG8_SA(1, 0), a3, voffA);
            PG8_WAIT_V(8); PG8_WAIT_L(0); PG8_BAR; PG8_MMA(1, 0, At, B0); PG8_MMA(1, 1, At, B1); PG8_BAR; PG8_SCHED;
            } else {
            PG8_LDB(B0, 0, 0); PG8_SCHED; PG8_LDA(At, 0, 0); PG8_STAGE(PG8_SA(1, 1), a1 + hstepA, voffA);
            PG8_WAIT_L(8); PG8_BAR; PG8_WAIT_L(0); PG8_MMA(0, 0, At, B0); PG8_BAR; PG8_SCHED;
            PG8_LDB(B1, 0, 1); PG8_STAGE(PG8_SB(0, 0), b2, voffB);
            PG8_BAR; PG8_WAIT_L(0); PG8_MMA(0, 1, At, B1); PG8_BAR;
            PG8_LDA(At, 0, 1); PG8_STAGE(PG8_SA(0, 0), a2, voffA);
            PG8_BAR; PG8_WAIT_L(0); PG8_MMA(1, 0, At, B0); PG8_BAR; PG8_SCHED;
            PG8_STAGE(PG8_SB(0, 1), b2 + hstepB, voffB);
            PG8_WAIT_V(6); PG8_BAR; PG8_MMA(1, 1, At, B1); PG8_BAR;
            PG8_LDB(B0, 1, 0); PG8_SCHED; PG8_LDA(At, 1, 0); PG8_STAGE(PG8_SA(0, 1), a2 + hstepA, voffA);
            PG8_WAIT_L(8); PG8_BAR; PG8_WAIT_L(0); PG8_MMA(0, 0, At, B0); PG8_BAR; PG8_SCHED;
            PG8_LDB(B1, 1, 1); PG8_STAGE(PG8_SB(1, 0), b3, voffB);
            PG8_BAR; PG8_WAIT_L(0); PG8_MMA(0, 1, At, B1); PG8_BAR;
            PG8_LDA(At, 1, 1); PG8_STAGE(PG8_SA(1, 0), a3, voffA);
            PG8_BAR; PG8_WAIT_L(0); PG8_MMA(1, 0, At, B0); PG8_BAR; PG8_SCHED;
            PG8_STAGE(PG8_SB(1, 1), b3 + hstepB, voffB);
            PG8_WAIT_V(6); PG8_BAR; PG8_MMA(1, 1, At, B1); PG8_BAR;
            }
        }
        if constexpr (ALIGN_EPI) { if (wr == 0) PG8_BAR; }
        if constexpr (!Epi::AFTER_DRAIN) { const int l2_ = mk_tid(wv_) & 63; E(acc, cur, wr, wc, l2_ & 15, l2_ >> 4); S.done(cur); }
        if (!has_next) break;
#pragma unroll
        for (int a = 0; a < 2; ++a)
#pragma unroll
            for (int b = 0; b < 2; ++b)
#pragma unroll
                for (int m = 0; m < 4; ++m)
#pragma unroll
                    for (int n = 0; n < 2; ++n) acc[a][b][m][n] = (f32x4){0.f, 0.f, 0.f, 0.f};
        cur = nxt; cA = nA; cB = nB; ++ui;
        if constexpr (ALIGN_EPI) { if (wr == 1) PG8_BAR; }
    }
    PG8_WAIT_V(0);
    if constexpr (!ALIGN_EPI) { if (wr == 0) PG8_BAR; }
    PG8_BAR;
    if constexpr (Epi::AFTER_DRAIN) { E.fused(acc, cur, wr, wc, fr, fq, lds, wid, lane); S.done(cur); }
#undef PG8_SA
#undef PG8_SB
#undef PG8_STAGE
#undef PG8_LDA
#undef PG8_LDB
#undef PG8_MMA
#undef PG8_WAIT_V
#undef PG8_WAIT_L
#undef PG8_BAR
#undef PG8_SCHED
}
}

#define LAS __attribute__((address_space(3)))
typedef unsigned short bf16_t;
typedef short bf16x8 __attribute__((ext_vector_type(8)));
typedef float f32x4 __attribute__((ext_vector_type(4)));
typedef float f32x16 __attribute__((ext_vector_type(16)));
typedef unsigned u32x4 __attribute__((ext_vector_type(4)));
typedef unsigned u32x2 __attribute__((ext_vector_type(2)));

constexpr int T = 16384, S = 8192, D = 1024, FF = 2816, NZ = 4608, DEPTH = 4, PLE = 256;
constexpr float EPS = 1e-6f;
constexpr int LDV = S + 64;
constexpr int Z_QA = 0, Z_CKV = 512, Z_QI = 640, Z_KI = 896, Z_WI = 928, Z_QB = 936, Z_KVB = 1448, Z_GB = 2216, Z_GM = 2240, Z_KV = 4288;
constexpr int NPH = 50;

constexpr size_t MiB = 1u << 20;
constexpr size_t WS_CTL = 0, CTL_BYTES = 2 * MiB, WS_SS = 64 * 1024;
constexpr size_t WS_ROPE = 2 * MiB, WS_BIAS = 3 * MiB;
constexpr size_t WS_BAR = 16 * 1024;
constexpr int LDS_BARST = 147456 - 64;
constexpr size_t WS_X = 4 * MiB, WS_XG = 68 * MiB, WS_WB0 = 100 * MiB, WS_WB1 = 154 * MiB, WS_Z = 208 * MiB;
constexpr size_t WS_QA = 352 * MiB, WS_QB = 368 * MiB, WS_KA = 384 * MiB, WS_VA = 386 * MiB, WS_QI = 388 * MiB, WS_KI = 396 * MiB, WS_WI = 397 * MiB;
constexpr size_t WS_KCMP = 398 * MiB, WS_VCMP = 403 * MiB, WS_KS = 408 * MiB, WS_KW = 413 * MiB, WS_VST = 418 * MiB, WS_VWT = 423 * MiB;
constexpr size_t WS_GATES = 428 * MiB, WS_HIDK = 430 * MiB, WS_HIDV = 431 * MiB, WS_KC = 432 * MiB, WS_VCT = 433 * MiB, WS_IDX = 434 * MiB, WS_CNT = 442 * MiB;
constexpr size_t WS_OA = 443 * MiB, WS_OB = 459 * MiB, WS_PBF = 475 * MiB  , WS_SSP = 491 * MiB  , WS_SEL = 509 * MiB  , WS_END = 511 * MiB;
constexpr size_t WS_U = WS_Z, WS_PP = WS_Z + 96 * MiB, WS_MERGED = WS_QA, WS_XGB = WS_QA;
constexpr size_t WO_13A = 0, WO_2A = WO_13A + (size_t)2 * FF * D, WO_IN = WO_2A + (size_t)D * FF, WO_CK = WO_IN + (size_t)NZ * D, WO_CV = WO_CK + 256 * 2048,
                 WO_PA = WO_CV + 256 * 2048  , WO_WO = WO_PA + 2048 * 1024, WO_13B = WO_WO + 1024 * 1024, WO_2B = WO_13B + (size_t)2 * FF * D,
                 WO_PG = WO_2B + (size_t)D * FF, WO_PP = WO_PG + 1024 * 1024, WO_END = WO_PP + 1024 * 256;
static_assert(WO_END * 2 <= 54 * MiB, "weight buffer");
constexpr int LDS_BYTES = 147456;

__device__ __forceinline__ unsigned f2bf(float f) { unsigned u = __builtin_bit_cast(unsigned, f); return (u + 0x7fffu + ((u >> 16) & 1u)) >> 16; }
__device__ __forceinline__ unsigned pk2(float lo, float hi) { return f2bf(lo) | (f2bf(hi) << 16); }
__device__ __forceinline__ float bf2f(unsigned h) { return __builtin_bit_cast(float, (h & 0xffffu) << 16); }
__device__ __forceinline__ float bflo(unsigned w) { return __builtin_bit_cast(float, w << 16); }
__device__ __forceinline__ float bfhi(unsigned w) { return __builtin_bit_cast(float, w & 0xffff0000u); }
__device__ __forceinline__ float row_rs(const float* ssp, int r) {
    const f32x4 a = *(const f32x4*)(ssp + (size_t)r * 16), b = *(const f32x4*)(ssp + (size_t)r * 16 + 4), c = *(const f32x4*)(ssp + (size_t)r * 16 + 8), d = *(const f32x4*)(ssp + (size_t)r * 16 + 12);
    const float t = (((a[0] + a[1]) + (a[2] + a[3])) + ((b[0] + b[1]) + (b[2] + b[3]))) + (((c[0] + c[1]) + (c[2] + c[3])) + ((d[0] + d[1]) + (d[2] + d[3])));
    return rsqrtf(t * (1.f / 1024.f) + 1e-6f);
}
__device__ __forceinline__ float sigmoidf_(float v) { return __builtin_amdgcn_rcpf(1.f + __expf(-v)); }
__device__ __forceinline__ float wave_sum(float v) {
#pragma unroll
    for (int o = 1; o < 64; o <<= 1) v += __shfl_xor(v, o);
    return v;
}
#define LDS_WAIT() asm volatile("s_waitcnt lgkmcnt(0)" ::: "memory")

using pg8::Unit;
struct EpiSwiglu {
    static constexpr bool PERM = true, AFTER_DRAIN = false;
    bf16_t* U; const float* ss;
    __device__ __forceinline__ void operator()(const f32x4 (&acc)[2][2][4][2], const Unit& u, int wr, int wc, int fr_, int fq_) const {
        int fr = fr_, fq = fq_; asm volatile("" : "+v"(fr), "+v"(fq));
#pragma unroll
        for (int ai = 0; ai < 2; ++ai)
#pragma unroll
            for (int m = 0; m < 4; ++m) {
                const int r = u.pm * 256 + ai * 128 + wr * 64 + m * 16 + fr;
                const float rs = row_rs(ss, r);
#pragma unroll
                for (int bj = 0; bj < 2; ++bj) {
                    const f32x4 a = acc[ai][bj][m][0] * rs, b = acc[ai][bj][m][1] * rs;
                    float o[4];
#pragma unroll
                    for (int i = 0; i < 4; ++i) o[i] = a[i] * __builtin_amdgcn_rcpf(1.f + __expf(-a[i])) * b[i];
                    u32x2 w; w.x = pk2(o[0], o[1]); w.y = pk2(o[2], o[3]);
                    *(u32x2*)(U + (size_t)r * FF + u.pn * 128 + bj * 64 + wc * 16 + fq * 4) = w;
                }
            }
    }
};
template <int MODE> struct EpiResid {
    static constexpr bool PERM = false, AFTER_DRAIN = false;
    const float* xin; float* xout; bf16_t* xg; const float* gnext; float* ssnext; float alpha; const float* sscur; const bf16_t* pp;
    __device__ __forceinline__ void operator()(const f32x4 (&acc)[2][2][4][2], const Unit& u, int wr, int wc, int fr_, int fq_) const {
        int fr = fr_, fq = fq_; asm volatile("" : "+v"(fr), "+v"(fq));
#pragma unroll
        for (int ai = 0; ai < 2; ++ai)
#pragma unroll
            for (int m = 0; m < 4; ++m) {
                const int r = u.pm * 256 + ai * 128 + wr * 64 + m * 16 + fr;
                float rs = 1.f; if (MODE == 1) rs = row_rs(sscur, r);
                float sq = 0.f;
#pragma unroll
                for (int bj = 0; bj < 2; ++bj)
#pragma unroll
                    for (int n = 0; n < 2; ++n) {
                        const int c = u.pn * 256 + bj * 128 + wc * 32 + n * 16 + fq * 4;
                        const size_t off = (size_t)r * D + c;
                        const f32x4 xi = *(const f32x4*)(xin + off), v = acc[ai][bj][m][n];
                        f32x4 xn;
                        if (MODE == 0) xn = xi + v * alpha;
                        else { const u32x2 pw = *(const u32x2*)(pp + off);
                            xn[0] = xi[0] + sigmoidf_(v[0] * rs) * bflo(pw.x); xn[1] = xi[1] + sigmoidf_(v[1] * rs) * bfhi(pw.x);
                            xn[2] = xi[2] + sigmoidf_(v[2] * rs) * bflo(pw.y); xn[3] = xi[3] + sigmoidf_(v[3] * rs) * bfhi(pw.y); }
                        *(f32x4*)(xout + off) = xn;
                        const f32x4 g = *(const f32x4*)(gnext + c);
                        u32x2 w; w.x = pk2(xn[0] * g[0], xn[1] * g[1]); w.y = pk2(xn[2] * g[2], xn[3] * g[3]);
                        *(u32x2*)(xg + off) = w;
                        sq += (xn[0] * xn[0] + xn[1] * xn[1]) + (xn[2] * xn[2] + xn[3] * xn[3]);
                    }
                sq += __shfl_xor(sq, 16); sq += __shfl_xor(sq, 32);
                if (fq == 0) ssnext[(size_t)r * 16 + u.pn * 4 + wc] = sq;
            }
    }
};
template <int MODE> struct EpiRow {
    static constexpr bool PERM = true, AFTER_DRAIN = false;
    bf16_t* O; int ldc; const float* ss; const float* bias; const bf16_t* gate; int ldg;
    __device__ __forceinline__ void operator()(const f32x4 (&acc)[2][2][4][2], const Unit& u, int wr, int wc, int fr_, int fq_) const {
        int fr = fr_, fq = fq_; asm volatile("" : "+v"(fr), "+v"(fq));
#pragma unroll
        for (int ai = 0; ai < 2; ++ai)
#pragma unroll
            for (int m = 0; m < 4; ++m) {
                const int r = u.pm * 256 + ai * 128 + wr * 64 + m * 16 + fr;
                float rs = 1.f; if (MODE == 0) rs = row_rs(ss, r);
#pragma unroll
                for (int bj = 0; bj < 2; ++bj) {
                    const int c = u.pn * 256 + bj * 128 + wc * 32 + fq * 8;
                    float v[8];
#pragma unroll
                    for (int i = 0; i < 4; ++i) { v[i] = acc[ai][bj][m][0][i]; v[4 + i] = acc[ai][bj][m][1][i]; }
                    if (MODE == 0) {
#pragma unroll
                        for (int i = 0; i < 8; ++i) v[i] *= rs;
                    }
                    if (MODE == 1) {
#pragma unroll
                        for (int i = 0; i < 8; ++i) { const float a = v[i] + bias[c + i]; v[i] = a * __builtin_amdgcn_rcpf(1.f + __expf(-a)); }
                    }
                    if (MODE == 3 || MODE == 4) {
                        const u32x4 gw = *(const u32x4*)(gate + (size_t)r * ldg + c);
                        const unsigned gwa[4] = {gw.x, gw.y, gw.z, gw.w};
#pragma unroll
                        for (int i = 0; i < 4; ++i) { v[2 * i] *= sigmoidf_(bflo(gwa[i])); v[2 * i + 1] *= sigmoidf_(bfhi(gwa[i])); }
                    }
                    bf16_t* op = O + (size_t)r * ldc + c;
                    if (MODE == 4) {
                        const u32x4 ow = *(const u32x4*)op; const unsigned owa[4] = {ow.x, ow.y, ow.z, ow.w};
#pragma unroll
                        for (int i = 0; i < 4; ++i) { v[2 * i] += bflo(owa[i]); v[2 * i + 1] += bfhi(owa[i]); }
                    }
                    u32x4 w; w.x = pk2(v[0], v[1]); w.y = pk2(v[2], v[3]); w.z = pk2(v[4], v[5]); w.w = pk2(v[6], v[7]);
                    *(u32x4*)op = w;
                }
            }
    }
};

struct EpiMerge {
    static constexpr bool PERM = true, AFTER_DRAIN = false;
    bf16_t* O; const bf16_t* z;
    __device__ __forceinline__ void operator()(const f32x4 (&acc)[2][2][4][2], const Unit& u, int wr, int wc, int fr_, int fq_) const {
        int fr = fr_, fq = fq_; asm volatile("" : "+v"(fr), "+v"(fq));
#pragma unroll
        for (int ai = 0; ai < 2; ++ai)
#pragma unroll
            for (int m = 0; m < 4; ++m) {
                const int r = u.pm * 256 + ai * 128 + wr * 64 + m * 16 + fr;
#pragma unroll
                for (int bj = 0; bj < 2; ++bj) {
                    const int c = u.pn * 128 + bj * 64 + wc * 16 + fq * 4;
                    const u32x2 ga = *(const u32x2*)(z + (size_t)r * NZ + Z_GM + c), gb = *(const u32x2*)(z + (size_t)r * NZ + Z_GM + 1024 + c);
                    const f32x4 a = acc[ai][bj][m][0], b = acc[ai][bj][m][1];
                    u32x2 w;
                    w.x = pk2(sigmoidf_(bflo(ga.x)) * a[0] + sigmoidf_(bflo(gb.x)) * b[0], sigmoidf_(bfhi(ga.x)) * a[1] + sigmoidf_(bfhi(gb.x)) * b[1]);
                    w.y = pk2(sigmoidf_(bflo(ga.y)) * a[2] + sigmoidf_(bflo(gb.y)) * b[2], sigmoidf_(bfhi(ga.y)) * a[3] + sigmoidf_(bfhi(gb.y)) * b[3]);
                    *(u32x2*)(O + (size_t)r * D + c) = w;
                }
            }
    }
};
template <class Epi> __device__ __forceinline__ void run_gemm(LAS unsigned char* lds, const bf16_t* A, int lda, const bf16_t* Bt, int M, int N, int K, int cshift, const Epi& E, int wv) {
    pg8::Gemm g{A, Bt, M, N, K, lda};
    pg8::StaticOrder So; So.init(M, N, mk_grid(), (int)((mk_bid() + mk_grid() - cshift) % mk_grid()));
    pg8::gemm_phase<Epi, pg8::StaticOrder, true, true>(lds, g, So, E, wv);
}

__device__ __forceinline__ void transpose_item(const float* W, int K, int N, bf16_t* WT, int row_off, int mode, LAS float* scr, int item, int lane, int ldw = 0, int koff = 0) {
    if (ldw == 0) ldw = K;
    const int nblk = N / 32, kb = item / nblk, nb = item % nblk, k0 = 64 * kb, n0 = 32 * nb;
    const int kr = lane >> 3, n4 = (lane & 7) * 4;
#pragma unroll
    for (int i = 0; i < 8; ++i) { const int kk = 8 * i + kr; const f32x4 v = *(const f32x4*)(W + (size_t)(k0 + kk) * N + n0 + n4);
        LAS float* d = scr + kk * 33 + n4; d[0] = v[0]; d[1] = v[1]; d[2] = v[2]; d[3] = v[3]; }
    LDS_WAIT();
    const int c = lane & 7;
#pragma unroll
    for (int j = 0; j < 4; ++j) { const int nl = (lane >> 3) + 8 * j; const LAS float* s = scr + (8 * c) * 33 + nl;
        u32x4 o; o.x = pk2(s[0 * 33], s[1 * 33]); o.y = pk2(s[2 * 33], s[3 * 33]); o.z = pk2(s[4 * 33], s[5 * 33]); o.w = pk2(s[6 * 33], s[7 * 33]);
        const int n = n0 + nl; const int dr = mode == 0 ? row_off + n : (8 * (n >> 2) + (n & 3) + (mode == 2 ? 4 : 0));
        *(u32x4*)(WT + (size_t)dr * ldw + koff + k0 + 8 * c) = o; }
    LDS_WAIT();
}

struct P {
    const float* in[26];
    float* out; unsigned char* ws;
    int ph_lo, ph_hi;
};
typedef const __attribute__((address_space(4))) P* KP;

__device__ __forceinline__ void convert_layer(KP p, int L, bf16_t* WB, LAS unsigned char* lds, int wv) {
    int tid_ = mk_tid(wv); asm volatile("" : "+v"(tid_)); const int tid = tid_, lane = tid & 63; int wave = wv; asm volatile("" : "+s"(wave));
    LAS float* scr = (LAS float*)(lds + wave * 16384);
    const int gw = mk_bid() * 8 + wave, NGW = mk_grid() * 8;
    constexpr int I_13 = 16 * 88, I_2 = 44 * 32, I_IN = 16 * 134, I_C = 32 * 8, I_PR = 8 * 32, I_SQ = 16 * 32, I_PP = 4 * 32;
    constexpr int NIT = 4 * I_13 + 2 * I_2 + I_IN + 2 * I_C + 2 * I_PR + 2 * I_SQ + I_PP;
    const size_t l13 = (size_t)L * D * FF, lsq = (size_t)L * D * D;
    for (int it = gw; it < NIT; it += NGW) {
        int r = it;
        if (r < I_13) { transpose_item(p->in[3] + l13, D, FF, WB + WO_13A, 0, 1, scr, r, lane); continue; } r -= I_13;
        if (r < I_13) { transpose_item(p->in[4] + l13, D, FF, WB + WO_13A, 0, 2, scr, r, lane); continue; } r -= I_13;
        if (r < I_2) { transpose_item(p->in[5] + l13, FF, D, WB + WO_2A, 0, 0, scr, r, lane); continue; } r -= I_2;
        if (r < I_IN) { transpose_item(p->in[7] + (size_t)L * D * 4288, D, 4288, WB + WO_IN, 0, 0, scr, r, lane); continue; } r -= I_IN;
        if (r < I_C) { transpose_item(p->in[11] + (size_t)L * 2048 * 256, 2048, 256, WB + WO_CK, 0, 0, scr, r, lane); continue; } r -= I_C;
        if (r < I_C) { transpose_item(p->in[13] + (size_t)L * 2048 * 256, 2048, 256, WB + WO_CV, 0, 0, scr, r, lane); continue; } r -= I_C;
        if (r < I_PR) { transpose_item(p->in[15] + (size_t)L * 512 * D, 512, D, WB + WO_PA, 0, 1, scr, r, lane, 1024, 0); continue; } r -= I_PR;
        if (r < I_PR) { transpose_item(p->in[16] + (size_t)L * 512 * D, 512, D, WB + WO_PA, 0, 2, scr, r, lane, 1024, 512); continue; } r -= I_PR;
        if (r < I_SQ) { transpose_item(p->in[17] + lsq, D, D, WB + WO_WO, 0, 0, scr, r, lane); continue; } r -= I_SQ;
        if (r < I_13) { transpose_item(p->in[19] + l13, D, FF, WB + WO_13B, 0, 1, scr, r, lane); continue; } r -= I_13;
        if (r < I_13) { transpose_item(p->in[20] + l13, D, FF, WB + WO_13B, 0, 2, scr, r, lane); continue; } r -= I_13;
        if (r < I_2) { transpose_item(p->in[21] + l13, FF, D, WB + WO_2B, 0, 0, scr, r, lane); continue; } r -= I_2;
        if (r < I_SQ) { transpose_item(p->in[23] + lsq, D, D, WB + WO_PG, 0, 0, scr, r, lane); continue; } r -= I_SQ;
        transpose_item(p->in[24] + (size_t)L * PLE * D, PLE, D, WB + WO_PP, 0, 0, scr, r, lane);
    }
    const int gt = mk_bid() * 512 + tid, NGT = mk_grid() * 512;
    const float* win = p->in[7] + (size_t)L * D * 4288; const float* gkv = p->in[8] + L * 128; const float* ukv = p->in[9] + (size_t)L * 128 * 128;
    for (int o = gt; o < 128 * 1024; o += NGT) {
        const int n = o & 127, k = o >> 7; float a = 0.f;
        for (int j = 0; j < 128; ++j) a += win[(size_t)k * 4288 + 512 + j] * gkv[j] * ukv[j * 128 + n];
        WB[WO_IN + (size_t)(4288 + n) * D + k] = (bf16_t)f2bf(a);
    }
    for (int o = gt; o < 2048 * 64; o += NGT) { const int row = o >> 6, ch = o & 63; unsigned zz; asm volatile("v_mov_b32 %0, 0" : "=v"(zz));
        *(u32x4*)(WB + WO_PA + (size_t)row * 1024 + ((row & 4) ? 0 : 512) + ch * 8) = (u32x4){zz, zz, zz, zz}; }
    for (int o = gt; o < 192 * 1024 / 8; o += NGT) { unsigned zz; asm volatile("v_mov_b32 %0, 0" : "=v"(zz)); *(u32x4*)(WB + WO_IN + (size_t)4416 * D + (size_t)o * 8) = (u32x4){zz, zz, zz, zz}; }
    float* bias = (float*)(p->ws + WS_BIAS);
    for (int o = gw; o < 512; o += NGW) {
        const int n = o & 255, kv = o >> 8; const float* w1 = p->in[kv ? 13 : 11] + (size_t)L * 2048 * 256; const float* pos = p->in[10] + L * 2048; float a = 0.f;
#pragma unroll 8
        for (int k = lane; k < 2048; k += 64) a += pos[k] * w1[(size_t)k * 256 + n];
        a = wave_sum(a);
        if (lane == 0) bias[o] = a;
    }
    const float* pl = p->in[1] + (size_t)L * T * PLE; bf16_t* pb = (bf16_t*)(p->ws + WS_PBF) + (size_t)(L & 1) * T * PLE;
    for (int o = gt; o < T * PLE / 8; o += NGT) { const f32x4 a = *(const f32x4*)(pl + (size_t)o * 8), b = *(const f32x4*)(pl + (size_t)o * 8 + 4);
        u32x4 w; w.x = pk2(a[0], a[1]); w.y = pk2(a[2], a[3]); w.z = pk2(b[0], b[1]); w.w = pk2(b[2], b[3]); *(u32x4*)(pb + (size_t)o * 8) = w; }
}

__device__ __forceinline__ void prologue_phase(KP p, LAS unsigned char* lds, int wv) {
    int tid_ = mk_tid(wv); asm volatile("" : "+v"(tid_)); const int tid = tid_, lane = tid & 63; int wave = wv; asm volatile("" : "+s"(wave));
    const int gt = mk_bid() * 512 + tid, NGT = mk_grid() * 512;
    float* rope = (float*)(p->ws + WS_ROPE);
    for (int o = gt; o < S * 12; o += NGT) {
        int pos, j; float inv;
        if (o < S * 8) { pos = o >> 3; j = o & 7;
            inv = j == 0 ? 1.0f : j == 1 ? 0.19392274f : j == 2 ? 0.037606031f : j == 3 ? 0.0072926646f : j == 4 ? 0.0014142136f : j == 5 ? 0.00027424819f : j == 6 ? 5.3182957e-05f : 1.0313385e-05f; }
        else { const int o2 = o - S * 8; pos = o2 >> 2; j = o2 & 3;
            inv = j == 0 ? 1.0f : j == 1 ? 0.037606031f : j == 2 ? 0.0014142136f : 5.3182957e-05f; }
        const float ang = (float)pos * inv;
        const double rev = (double)ang * 0.15915494309189533577;
        const float fr = (float)(rev - __builtin_floor(rev));
        const float c = __builtin_amdgcn_cosf(fr), s = __builtin_amdgcn_sinf(fr);
        if (o < S * 8) { rope[o] = c; rope[S * 8 + o] = s; } else { rope[S * 16 + (o - S * 8)] = c; rope[S * 20 + (o - S * 8)] = s; }
    }
    convert_layer(p, 0, (bf16_t*)(p->ws + WS_WB0), lds, wv);
    const float* x = p->in[0]; const float* g = p->in[2]; bf16_t* xg = (bf16_t*)(p->ws + WS_XG); float* ss = (float*)(p->ws + WS_SSP);
    const int gw = mk_bid() * 8 + wave, NGW = mk_grid() * 8;
    for (int r = gw; r < T; r += NGW) {
        float sq = 0.f;
#pragma unroll
        for (int j = 0; j < 4; ++j) { const int c = (j * 64 + lane) * 4; const f32x4 v = *(const f32x4*)(x + (size_t)r * D + c), gg = *(const f32x4*)(g + c);
            sq += (v[0] * v[0] + v[1] * v[1]) + (v[2] * v[2] + v[3] * v[3]);
            u32x2 w; w.x = pk2(v[0] * gg[0], v[1] * gg[1]); w.y = pk2(v[2] * gg[2], v[3] * gg[3]); *(u32x2*)(xg + (size_t)r * D + c) = w; }
        sq = wave_sum(sq);
        if (lane < 16) ss[(size_t)r * 16 + lane] = lane == 0 ? sq : 0.f;
    }
}

__device__ __forceinline__ float rope_at(const LAS bf16_t* base, int d, int half, const float* cs, const float* sn) {
    const int j = d < half ? d : d - half;
    const float x1 = bf2f(base[j]), x2 = bf2f(base[j + half]);
    return d < half ? x1 * cs[j] - x2 * sn[j] : x2 * cs[j] + x1 * sn[j];
}
__device__ __forceinline__ void post_phase(KP p, LAS unsigned char* lds, int wv) {
    int tid_ = mk_tid(wv); asm volatile("" : "+v"(tid_)); const int tid = tid_, lane = tid & 63; int wave = wv; asm volatile("" : "+s"(wave));
    LAS bf16_t* zr = (LAS bf16_t*)(lds + wave * 16384);
    LAS bf16_t* vt = (LAS bf16_t*)(lds + wave * 16384 + 9216);
    const bf16_t* Z = (const bf16_t*)(p->ws + WS_Z);
    const float* rope = (const float*)(p->ws + WS_ROPE);
    bf16_t* QA = (bf16_t*)(p->ws + WS_QA); bf16_t* QB = (bf16_t*)(p->ws + WS_QB); bf16_t* KA = (bf16_t*)(p->ws + WS_KA); bf16_t* VA = (bf16_t*)(p->ws + WS_VA);
    bf16_t* QI = (bf16_t*)(p->ws + WS_QI); bf16_t* KI = (bf16_t*)(p->ws + WS_KI); float* WI = (float*)(p->ws + WS_WI); float* GATES = (float*)(p->ws + WS_GATES);
    bf16_t* KCMP = (bf16_t*)(p->ws + WS_KCMP); bf16_t* VCMP = (bf16_t*)(p->ws + WS_VCMP); bf16_t* KS = (bf16_t*)(p->ws + WS_KS); bf16_t* KW = (bf16_t*)(p->ws + WS_KW);
    bf16_t* VST = (bf16_t*)(p->ws + WS_VST); bf16_t* VWT = (bf16_t*)(p->ws + WS_VWT);
    const int gw = mk_bid() * 8 + wave, NGW = mk_grid() * 8;
    for (int grp = gw; grp < T / 8; grp += NGW) {
        const int tg0 = grp * 8, b = tg0 >> 13, s0 = tg0 & (S - 1);
        u32x4 zp[9];
#pragma unroll
        for (int i = 0; i < 9; ++i) zp[i] = *(const u32x4*)(Z + (size_t)tg0 * NZ + (i * 64 + lane) * 8);
#pragma unroll 1
        for (int tt = 0; tt < 8; ++tt) {
            const int tg = tg0 + tt, s = s0 + tt;
            LDS_WAIT();
#pragma unroll
            for (int i = 0; i < 9; ++i) *(LAS u32x4*)(zr + (i * 64 + lane) * 8) = zp[i];
            if (tt + 1 < 8) {
#pragma unroll
                for (int i = 0; i < 9; ++i) zp[i] = *(const u32x4*)(Z + (size_t)(tg + 1) * NZ + (i * 64 + lane) * 8);
            }
            LDS_WAIT();
            const float* c16 = rope + s * 8; const float* s16 = rope + S * 8 + s * 8; const float* c8 = rope + S * 16 + s * 4; const float* s8 = rope + S * 20 + s * 4;
#pragma unroll
            for (int i = 0; i < 8; ++i) { const int e = lane + 64 * i, d = e & 63;
                float va = d < 16 ? rope_at(zr + Z_QA + (e & ~63), d, 8, c16, s16) : bf2f(zr[Z_QA + e]);
                float vb = d < 16 ? rope_at(zr + Z_QB + (e & ~63), d, 8, c16, s16) : bf2f(zr[Z_QB + e]);
                QA[(size_t)tg * 512 + e] = (bf16_t)f2bf(va * 0.18033688011112042f); QB[(size_t)tg * 512 + e] = (bf16_t)f2bf(vb * 0.18033688011112042f); }
#pragma unroll
            for (int i = 0; i < 4; ++i) { const int e = lane + 64 * i, d = e & 31;
                float v = d < 8 ? rope_at(zr + Z_QI + (e & ~31), d, 4, c8, s8) : bf2f(zr[Z_QI + e]);
                QI[(size_t)tg * 256 + e] = (bf16_t)f2bf(v); }
            if (lane < 32) { const int d = lane; float v = d < 8 ? rope_at(zr + Z_KI, d, 4, c8, s8) : bf2f(zr[Z_KI + d]); KI[(size_t)tg * 32 + d] = (bf16_t)f2bf(v); }
            if (lane < 8) WI[(size_t)tg * 8 + lane] = bf2f(zr[Z_WI + lane]) * 0.35355339059327373f;
            if (lane < 24) GATES[(size_t)tg * 24 + lane] = sigmoidf_(bf2f(zr[Z_GB + lane]));
            { const float a = bf2f(zr[Z_CKV + lane]), c = bf2f(zr[Z_CKV + 64 + lane]);
              const float rs = rsqrtf(wave_sum(a * a + c * c) * (1.f / 128.f) + EPS);
              const int d = lane;
              float kv = d < 16 ? rope_at(zr + Z_KV, d, 8, c16, s16) : bf2f(zr[Z_KV + d]);
              KA[(size_t)tg * 64 + d] = (bf16_t)f2bf(kv * rs);
              VA[(size_t)tg * 64 + d] = (bf16_t)f2bf(bf2f(zr[Z_KV + 64 + d]) * rs); }
#pragma unroll
            for (int i = 0; i < 2; ++i) { const int e = lane + 64 * i, g = i, d = lane;
                const size_t dst = ((size_t)(b * 2 + g) * S + s) * 64 + d;
                float kc = d < 16 ? rope_at(zr + Z_KVB + 0 + g * 64, d, 8, c16, s16) : bf2f(zr[Z_KVB + 0 + e]);
                float ks = d < 16 ? rope_at(zr + Z_KVB + 256 + g * 64, d, 8, c16, s16) : bf2f(zr[Z_KVB + 256 + e]);
                float kw = d < 16 ? rope_at(zr + Z_KVB + 512 + g * 64, d, 8, c16, s16) : bf2f(zr[Z_KVB + 512 + e]);
                KCMP[dst] = (bf16_t)f2bf(kc); KS[dst] = (bf16_t)f2bf(ks); KW[dst] = (bf16_t)f2bf(kw);
                VCMP[dst] = zr[Z_KVB + 128 + e];
                vt[(e) * 8 + tt] = zr[Z_KVB + 384 + e];
                vt[(128 + e) * 8 + tt] = zr[Z_KVB + 640 + e]; }
        }
        LDS_WAIT();
#pragma unroll
        for (int i = 0; i < 4; ++i) { const int rr = lane + 64 * i, e = rr & 127, g = e >> 6, d = e & 63;
            bf16_t* dst = (rr >> 7 ? VWT : VST) + ((size_t)(b * 2 + g) * 64 + d) * LDV + s0;
            *(u32x4*)dst = *(const LAS u32x4*)(vt + rr * 8); }
        LDS_WAIT();
    }
}

__device__ __forceinline__ void cmp2_phase(KP p, int L, int wv) {
    int tid_ = mk_tid(wv); asm volatile("" : "+v"(tid_)); const int gt = mk_bid() * 512 + tid_, NGT = mk_grid() * 512;
    bf16_t* KC = (bf16_t*)(p->ws + WS_KC); bf16_t* VCT = (bf16_t*)(p->ws + WS_VCT);
    for (int o = gt; o < 2 * 2048 * 64; o += NGT) {
        const int n = o & 63, r = (o >> 6) & 2047, kv = o >> 17;
        const bf16_t* hid = (const bf16_t*)(p->ws + (kv ? WS_HIDV : WS_HIDK)) + (size_t)r * 256;
        const float* w2 = p->in[kv ? 14 : 12] + (size_t)L * 256 * 64;
        float a = 0.f;
        for (int j = 0; j < 256; ++j) a += bf2f(hid[j]) * w2[j * 64 + n];
        if (kv == 0) KC[(size_t)r * 64 + n] = (bf16_t)f2bf(a);
        else VCT[((size_t)(r >> 9) * 64 + n) * 512 + (r & 511)] = (bf16_t)f2bf(a);
    }
}

__device__ __forceinline__ unsigned quant16(float v, float lo, float scale) { const float q = (v - lo) * scale; return min(65535u, (unsigned)q); }
__device__ __forceinline__ void scan_bins(const LAS unsigned* h, unsigned need, int lane, LAS int* outb, LAS int* outneed) {
    const unsigned h0 = h[4 * lane], h1 = h[4 * lane + 1], h2 = h[4 * lane + 2], h3 = h[4 * lane + 3];
    const unsigned tot = h0 + h1 + h2 + h3;
    unsigned suf = tot;
#pragma unroll
    for (int o = 1; o < 64; o <<= 1) { const unsigned t = __shfl_down(suf, o); if (lane + o < 64) suf += t; }
    unsigned cum = suf - tot;
    const unsigned hh[4] = {h0, h1, h2, h3};
#pragma unroll
    for (int b = 3; b >= 0; --b) { if (cum < need && cum + hh[b] >= need) { *outb = 4 * lane + b; *outneed = (int)(need - cum); } cum += hh[b]; }
}
__device__ __forceinline__ void indexer_phase(KP p, LAS unsigned char* lds, int L, int wv, int cslot, const bool score_only = false) {
    int tid_ = mk_tid(wv); asm volatile("" : "+v"(tid_)); const int tid = tid_, lane = tid & 63; int wave = wv; asm volatile("" : "+s"(wave));
    LAS float* sc = (LAS float*)lds;
    LAS unsigned* hist = (LAS unsigned*)(lds + 131072);
    LAS float* mm = (LAS float*)(lds + 131072 + 4096);
    LAS int* ctl = (LAS int*)(lds + 131072 + 4096 + 256);
    const bf16_t* QI = (const bf16_t*)(p->ws + WS_QI); const bf16_t* KI = (const bf16_t*)(p->ws + WS_KI); const float* WI = (const float*)(p->ws + WS_WI);
    unsigned short* IDX = (unsigned short*)(p->ws + WS_IDX); int* CNT = (int*)(p->ws + WS_CNT);
    unsigned* ctr = (unsigned*)(p->ws + WS_CTL) + 64 * L + cslot;
    const int r = lane & 31, hi = lane >> 5;
    bf16x8 na0, na1; float nw[16]; bool pref = false;
#pragma unroll
    for (int i = 0; i < 16; ++i) nw[i] = 0.f;
    na0 = (bf16x8){0, 0, 0, 0, 0, 0, 0, 0}; na1 = na0;
    int cur_item = 0;
    if (tid == 0) cur_item = (int)atomicAdd(ctr, 1u);
    for (;;) {
        __syncthreads();
        int nxt_item = 0;
        if (tid == 0) { ctl[0] = cur_item; nxt_item = (int)atomicAdd(ctr, 1u); }
        for (int i = tid; i < 1024; i += 512) hist[i] = 0u;
        __syncthreads();
        const int item = ctl[0];
        if (item >= T / 4) break;
        const int tg0 = (T / 4 - 1 - item) * 4, b = tg0 >> 13, s0 = tg0 & (S - 1);
        const int ntile = (s0 + 4 + 31) >> 5;
        const int i16 = (r & 3) + 4 * (r >> 3), aq = 2 * ((r >> 2) & 1) + (i16 >> 3), ah = i16 & 7;
        bf16x8 a0 = na0, a1 = na1; float w[16];
#pragma unroll
        for (int i = 0; i < 16; ++i) w[i] = nw[i];
        if (!pref) {
            const bf16_t* qp = QI + (size_t)(tg0 + aq) * 256 + ah * 32 + 8 * hi;
            a0 = *(const bf16x8*)qp; a1 = *(const bf16x8*)(qp + 16);
#pragma unroll
            for (int i = 0; i < 16; ++i) w[i] = WI[(size_t)(tg0 + 2 * hi + (i >> 3)) * 8 + (i & 7)];
        }
        float mn2[2] = {3.0e38f, 3.0e38f}, mx2[2] = {-3.0e38f, -3.0e38f};
        for (int kt = wave; kt < ntile; kt += 8) {
            const int key = kt * 32 + r;
            const bf16_t* kp = KI + ((size_t)b * S + key) * 32 + 8 * hi;
            const bf16x8 b0 = *(const bf16x8*)kp, b1 = *(const bf16x8*)(kp + 16);
            f32x16 acc;
#pragma unroll
            for (int i = 0; i < 16; ++i) acc[i] = 0.f;
            acc = __builtin_amdgcn_mfma_f32_32x32x16_bf16(a0, b0, acc, 0, 0, 0);
            acc = __builtin_amdgcn_mfma_f32_32x32x16_bf16(a1, b1, acc, 0, 0, 0);
#pragma unroll
            for (int ql = 0; ql < 2; ++ql) {
                float pq = 0.f;
#pragma unroll
                for (int i = 0; i < 8; ++i) pq += w[ql * 8 + i] * fmaxf(acc[8 * ql + i], 0.f);
                const int q = 2 * hi + ql;
                const bool valid = key <= s0 + q;
                const float plo = valid ? pq : -3.0e38f;
                mn2[ql] = fminf(mn2[ql], valid ? pq : 3.0e38f); mx2[ql] = fmaxf(mx2[ql], plo);
                sc[q * 8192 + key] = plo;
            }
        }
        float mn[4], mx[4];
#pragma unroll
        for (int q = 0; q < 4; ++q) { const bool own = hi == (q >> 1); mn[q] = own ? mn2[q & 1] : 3.0e38f; mx[q] = own ? mx2[q & 1] : -3.0e38f; }
#pragma unroll
        for (int q = 0; q < 4; ++q)
#pragma unroll
            for (int o = 1; o < 64; o <<= 1) { mn[q] = fminf(mn[q], __shfl_xor(mn[q], o)); mx[q] = fmaxf(mx[q], __shfl_xor(mx[q], o)); }
        if (lane == 0) {
#pragma unroll
            for (int q = 0; q < 4; ++q) { mm[wave * 8 + q] = mn[q]; mm[wave * 8 + 4 + q] = mx[q]; }
        }
        if (tid == 0) ctl[1] = nxt_item;
        __syncthreads();
        { const int nitem = ctl[1]; pref = nitem < T / 4;
          if (pref) { const int ntg0 = (T / 4 - 1 - nitem) * 4;
              const bf16_t* qp = QI + (size_t)(ntg0 + aq) * 256 + ah * 32 + 8 * hi;
              na0 = *(const bf16x8*)qp; na1 = *(const bf16x8*)(qp + 16);
#pragma unroll
              for (int i = 0; i < 16; ++i) nw[i] = WI[(size_t)(ntg0 + 2 * hi + (i >> 3)) * 8 + (i & 7)]; } }
        if (score_only) { cur_item = nxt_item; continue; }
        {
            const int row = tid >> 7, j = tid & 127, nrow = s0 + row + 1;
            float lo = 3.0e38f, hv = -3.0e38f;
#pragma unroll
            for (int w8 = 0; w8 < 8; ++w8) { lo = fminf(lo, mm[w8 * 8 + row]); hv = fmaxf(hv, mm[w8 * 8 + 4 + row]); }
            const float scale = hv > lo ? 65535.f / (hv - lo) : 0.f;
            if (nrow > 256) for (int i = j; i < nrow; i += 128) __hip_atomic_fetch_add(&hist[row * 256 + (quant16(sc[row * 8192 + i], lo, scale) >> 8)], 1u, __ATOMIC_RELAXED, __HIP_MEMORY_SCOPE_WORKGROUP);
            __syncthreads();
            if (wave < 4 && s0 + wave + 1 > 256) scan_bins(hist + wave * 256, 256u, lane, ctl + 4 + wave, ctl + 8 + wave);
            __syncthreads();
            for (int i = tid; i < 1024; i += 512) hist[i] = 0u;
            __syncthreads();
            if (nrow > 256) { const unsigned B1 = (unsigned)ctl[4 + row];
                for (int i = j; i < nrow; i += 128) { const unsigned k16 = quant16(sc[row * 8192 + i], lo, scale); if ((k16 >> 8) == B1) __hip_atomic_fetch_add(&hist[row * 256 + (k16 & 255u)], 1u, __ATOMIC_RELAXED, __HIP_MEMORY_SCOPE_WORKGROUP); } }
            __syncthreads();
            if (wave < 4 && s0 + wave + 1 > 256) scan_bins(hist + wave * 256, (unsigned)ctl[8 + wave], lane, ctl + 12 + wave, ctl + 16 + wave);
            __syncthreads();
        }
        {
            const int row = tid >> 7, j = tid & 127, nrow = s0 + row + 1; const size_t tg = (size_t)tg0 + row;
            const bool big = nrow > 256;
            float lo = 3.0e38f, hv = -3.0e38f;
#pragma unroll
            for (int w8 = 0; w8 < 8; ++w8) { lo = fminf(lo, mm[w8 * 8 + row]); hv = fmaxf(hv, mm[w8 * 8 + 4 + row]); }
            const float scale = hv > lo ? 65535.f / (hv - lo) : 0.f;
            const unsigned T16 = ((unsigned)ctl[4 + row] << 8) | (unsigned)ctl[12 + row]; const int need2 = ctl[16 + row];
            const int chunk = ((nrow + 127) >> 7) | 1, beg = j * chunk, end = min(beg + chunk, nrow);
            int cg = 0, ce = 0;
            if (big) for (int i = beg; i < end; ++i) { const unsigned k16 = quant16(sc[row * 8192 + i], lo, scale); cg += k16 > T16 ? 1 : 0; ce += k16 == T16 ? 1 : 0; }
            const unsigned v = (unsigned)cg | ((unsigned)ce << 16);
            unsigned incl = v;
#pragma unroll
            for (int o = 1; o < 64; o <<= 1) { const unsigned t = __shfl_up(incl, o); if (lane >= o) incl += t; }
            LAS unsigned* wsum = (LAS unsigned*)(ctl + 32);
            if (lane == 63) wsum[wave] = incl;
            __syncthreads();
            const unsigned pre = incl - v + ((wave & 1) ? wsum[wave - 1] : 0u);
            if (big) {
                int eb = (int)(pre >> 16); int pos = (int)(pre & 0xffffu) + min(eb, need2);
                for (int i = beg; i < end; ++i) { const unsigned k16 = quant16(sc[row * 8192 + i], lo, scale);
                    if (k16 > T16) { if (pos < 256) IDX[tg * 256 + pos] = (unsigned short)i; ++pos; }
                    else if (k16 == T16) { if (eb < need2) { if (pos < 256) IDX[tg * 256 + pos] = (unsigned short)i; ++pos; } ++eb; } }
                if (j == 0) CNT[tg] = 256;
            } else {
#pragma unroll
                for (int i = 0; i < 2; ++i) { const int e = j + 128 * i; IDX[tg * 256 + e] = (unsigned short)(e < nrow ? e : 0); }
                if (j == 0) CNT[tg] = nrow;
            }
        }
        cur_item = nxt_item;
    }
}

__device__ __forceinline__ f32x4 mfma16(bf16x8 a, bf16x8 b, f32x4 c) { return __builtin_amdgcn_mfma_f32_16x16x32_bf16(a, b, c, 0, 0, 0); }
__device__ __forceinline__ float ex2(float v) { return __builtin_amdgcn_exp2f(v); }
__device__ __forceinline__ float fmax2(float a, float b) { return __builtin_amdgcn_fmed3f(a, b, __builtin_inff()); }
__device__ __forceinline__ float fmax3(float a, float b, float c) { return fmax2(fmax2(a, b), c); }
__device__ __forceinline__ unsigned cvtpk(float lo, float hi) { unsigned r; asm("v_cvt_pk_bf16_f32 %0, %1, %2" : "=v"(r) : "v"(lo), "v"(hi)); return r; }
__device__ __forceinline__ void load_k64(const bf16_t* Kb, int kb, int krow0, int kq, bf16x8 (&k)[8]) {
#pragma unroll
    for (int j = 0; j < 4; ++j) { const bf16_t* p = Kb + (size_t)(kb + 32 * (j >> 1) + 4 * (j & 1) + krow0) * 64 + 8 * kq; k[2 * j] = *(const bf16x8*)p; k[2 * j + 1] = *(const bf16x8*)(p + 32); }
}
__device__ __forceinline__ void load_v64(const bf16_t* Vt, int ldv, int kb, int lc, int kq, bf16x8 (&v)[8]) {
#pragma unroll
    for (int dt = 0; dt < 4; ++dt) { const bf16_t* p = Vt + (size_t)(16 * dt + lc) * ldv + kb + 8 * kq; v[2 * dt] = *(const bf16x8*)p; v[2 * dt + 1] = *(const bf16x8*)(p + 32); }
}
__device__ __forceinline__ void qk64(const bf16x8 (&k)[8], bf16x8 q0, bf16x8 q1, float (&s)[16]) {
#pragma unroll
    for (int j = 0; j < 4; ++j) { f32x4 a = (f32x4){0.f, 0.f, 0.f, 0.f}; a = mfma16(k[2 * j], q0, a); a = mfma16(k[2 * j + 1], q1, a);
#pragma unroll
        for (int i = 0; i < 4; ++i) s[(j >> 1) * 8 + (j & 1) * 4 + i] = a[i]; }
}
#define VAL64(d, lim, i) ((unsigned)((d) - (32 * ((i) >> 3) + ((i) & 7))) < (lim))
template <bool FULL> __device__ __forceinline__ void sm64(const float (&s)[16], int d, unsigned lim, float& m, float& l, f32x4 (&o)[4], bf16x8& pf0, bf16x8& pf1) {
    float mx = -1e30f;
#pragma unroll
    for (int i = 0; i < 16; i += 2) mx = fmax3(mx, (FULL || VAL64(d, lim, i)) ? s[i] : -1e30f, (FULL || VAL64(d, lim, i + 1)) ? s[i + 1] : -1e30f);
    mx = fmax2(mx, __shfl_xor(mx, 16)); mx = fmax2(mx, __shfl_xor(mx, 32));
    const float mn = fmax2(m, mx), alpha = ex2(m - mn);
    float pr[16], sum = 0.f;
#pragma unroll
    for (int i = 0; i < 16; ++i) { pr[i] = (FULL || VAL64(d, lim, i)) ? ex2(s[i] - mn) : 0.f; sum += pr[i]; }
    l = l * alpha + sum; m = mn;
#pragma unroll
    for (int dt = 0; dt < 4; ++dt) o[dt] = o[dt] * alpha;
    u32x4 w0, w1;
    w0.x = cvtpk(pr[0], pr[1]); w0.y = cvtpk(pr[2], pr[3]); w0.z = cvtpk(pr[4], pr[5]); w0.w = cvtpk(pr[6], pr[7]);
    w1.x = cvtpk(pr[8], pr[9]); w1.y = cvtpk(pr[10], pr[11]); w1.z = cvtpk(pr[12], pr[13]); w1.w = cvtpk(pr[14], pr[15]);
    pf0 = __builtin_bit_cast(bf16x8, w0); pf1 = __builtin_bit_cast(bf16x8, w1);
}
__device__ __forceinline__ void pv64(const bf16x8 (&v)[8], bf16x8 pf0, bf16x8 pf1, f32x4 (&o)[4]) {
#pragma unroll
    for (int dt = 0; dt < 4; ++dt) { o[dt] = mfma16(v[2 * dt], pf0, o[dt]); o[dt] = mfma16(v[2 * dt + 1], pf1, o[dt]); }
}
struct WinF { int kb0, tq, kq, s0; static constexpr unsigned LIM = 512u;
    __device__ __forceinline__ int kb(int i) const { return kb0 + 64 * i; }
    __device__ __forceinline__ bool full(int kbv) const { return kbv + 63 <= s0 && kbv > s0 + 15 - 512; }
    __device__ __forceinline__ int d(int kbv) const { return tq - kbv - 8 * kq; } };
struct SelF { int selv; int tq, kq, tqu; static constexpr unsigned LIM = 0x80000000u;
    __device__ __forceinline__ int kb(int i) const { return 64 * __builtin_amdgcn_readlane(selv, i); }
    __device__ __forceinline__ bool full(int kbv) const { return kbv + 63 <= tqu; }
    __device__ __forceinline__ int d(int kbv) const { return tq - kbv - 8 * kq; } };
template <class F> __device__ __forceinline__ void attn_blocks(const bf16_t* Kb, const bf16_t* Vt, int ldv, int n, const F& f, bf16x8 q0, bf16x8 q1, float& m, float& l, f32x4 (&o)[4], int lc, int kq, int krow0) {
    bf16x8 kA[8], kB[8], vA[8];
    int kbc = f.kb(0);
    load_k64(Kb, kbc, krow0, kq, kA);
#define ATT_STEP(KC, KN, idx) { \
        int kbn = kbc; const bool more = (idx) + 1 < n; \
        load_v64(Vt, ldv, kbc, lc, kq, vA); \
        if (more) { kbn = f.kb((idx) + 1); load_k64(Kb, kbn, krow0, kq, KN); } \
        __builtin_amdgcn_sched_barrier(0); \
        float s[16]; qk64(KC, q0, q1, s); bf16x8 pf0, pf1; if (f.full(kbc)) sm64<true>(s, 0, 0u, m, l, o, pf0, pf1); else sm64<false>(s, f.d(kbc), F::LIM, m, l, o, pf0, pf1); pv64(vA, pf0, pf1, o); kbc = kbn; __builtin_amdgcn_sched_barrier(0); }
#pragma unroll 1
    for (int i = 0; i < n; i += 2) {
        ATT_STEP(kA, kB, i)
        if (i + 1 < n) ATT_STEP(kB, kA, i + 1)
    }
#undef ATT_STEP
}
struct StgW { LAS unsigned char* gb; const bf16_t* kg; const bf16_t* vg; int wofs; };
__device__ __forceinline__ StgW stg_make(LAS unsigned char* stg, const bf16_t* Kb, const bf16_t* Vt, int ldv, int wave, int lane) {
    const int w4 = wave & 3, lr = lane >> 2, lcn = lane & 3; StgW w;
    w.gb = stg + (wave >> 2) * 36864; w.kg = Kb + (size_t)(16 * w4 + lr) * 64 + 16 * lcn; w.vg = Vt + (size_t)(16 * w4 + lr) * ldv + 16 * lcn; w.wofs = (16 * w4 + lr) * 144 + 32 * lcn; return w; }
__device__ __forceinline__ void stg_ldk(const StgW& w, int kb, u32x4& a, u32x4& b) { const bf16_t* kp = w.kg + (size_t)kb * 64; a = *(const u32x4*)kp; b = *(const u32x4*)(kp + 8); }
__device__ __forceinline__ void stg_ldv(const StgW& w, int kb, u32x4& a, u32x4& b) { const bf16_t* vp = w.vg + kb; a = *(const u32x4*)vp; b = *(const u32x4*)(vp + 8); }
__device__ __forceinline__ void stg_stk(const StgW& w, int buf, u32x4 a, u32x4 b) { LAS unsigned char* d = w.gb + buf * 18432 + w.wofs; *(LAS u32x4*)d = a; *(LAS u32x4*)(d + 16) = b; }
__device__ __forceinline__ void stg_stv(const StgW& w, int buf, u32x4 a, u32x4 b) { LAS unsigned char* d = w.gb + buf * 18432 + 9216 + w.wofs; *(LAS u32x4*)d = a; *(LAS u32x4*)(d + 16) = b; }
__device__ __forceinline__ void stg_rdk(const LAS unsigned char* b, int krow0, int kq, bf16x8 (&kf)[8]) {
#pragma unroll
    for (int j = 0; j < 4; ++j) { const LAS unsigned char* rp = b + (32 * (j >> 1) + 4 * (j & 1) + krow0) * 144 + 16 * kq; kf[2 * j] = *(const LAS bf16x8*)rp; kf[2 * j + 1] = *(const LAS bf16x8*)(rp + 64); }
}
__device__ __forceinline__ void stg_rdv(const LAS unsigned char* b, int lc, int kq, bf16x8 (&vf)[8]) {
#pragma unroll
    for (int dt = 0; dt < 4; ++dt) { const LAS unsigned char* rp = b + 9216 + (16 * dt + lc) * 144 + 16 * kq; vf[2 * dt] = *(const LAS bf16x8*)rp; vf[2 * dt + 1] = *(const LAS bf16x8*)(rp + 64); }
}
__device__ __forceinline__ void window_lds(LAS unsigned char* stg, const bf16_t* Kw, const bf16_t* Vw, int kb0, int n, int wave, int lane, int lc, int kq, int krow0, const WinF& wf,
                                           bf16x8 q0, bf16x8 q1, float& m, float& l, f32x4 (&o)[4]) {
    const int w4 = wave & 3;
    LAS unsigned char* gb = stg + (wave >> 2) * 36864;
    const int lr = lane >> 2, lcn = lane & 3;
    const bf16_t* kg = Kw + (size_t)(16 * w4 + lr) * 64 + 16 * lcn;
    const bf16_t* vg = Vw + (size_t)(16 * w4 + lr) * LDV + 16 * lcn;
    const int wofs = (16 * w4 + lr) * 144 + 32 * lcn;
    u32x4 pk0, pk1, pv0, pv1;
    { const bf16_t* kp = kg + (size_t)kb0 * 64; const bf16_t* vp = vg + kb0;
      pk0 = *(const u32x4*)kp; pk1 = *(const u32x4*)(kp + 8); pv0 = *(const u32x4*)vp; pv1 = *(const u32x4*)(vp + 8); }
    *(LAS u32x4*)(gb + wofs) = pk0; *(LAS u32x4*)(gb + wofs + 16) = pk1; *(LAS u32x4*)(gb + 9216 + wofs) = pv0; *(LAS u32x4*)(gb + 9216 + wofs + 16) = pv1;
    __syncthreads();
#pragma unroll 1
    for (int i = 0; i < n; ++i) {
        const int kbc = kb0 + 64 * i; const bool more = i + 1 < n;
        if (more) { const bf16_t* kp = kg + (size_t)(kbc + 64) * 64; const bf16_t* vp = vg + kbc + 64;
            pk0 = *(const u32x4*)kp; pk1 = *(const u32x4*)(kp + 8); pv0 = *(const u32x4*)vp; pv1 = *(const u32x4*)(vp + 8); }
        const LAS unsigned char* b = gb + (i & 1) * 18432;
        bf16x8 kf[8], vf[8];
#pragma unroll
        for (int j = 0; j < 4; ++j) { const LAS unsigned char* rp = b + (32 * (j >> 1) + 4 * (j & 1) + krow0) * 144 + 16 * kq; kf[2 * j] = *(const LAS bf16x8*)rp; kf[2 * j + 1] = *(const LAS bf16x8*)(rp + 64); }
#pragma unroll
        for (int dt = 0; dt < 4; ++dt) { const LAS unsigned char* rp = b + 9216 + (16 * dt + lc) * 144 + 16 * kq; vf[2 * dt] = *(const LAS bf16x8*)rp; vf[2 * dt + 1] = *(const LAS bf16x8*)(rp + 64); }
        float s[16]; qk64(kf, q0, q1, s); bf16x8 pf0, pf1;
        if (wf.full(kbc)) sm64<true>(s, 0, 0u, m, l, o, pf0, pf1); else sm64<false>(s, wf.d(kbc), WinF::LIM, m, l, o, pf0, pf1);
        pv64(vf, pf0, pf1, o);
        if (more) { LAS unsigned char* nb = gb + ((i + 1) & 1) * 18432;
            *(LAS u32x4*)(nb + wofs) = pk0; *(LAS u32x4*)(nb + wofs + 16) = pk1; *(LAS u32x4*)(nb + 9216 + wofs) = pv0; *(LAS u32x4*)(nb + 9216 + wofs + 16) = pv1; }
        __syncthreads();
    }
}
__device__ __forceinline__ void qk32(const bf16_t* k0p, const bf16_t* k1p, bf16x8 q0, bf16x8 q1, float (&s)[8]) {
    const bf16x8 ka = *(const bf16x8*)k0p, kb = *(const bf16x8*)(k0p + 32), kc = *(const bf16x8*)k1p, kd = *(const bf16x8*)(k1p + 32);
    f32x4 s0 = (f32x4){0.f, 0.f, 0.f, 0.f}, s1 = s0;
    s0 = mfma16(ka, q0, s0); s0 = mfma16(kb, q1, s0); s1 = mfma16(kc, q0, s1); s1 = mfma16(kd, q1, s1);
#pragma unroll
    for (int i = 0; i < 4; ++i) { s[i] = s0[i]; s[4 + i] = s1[i]; }
}
__device__ __forceinline__ bf16x8 sm_step(const float (&s)[8], int d2, float& m, float& l, f32x4 (&o)[4]) {
    float mx = -1e30f;
#pragma unroll
    for (int i = 0; i < 8; i += 2) mx = fmax3(mx, (i < d2) ? s[i] : -1e30f, (i + 1 < d2) ? s[i + 1] : -1e30f);
    mx = fmax2(mx, __shfl_xor(mx, 16)); mx = fmax2(mx, __shfl_xor(mx, 32));
    const float mn = fmax2(m, mx), alpha = ex2(m - mn);
    float pr[8], sum = 0.f;
#pragma unroll
    for (int i = 0; i < 8; ++i) { pr[i] = (i < d2) ? ex2(s[i] - mn) : 0.f; sum += pr[i]; }
    l = l * alpha + sum; m = mn;
#pragma unroll
    for (int dt = 0; dt < 4; ++dt) o[dt] = o[dt] * alpha;
    u32x4 w; w.x = cvtpk(pr[0], pr[1]); w.y = cvtpk(pr[2], pr[3]); w.z = cvtpk(pr[4], pr[5]); w.w = cvtpk(pr[6], pr[7]);
    return __builtin_bit_cast(bf16x8, w);
}
struct DsaL { bf16x8 ka, kb, kc, kd; u32x4 v0, v1, v2, v3; };
__device__ __forceinline__ void dsa_load(const unsigned short* idx, int sb, int krow0, int kq, int lane, const bf16_t* Kb, const bf16_t* Vb, DsaL& L) {
    const int i0 = idx[sb + krow0], i1 = idx[sb + krow0 + 4], vkey = idx[sb + (lane >> 1)];
    const bf16_t* k0p = Kb + (size_t)i0 * 64 + 8 * kq; const bf16_t* k1p = Kb + (size_t)i1 * 64 + 8 * kq;
    L.ka = *(const bf16x8*)k0p; L.kb = *(const bf16x8*)(k0p + 32); L.kc = *(const bf16x8*)k1p; L.kd = *(const bf16x8*)(k1p + 32);
    const bf16_t* vp = Vb + (size_t)vkey * 64 + (lane & 1) * 32;
    L.v0 = *(const u32x4*)vp; L.v1 = *(const u32x4*)(vp + 8); L.v2 = *(const u32x4*)(vp + 16); L.v3 = *(const u32x4*)(vp + 24);
}
__device__ __forceinline__ void dsa_compute(const DsaL& L, bf16x8 q0, bf16x8 q1, int d2, float& m, float& l, f32x4 (&o)[4], LAS unsigned char* vreg, int lane, int lc, int kq) {
    f32x4 s0 = (f32x4){0.f, 0.f, 0.f, 0.f}, s1 = s0;
    s0 = mfma16(L.ka, q0, s0); s0 = mfma16(L.kb, q1, s0); s1 = mfma16(L.kc, q0, s1); s1 = mfma16(L.kd, q1, s1);
    float s[8];
#pragma unroll
    for (int i = 0; i < 4; ++i) { s[i] = s0[i]; s[4 + i] = s1[i]; }
    const bf16x8 pf = sm_step(s, d2, m, l, o);
    LAS u32x4* wdst = (LAS u32x4*)(vreg + (lane >> 1) * 144 + (lane & 1) * 64);
    wdst[0] = L.v0; wdst[1] = L.v1; wdst[2] = L.v2; wdst[3] = L.v3;
    LDS_WAIT();
    const unsigned taddr = (unsigned)(size_t)vreg + (unsigned)((8 * kq + (lc >> 2)) * 144 + 8 * (lc & 3));
    u32x2 t0, t1, t2, t3, t4, t5, t6, t7;
    asm volatile("ds_read_b64_tr_b16 %0, %8\n\tds_read_b64_tr_b16 %1, %8 offset:576\n\tds_read_b64_tr_b16 %2, %8 offset:32\n\tds_read_b64_tr_b16 %3, %8 offset:608\n\t"
                 "ds_read_b64_tr_b16 %4, %8 offset:64\n\tds_read_b64_tr_b16 %5, %8 offset:640\n\tds_read_b64_tr_b16 %6, %8 offset:96\n\tds_read_b64_tr_b16 %7, %8 offset:672\n\ts_waitcnt lgkmcnt(0)"
                 : "=&v"(t0), "=&v"(t1), "=&v"(t2), "=&v"(t3), "=&v"(t4), "=&v"(t5), "=&v"(t6), "=&v"(t7) : "v"(taddr) : "memory");
    o[0] = mfma16(__builtin_bit_cast(bf16x8, (u32x4){t0.x, t0.y, t1.x, t1.y}), pf, o[0]);
    o[1] = mfma16(__builtin_bit_cast(bf16x8, (u32x4){t2.x, t2.y, t3.x, t3.y}), pf, o[1]);
    o[2] = mfma16(__builtin_bit_cast(bf16x8, (u32x4){t4.x, t4.y, t5.x, t5.y}), pf, o[2]);
    o[3] = mfma16(__builtin_bit_cast(bf16x8, (u32x4){t6.x, t6.y, t7.x, t7.y}), pf, o[3]);
}
__device__ __forceinline__ void attn_phase(KP p, LAS unsigned char* lds, int wv) {
    int tid_ = mk_tid(wv); asm volatile("" : "+v"(tid_)); const int tid = tid_, lane = tid & 63; int wave = wv; asm volatile("" : "+s"(wave));
    LAS float* imp = (LAS float*)lds;
    LAS float* obuf = (LAS float*)(lds + 65536);
    LAS int* sel = (LAS int*)(lds + 98304);
    const bf16_t* QA = (const bf16_t*)(p->ws + WS_QA); const bf16_t* QB = (const bf16_t*)(p->ws + WS_QB);
    const bf16_t* KA = (const bf16_t*)(p->ws + WS_KA); const bf16_t* VA = (const bf16_t*)(p->ws + WS_VA);
    const bf16_t* KS = (const bf16_t*)(p->ws + WS_KS); const bf16_t* KW = (const bf16_t*)(p->ws + WS_KW);
    const bf16_t* VST = (const bf16_t*)(p->ws + WS_VST); const bf16_t* VWT = (const bf16_t*)(p->ws + WS_VWT);
    const bf16_t* KC = (const bf16_t*)(p->ws + WS_KC); const bf16_t* VCT = (const bf16_t*)(p->ws + WS_VCT);
    const float* GATES = (const float*)(p->ws + WS_GATES);
    const unsigned short* IDX = (const unsigned short*)(p->ws + WS_IDX); const int* CNT = (const int*)(p->ws + WS_CNT);
    bf16_t* OA = (bf16_t*)(p->ws + WS_OA); bf16_t* OB = (bf16_t*)(p->ws + WS_OB);
    const int G_ = mk_grid(), bid_ = mk_bid();
    const bool aff = (G_ & 1) == 0;
    int* SELG = (int*)(p->ws + WS_SEL);
#pragma unroll 1
    for (int it_ = 0; ; ++it_) {
        int tile;
        if (aff) { const int hw = G_ >> 1, li = bid_ >> 1; if (it_ * hw >= T / 32) break; tile = (bid_ & 1) * (T / 32) + hw * it_ + ((it_ & 1) ? (hw - 1 - li) : li); }
        else { tile = bid_ + G_ * it_; if (tile >= T / 16) break; }
        const int tg0 = tile * 16, b = tg0 >> 13, s0 = tg0 & (S - 1);
        __syncthreads();
        for (int i = tid; i < 8 * 16 * 128; i += 512) imp[i] = 0.f;
        __syncthreads();
        {
            int l2_ = lane; asm volatile("" : "+v"(l2_)); const int lc = l2_ & 15, kq = l2_ >> 4, krow0 = 8 * (lc >> 2) + (lc & 3);
            const int h = wave, g = h >> 2, bg = b * 2 + g;
            const int tq = s0 + lc;
            const bf16_t* qrow = QB + (size_t)(tg0 + lc) * 512 + h * 64 + 8 * kq;
            const bf16x8 q0 = *(const bf16x8*)qrow, q1 = *(const bf16x8*)(qrow + 32);
            const float g0 = GATES[(size_t)(tg0 + lc) * 24 + h * 3 + 0], g2 = GATES[(size_t)(tg0 + lc) * 24 + h * 3 + 2];
            f32x4 oc[4], ow[4];
#pragma unroll
            for (int dt = 0; dt < 4; ++dt) { oc[dt] = (f32x4){0.f, 0.f, 0.f, 0.f}; ow[dt] = oc[dt]; }
            if (s0 + 15 >= 31) {
                const int cmax = (s0 + 15 - 31) >> 4;
                const bf16_t* Kc = KC + (size_t)bg * 512 * 64; const bf16_t* Vc = VCT + (size_t)bg * 64 * 512;
                const int cq = tq >= 31 ? (tq - 31) >> 4 : -1;
                const int nst = cmax / 64 + 1;
                float m = -1e30f, l = 0.f;
                const StgW sw = stg_make(lds + 65536, Kc, Vc, 512, wave, lane);
                {
                    u32x4 pk0, pk1;
                    stg_ldk(sw, 0, pk0, pk1); stg_stk(sw, 0, pk0, pk1);
                    __syncthreads();
#pragma unroll 1
                    for (int st = 0; st < nst; ++st) {
                        const bool more = st + 1 < nst;
                        if (more) stg_ldk(sw, 64 * (st + 1), pk0, pk1);
                        bf16x8 kf[8]; stg_rdk(sw.gb + (st & 1) * 18432, krow0, kq, kf);
                        float s[16]; qk64(kf, q0, q1, s); const int kb = 64 * st; float mx = -1e30f;
                        const int dd = cq - kb - 8 * kq;
#pragma unroll
                        for (int i = 0; i < 16; i += 2) mx = fmax3(mx, VAL64(dd, 0x80000000u, i) ? s[i] : -1e30f, VAL64(dd, 0x80000000u, i + 1) ? s[i + 1] : -1e30f);
                        mx = fmax2(mx, __shfl_xor(mx, 16)); mx = fmax2(mx, __shfl_xor(mx, 32));
                        const float mn = fmax2(m, mx); float sum = 0.f;
#pragma unroll
                        for (int i = 0; i < 16; ++i) sum += VAL64(dd, 0x80000000u, i) ? ex2(s[i] - mn) : 0.f;
                        l = l * ex2(m - mn) + sum; m = mn;
                        if (more) stg_stk(sw, (st + 1) & 1, pk0, pk1);
                        __syncthreads();
                    }
                }
                l += __shfl_xor(l, 16); l += __shfl_xor(l, 32);
                const float inv = l > 0.f ? 1.f / l : 0.f;
                float carry = 0.f;
                u32x4 pk0, pk1, pv0, pv1;
                stg_ldk(sw, 0, pk0, pk1); stg_ldv(sw, 0, pv0, pv1); stg_stk(sw, 0, pk0, pk1); stg_stv(sw, 0, pv0, pv1);
                __syncthreads();
#pragma unroll 1
                for (int st = 0; st < nst; ++st) {
                    const int kb = 64 * st; bf16x8 kA[8], vA[8]; float s[16], pr[16];
                    const bool more = st + 1 < nst;
                    if (more) { stg_ldk(sw, kb + 64, pk0, pk1); stg_ldv(sw, kb + 64, pv0, pv1); }
                    stg_rdk(sw.gb + (st & 1) * 18432, krow0, kq, kA); stg_rdv(sw.gb + (st & 1) * 18432, lc, kq, vA);
                    qk64(kA, q0, q1, s);
#pragma unroll
                    for (int i = 0; i < 16; ++i) pr[i] = VAL64(cq - kb - 8 * kq, 0x80000000u, i) ? ex2(s[i] - m) * inv : 0.f;
                    u32x4 w0, w1;
                    w0.x = cvtpk(pr[0], pr[1]); w0.y = cvtpk(pr[2], pr[3]); w0.z = cvtpk(pr[4], pr[5]); w0.w = cvtpk(pr[6], pr[7]);
                    w1.x = cvtpk(pr[8], pr[9]); w1.y = cvtpk(pr[10], pr[11]); w1.z = cvtpk(pr[12], pr[13]); w1.w = cvtpk(pr[14], pr[15]);
                    pv64(vA, __builtin_bit_cast(bf16x8, w0), __builtin_bit_cast(bf16x8, w1), oc);
#pragma unroll
                    for (int gr = 0; gr < 2; ++gr) {
                        const float p7 = pr[8 * gr + 7];
                        const float up = __shfl_up(p7, 16);
                        const float wrap = __shfl_down(p7, 48);
                        const float prev = kq == 0 ? carry : up;
                        carry = wrap;
                        const float e0 = (pr[8 * gr + 0] + pr[8 * gr + 1]) + (pr[8 * gr + 2] + pr[8 * gr + 3]) + prev;
                        const float e1 = (pr[8 * gr + 4] + pr[8 * gr + 5]) + (pr[8 * gr + 6] + pr[8 * gr + 7]) + pr[8 * gr + 3];
                        const int n0 = (kb + 32 * gr) / 4 + 2 * kq;
                        imp[(h * 16 + lc) * 128 + n0] = e0; imp[(h * 16 + lc) * 128 + n0 + 1] = e1;
                    }
                    if (more) { stg_stk(sw, (st + 1) & 1, pk0, pk1); stg_stv(sw, (st + 1) & 1, pv0, pv1); }
                    __syncthreads();
                }
            }
            {
                const bf16_t* Kw = KW + (size_t)bg * S * 64; const bf16_t* Vw = VWT + (size_t)bg * 64 * LDV;
                float m = -1e30f, l = 0.f;
                const int kb0 = s0 >= 512 ? s0 - 512 : 0;
                const WinF wf{kb0, tq, kq, s0};
                window_lds(lds + 65536, Kw, Vw, kb0, (s0 + 16 - kb0 + 63) >> 6, wave, lane, lc, kq, krow0, wf, q0, q1, m, l, ow);
                l += __shfl_xor(l, 16); l += __shfl_xor(l, 32);
                const float inv = l > 0.f ? g2 / l : 0.f;
#pragma unroll
                for (int dt = 0; dt < 4; ++dt) { const f32x4 o = oc[dt] * g0 + ow[dt] * inv; *(LAS f32x4*)(obuf + lc * 512 + h * 64 + 16 * dt + 4 * kq) = o; }
            }
        }
        __syncthreads();
#pragma unroll 1
        for (int rr = 0; rr < 4; ++rr) {
            const int row = wave * 4 + rr, q = row >> 1, g = row & 1, tq = s0 + q, cur = tq >> 6;
            LAS unsigned long long* kbuf = (LAS unsigned long long*)(lds + 100352 + wave * 1024);
            unsigned long long key[2];
#pragma unroll
            for (int hf = 0; hf < 2; ++hf) { const int n = lane + 64 * hf;
                float v = ((imp[((4 * g + 0) * 16 + q) * 128 + n] + imp[((4 * g + 1) * 16 + q) * 128 + n]) + imp[((4 * g + 2) * 16 + q) * 128 + n]) + imp[((4 * g + 3) * 16 + q) * 128 + n];
                if (n == 0 || n == cur) v = 1e4f; else if (64 * n > tq) v = -1.f;
                unsigned u = __builtin_bit_cast(unsigned, v); u = (u & 0x80000000u) ? ~u : (u | 0x80000000u);
                key[hf] = ((unsigned long long)u << 32) | (unsigned)(127 - n); }
            LDS_WAIT();
            kbuf[lane] = key[0]; kbuf[lane + 64] = key[1];
            LDS_WAIT();
            int r0 = 0, r1 = 0;
#pragma unroll 16
            for (int mI = 0; mI < 128; ++mI) { const unsigned long long k = kbuf[mI]; r0 += k > key[0] ? 1 : 0; r1 += k > key[1] ? 1 : 0; }
            if (r0 < 16) { sel[row * 16 + r0] = lane; SELG[((size_t)tile * 32 + row) * 16 + r0] = lane; }
            if (r1 < 16) { sel[row * 16 + r1] = lane + 64; SELG[((size_t)tile * 32 + row) * 16 + r1] = lane + 64; }
        }
        __syncthreads();
        {
            int l2_ = lane; asm volatile("" : "+v"(l2_)); const int lc = l2_ & 15, kq = l2_ >> 4, krow0 = 8 * (lc >> 2) + (lc & 3);
            const size_t tgA = (size_t)tg0 + wave * 2, tgB = tgA + 1;
            const bf16_t* qrA = QA + tgA * 512 + (lc & 7) * 64 + 8 * kq; const bf16_t* qrB = qrA + 512;
            const bf16x8 qA0 = *(const bf16x8*)qrA, qA1 = *(const bf16x8*)(qrA + 32), qB0 = *(const bf16x8*)qrB, qB1 = *(const bf16x8*)(qrB + 32);
            const int cntA = CNT[tgA], cntB = CNT[tgB], cmaxq = cntA > cntB ? cntA : cntB;
            const unsigned short* idxA = IDX + tgA * 256; const unsigned short* idxB = IDX + tgB * 256;
            const bf16_t* Kb = KA + (size_t)b * S * 64; const bf16_t* Vb = VA + (size_t)b * S * 64;
            LAS unsigned char* vregA = lds + 108544 + wave * 4608; LAS unsigned char* vregB = lds + wave * 4608;
            f32x4 oA[4], oB[4];
#pragma unroll
            for (int dt = 0; dt < 4; ++dt) { oA[dt] = (f32x4){0.f, 0.f, 0.f, 0.f}; oB[dt] = oA[dt]; }
            float mA = -1e30f, lA = 0.f, mB = -1e30f, lB = 0.f;
#pragma unroll 1
            for (int sb = 0; sb < 256; sb += 32) {
                if (sb >= cmaxq) break;
                DsaL LA, LB;
                dsa_load(idxA, sb, krow0, kq, lane, Kb, Vb, LA); dsa_load(idxB, sb, krow0, kq, lane, Kb, Vb, LB);
                __builtin_amdgcn_sched_barrier(0);
                dsa_compute(LA, qA0, qA1, cntA - sb - 8 * kq, mA, lA, oA, vregA, lane, lc, kq);
                dsa_compute(LB, qB0, qB1, cntB - sb - 8 * kq, mB, lB, oB, vregB, lane, lc, kq);
            }
            lA += __shfl_xor(lA, 16); lA += __shfl_xor(lA, 32); lB += __shfl_xor(lB, 16); lB += __shfl_xor(lB, 32);
            const float invA = lA > 0.f ? 1.f / lA : 0.f, invB = lB > 0.f ? 1.f / lB : 0.f;
            if (lc < 8) {
#pragma unroll
                for (int dt = 0; dt < 4; ++dt) { const f32x4 va = oA[dt] * invA, vb = oB[dt] * invB; u32x2 wa, wb; wa.x = pk2(va[0], va[1]); wa.y = pk2(va[2], va[3]); wb.x = pk2(vb[0], vb[1]); wb.y = pk2(vb[2], vb[3]);
                    *(u32x2*)(OA + tgA * 1024 + lc * 64 + 16 * dt + 4 * kq) = wa; *(u32x2*)(OA + tgB * 1024 + lc * 64 + 16 * dt + 4 * kq) = wb; }
            }
        }
        __syncthreads();
#pragma unroll
        for (int i = 0; i < 2; ++i) { const int e = (i * 512 + tid) * 8;
            const f32x4 a = *(const LAS f32x4*)(obuf + e), c = *(const LAS f32x4*)(obuf + e + 4);
            u32x4 w; w.x = pk2(a[0], a[1]); w.y = pk2(a[2], a[3]); w.z = pk2(c[0], c[1]); w.w = pk2(c[2], c[3]);
            *(u32x4*)(OA + (size_t)(tg0 + (e >> 9)) * 1024 + 512 + (e & 511)) = w; }
    }
}

struct SetSt { bf16x8 q0, q1; float m, l; f32x4 o[4]; unsigned long long mlo, mhi; int tq, tqmin; };
__device__ __forceinline__ void set_step(SetSt& st, const bf16x8 (&KC)[8], const bf16x8 (&vA)[8], int kbc, int kq) {
    const int n = kbc >> 6; const unsigned long long mw = n < 64 ? st.mlo : st.mhi; const bool mem = (mw >> (n & 63)) & 1ull;
    const unsigned long long bm = __ballot(mem);
    if (bm != 0ull) {
        float s[16]; qk64(KC, st.q0, st.q1, s); bf16x8 pf0, pf1;
        if (bm == ~0ull && kbc + 63 <= st.tqmin) sm64<true>(s, 0, 0u, st.m, st.l, st.o, pf0, pf1);
        else sm64<false>(s, mem ? st.tq - kbc - 8 * kq : -1, 0x80000000u, st.m, st.l, st.o, pf0, pf1);
        pv64(vA, pf0, pf1, st.o);
    }
}
__device__ __forceinline__ void attn_sel_phase_walk(KP p, LAS unsigned char* lds, int wv, const bool dummy, const bool nowrite = false) {
    int tid_ = mk_tid(wv); asm volatile("" : "+v"(tid_)); const int lane = tid_ & 63; int wave = wv; asm volatile("" : "+s"(wave));
    const bf16_t* QB = (const bf16_t*)(p->ws + WS_QB); const bf16_t* KS = (const bf16_t*)(p->ws + WS_KS); const bf16_t* VST = (const bf16_t*)(p->ws + WS_VST);
    const float* GATES = (const float*)(p->ws + WS_GATES); const int* SELG = (const int*)(p->ws + WS_SEL); bf16_t* OB = (bf16_t*)(p->ws + WS_OA);
    LAS int* list = (LAS int*)(lds + wave * 512);
    const int G_ = mk_grid(), bid_ = mk_bid();
    const bool aff2 = (G_ & 3) == 0 && ((T / 32) % (G_ >> 2)) == 0 && (((T / 32) / (G_ >> 2)) & 3) == 0;
    const int npass = aff2 ? ((T / 32) / (G_ >> 2)) / 4 : (T / 32 + G_ - 1) / G_;
#pragma unroll 1
    for (int ps = 0; ps < npass; ++ps) {
        int l2_ = lane; asm volatile("" : "+v"(l2_)); const int lc = l2_ & 15, kq = l2_ >> 4, krow0 = 8 * (lc >> 2) + (lc & 3);
        int tile, g, half;
        if (aff2) { const int nb = G_ >> 2, jb = bid_ >> 2, k = 4 * ps + (wave >> 1);
            tile = (bid_ & 1) * (T / 32) + nb * k + ((k & 1) ? (nb - 1 - jb) : jb); g = (bid_ >> 1) & 1; half = wave & 1; }
        else { const int tp = ps * G_ + ((ps & 1) ? (G_ - 1 - bid_) : bid_); if (tp >= T / 32) continue;
            tile = 2 * tp + (wave >> 2); g = (wave >> 1) & 1; half = wave & 1; }
        const int tg0 = tile * 16, b = tg0 >> 13, s0 = tg0 & (S - 1), bg = b * 2 + g, hh = 4 * g + (lc & 3);
        SetSt st[2];
#pragma unroll
        for (int si = 0; si < 2; ++si) {
            const int q = 8 * half + 4 * si + (lc >> 2), row = q * 2 + g;
            unsigned mk0 = 0u, mk1 = 0u, mk2 = 0u, mk3 = 0u;
            const int* sp = SELG + ((size_t)tile * 32 + row) * 16;
#pragma unroll
            for (int c4 = 0; c4 < 4; ++c4) { const u32x4 v = *(const u32x4*)(sp + 4 * c4); const unsigned va[4] = {v.x, v.y, v.z, v.w};
#pragma unroll
                for (int j = 0; j < 4; ++j) { const unsigned n = dummy ? 0u : va[j], bit = 1u << (n & 31u), w = n >> 5;
                    mk0 |= w == 0u ? bit : 0u; mk1 |= w == 1u ? bit : 0u; mk2 |= w == 2u ? bit : 0u; mk3 |= w == 3u ? bit : 0u; } }
            st[si].mlo = (unsigned long long)mk0 | ((unsigned long long)mk1 << 32); st[si].mhi = (unsigned long long)mk2 | ((unsigned long long)mk3 << 32);
            st[si].tq = s0 + q; st[si].tqmin = s0 + 8 * half + 4 * si;
            const bf16_t* qrow = QB + (size_t)(tg0 + q) * 512 + hh * 64 + 8 * kq;
            st[si].q0 = *(const bf16x8*)qrow; st[si].q1 = *(const bf16x8*)(qrow + 32);
            st[si].m = -1e30f; st[si].l = 0.f;
#pragma unroll
            for (int dt = 0; dt < 4; ++dt) st[si].o[dt] = (f32x4){0.f, 0.f, 0.f, 0.f};
        }
        unsigned long long Ulo = 0ull, Uhi = 0ull;
#pragma unroll
        for (int si = 0; si < 2; ++si)
#pragma unroll
            for (int j = 0; j < 4; ++j) {
                Ulo |= (unsigned long long)(unsigned)__builtin_amdgcn_readlane((int)(unsigned)st[si].mlo, 4 * j) | ((unsigned long long)(unsigned)__builtin_amdgcn_readlane((int)(unsigned)(st[si].mlo >> 32), 4 * j) << 32);
                Uhi |= (unsigned long long)(unsigned)__builtin_amdgcn_readlane((int)(unsigned)st[si].mhi, 4 * j) | ((unsigned long long)(unsigned)__builtin_amdgcn_readlane((int)(unsigned)(st[si].mhi >> 32), 4 * j) << 32);
            }
        LDS_WAIT();
        const unsigned long long ltm = (1ull << lane) - 1ull;
        const int c0 = __popcll(Ulo), cntu = c0 + __popcll(Uhi);
        if ((Ulo >> lane) & 1ull) list[__popcll(Ulo & ltm)] = lane;
        if ((Uhi >> lane) & 1ull) list[c0 + __popcll(Uhi & ltm)] = 64 + lane;
        LDS_WAIT();
        const int listv = list[lane], listv2 = list[64 + lane];
        LDS_WAIT();
        const bf16_t* Ks = KS + (size_t)bg * S * 64; const bf16_t* Vs = VST + (size_t)bg * 64 * LDV;
        {
            bf16x8 kA[8], kB[8], vA[8];
#define LISTKB(i) (64 * ((i) < 64 ? __builtin_amdgcn_readlane(listv, (i)) : __builtin_amdgcn_readlane(listv2, (i) - 64)))
            int kbc = LISTKB(0);
            load_k64(Ks, kbc, krow0, kq, kA);
#define SEL_STEP(KC, KN, idx) { \
            int kbn = kbc; const bool more = (idx) + 1 < cntu; \
            load_v64(Vs, LDV, kbc, lc, kq, vA); \
            if (more) { kbn = LISTKB((idx) + 1); load_k64(Ks, kbn, krow0, kq, KN); } \
            __builtin_amdgcn_sched_barrier(0); \
            set_step(st[0], KC, vA, kbc, kq); set_step(st[1], KC, vA, kbc, kq); \
            kbc = kbn; __builtin_amdgcn_sched_barrier(0); }
#pragma unroll 1
            for (int i = 0; i < cntu; i += 2) {
                SEL_STEP(kA, kB, i)
                if (i + 1 < cntu) SEL_STEP(kB, kA, i + 1)
            }
#undef SEL_STEP
#undef LISTKB
        }
#pragma unroll
        for (int si = 0; si < 2; ++si) {
            const int q = 8 * half + 4 * si + (lc >> 2);
            float l = st[si].l; l += __shfl_xor(l, 16); l += __shfl_xor(l, 32);
            const float g1 = GATES[(size_t)(tg0 + q) * 24 + hh * 3 + 1];
            const float inv = l > 0.f ? g1 / l : 0.f;
            if ((!dummy && !nowrite) || l == -1.f) {
#pragma unroll
                for (int dt = 0; dt < 4; ++dt) { bf16_t* dst = OB + (size_t)(tg0 + q) * 1024 + 512 + hh * 64 + 16 * dt + 4 * kq; const u32x2 ow = *(const u32x2*)dst;
                    const f32x4 v = st[si].o[dt] * inv; u32x2 w; w.x = pk2(bflo(ow.x) + v[0], bfhi(ow.x) + v[1]); w.y = pk2(bflo(ow.y) + v[2], bfhi(ow.y) + v[3]); *(u32x2*)dst = w; }
            }
        }
    }
}

__device__ __forceinline__ void attn_sel_phase(KP p, LAS unsigned char* lds, int wv, const bool dummy, const bool nowrite = false) {
    const int G_ = mk_grid(), bid_ = mk_bid();
    const bool aff2 = (G_ & 3) == 0 && ((T / 32) % (G_ >> 2)) == 0 && (((T / 32) / (G_ >> 2)) & 3) == 0;
    if (!aff2 || dummy) { attn_sel_phase_walk(p, lds, wv, dummy, nowrite); return; }
    int tid_ = mk_tid(wv); asm volatile("" : "+v"(tid_)); const int lane = tid_ & 63; int wave = wv; asm volatile("" : "+s"(wave));
    const bf16_t* QB = (const bf16_t*)(p->ws + WS_QB); const bf16_t* KS = (const bf16_t*)(p->ws + WS_KS); const bf16_t* VST = (const bf16_t*)(p->ws + WS_VST);
    const float* GATES = (const float*)(p->ws + WS_GATES); const int* SELG = (const int*)(p->ws + WS_SEL); bf16_t* OB = (bf16_t*)(p->ws + WS_OA);
    const int nb = G_ >> 2, jb = bid_ >> 2, b = bid_ & 1, g = (bid_ >> 1) & 1, bg = b * 2 + g;
    const int npass = ((T / 32) / nb) / 4;
    const bf16_t* Ks = KS + (size_t)bg * S * 64; const bf16_t* Vs = VST + (size_t)bg * 64 * LDV;
    const int srow = 8 * wave + (lane >> 3), sch = lane & 7;
    const bf16_t* kgp = Ks + (size_t)srow * 64 + 8 * sch;
    const bf16_t* vgp = Vs + (size_t)srow * LDV + 8 * sch;
    const int wofs = srow * 144 + 16 * sch;
#pragma unroll 1
    for (int ps = 0; ps < npass; ++ps) {
        int l2_ = lane; asm volatile("" : "+v"(l2_)); const int lc = l2_ & 15, kq = l2_ >> 4, krow0 = 8 * (lc >> 2) + (lc & 3);
        const int k = 4 * ps + (wave >> 1), half = wave & 1;
        const int tile = b * (T / 32) + nb * k + ((k & 1) ? (nb - 1 - jb) : jb);
        const int tg0 = tile * 16, s0 = tg0 & (S - 1), hh = 4 * g + (lc & 3);
        const int k3 = 4 * ps + 3, s0max = 16 * (nb * k3 + ((k3 & 1) ? (nb - 1 - jb) : jb));
        const int nsteps = ((s0max + 15) >> 6) + 1;
        SetSt st[2];
#pragma unroll
        for (int si = 0; si < 2; ++si) {
            const int q = 8 * half + 4 * si + (lc >> 2), row = q * 2 + g;
            unsigned mk0 = 0u, mk1 = 0u, mk2 = 0u, mk3 = 0u;
            const int* sp = SELG + ((size_t)tile * 32 + row) * 16;
#pragma unroll
            for (int c4 = 0; c4 < 4; ++c4) { const u32x4 v = *(const u32x4*)(sp + 4 * c4); const unsigned va[4] = {v.x, v.y, v.z, v.w};
#pragma unroll
                for (int j = 0; j < 4; ++j) { const unsigned n = va[j], bit = 1u << (n & 31u), w = n >> 5;
                    mk0 |= w == 0u ? bit : 0u; mk1 |= w == 1u ? bit : 0u; mk2 |= w == 2u ? bit : 0u; mk3 |= w == 3u ? bit : 0u; } }
            st[si].mlo = (unsigned long long)mk0 | ((unsigned long long)mk1 << 32); st[si].mhi = (unsigned long long)mk2 | ((unsigned long long)mk3 << 32);
            st[si].tq = s0 + q; st[si].tqmin = s0 + 8 * half + 4 * si;
            const bf16_t* qrow = QB + (size_t)(tg0 + q) * 512 + hh * 64 + 8 * kq;
            st[si].q0 = *(const bf16x8*)qrow; st[si].q1 = *(const bf16x8*)(qrow + 32);
            st[si].m = -1e30f; st[si].l = 0.f;
#pragma unroll
            for (int dt = 0; dt < 4; ++dt) st[si].o[dt] = (f32x4){0.f, 0.f, 0.f, 0.f};
        }
        unsigned long long Ulo = 0ull, Uhi = 0ull;
#pragma unroll
        for (int si = 0; si < 2; ++si)
#pragma unroll
            for (int j = 0; j < 4; ++j) {
                Ulo |= (unsigned long long)(unsigned)__builtin_amdgcn_readlane((int)(unsigned)st[si].mlo, 4 * j) | ((unsigned long long)(unsigned)__builtin_amdgcn_readlane((int)(unsigned)(st[si].mlo >> 32), 4 * j) << 32);
                Uhi |= (unsigned long long)(unsigned)__builtin_amdgcn_readlane((int)(unsigned)st[si].mhi, 4 * j) | ((unsigned long long)(unsigned)__builtin_amdgcn_readlane((int)(unsigned)(st[si].mhi >> 32), 4 * j) << 32);
            }
        u32x4 pk, pv;
        __syncthreads();
        pk = *(const u32x4*)kgp; pv = *(const u32x4*)vgp;
        *(LAS u32x4*)(lds + wofs) = pk; *(LAS u32x4*)(lds + 9216 + wofs) = pv;
        __syncthreads();
#pragma unroll 1
        for (int n = 0; n < nsteps; ++n) {
            const int kbc = 64 * n; const bool more = n + 1 < nsteps;
            if (more) { pk = *(const u32x4*)(kgp + (size_t)(kbc + 64) * 64); pv = *(const u32x4*)(vgp + kbc + 64); }
            const bool mine = ((n < 64 ? Ulo : Uhi) >> (n & 63)) & 1ull;
            if (mine) {
                const LAS unsigned char* bb = lds + (n & 1) * 18432;
                bf16x8 kf[8], vf[8]; stg_rdk(bb, krow0, kq, kf); stg_rdv(bb, lc, kq, vf);
                set_step(st[0], kf, vf, kbc, kq); set_step(st[1], kf, vf, kbc, kq);
            }
            if (more) { LAS unsigned char* nbuf = lds + ((n + 1) & 1) * 18432; *(LAS u32x4*)(nbuf + wofs) = pk; *(LAS u32x4*)(nbuf + 9216 + wofs) = pv; }
            __syncthreads();
        }
#pragma unroll
        for (int si = 0; si < 2; ++si) {
            const int q = 8 * half + 4 * si + (lc >> 2);
            float l = st[si].l; l += __shfl_xor(l, 16); l += __shfl_xor(l, 32);
            const float g1 = GATES[(size_t)(tg0 + q) * 24 + hh * 3 + 1];
            const float inv = l > 0.f ? g1 / l : 0.f;
            if (!nowrite || l == -1.f) {
#pragma unroll
                for (int dt = 0; dt < 4; ++dt) { bf16_t* dst = OB + (size_t)(tg0 + q) * 1024 + 512 + hh * 64 + 16 * dt + 4 * kq; const u32x2 ow = *(const u32x2*)dst;
                    const f32x4 v = st[si].o[dt] * inv; u32x2 w; w.x = pk2(bflo(ow.x) + v[0], bfhi(ow.x) + v[1]); w.y = pk2(bflo(ow.y) + v[2], bfhi(ow.y) + v[3]); *(u32x2*)dst = w; }
            }
        }
    }
}

#define XB_TMO      128
#define XB_XCNT(j)  (256  + 64 * (j))
#define XB_XSUB(j)  (1280 + 64 * (j))
#define XB_XGEN(j)  (2304 + 64 * (j))
#define XB_TOP      3328
#define XB_TOPGEN   3392
#define XCD_BAR_WORDS 3456
#define XB_SPIN_CAP (1u << 18)

__device__ __forceinline__ unsigned xb_ld(unsigned* p)              { return __hip_atomic_load(p, __ATOMIC_RELAXED, __HIP_MEMORY_SCOPE_AGENT); }
__device__ __forceinline__ unsigned xb_add(unsigned* p, unsigned v) { return __hip_atomic_fetch_add(p, v, __ATOMIC_RELAXED, __HIP_MEMORY_SCOPE_AGENT); }
__device__ __forceinline__ unsigned xb_xcc_id() { return (unsigned)__builtin_amdgcn_s_getreg((3 << 11) | 20) & 0xFu; }
#define XB_SPIN(cond, bar) do { unsigned _sp = 0; while (cond) { __builtin_amdgcn_s_sleep(1); \
    if ((++_sp & 255u) == 0u) { if (xb_ld(&(bar)[XB_TMO])) break; if (_sp > XB_SPIN_CAP) { atomicAdd(&(bar)[XB_TMO], 1u); break; } } } } while (0)

struct XcdBarrier {
    unsigned* bar; unsigned x;
    volatile LAS unsigned* st;
};

__device__ __forceinline__ XcdBarrier xcd_barrier_post(unsigned* bar, volatile LAS unsigned* st, int tid) {
    XcdBarrier b; b.bar = bar; b.x = xb_xcc_id(); b.st = st;
    if (tid == 0) (void)xb_add(&bar[XB_XCNT(b.x)], 1u);
    return b;
}
__device__ __forceinline__ void xcd_barrier_complete(unsigned* bar, unsigned x, unsigned& nloc, unsigned& nx) {
    const unsigned G = gridDim.x * gridDim.y * gridDim.z;
    unsigned sum, cnt, mine, sp = 0u;
    for (;;) {
        sum = 0u; cnt = 0u; mine = 0u;
#pragma unroll
        for (unsigned j = 0; j < 16; ++j) { const unsigned c = xb_ld(&bar[XB_XCNT(j)]); sum += c; cnt += (c > 0u) ? 1u : 0u; mine = (j == x) ? c : mine; }
        if (sum == G) break;
        __builtin_amdgcn_s_sleep(1);
        if ((++sp & 255u) == 0u) { if (xb_ld(&bar[XB_TMO])) break; if (sp > XB_SPIN_CAP) { atomicAdd(&bar[XB_TMO], 1u); break; } }
    }
    nloc = mine > 0u ? mine : 1u; nx = cnt > 0u ? cnt : 1u;
}

__device__ __forceinline__ void xcd_barrier(const XcdBarrier& b, int tid) {
    asm volatile("s_waitcnt vmcnt(0)" ::: "memory");
    __syncthreads();
    if (tid == 0) {
        unsigned* bar = b.bar;
        __builtin_amdgcn_s_waitcnt(0);
        unsigned nloc = b.st[0], nx = b.st[1];
        if (nloc == 0u) { xcd_barrier_complete(bar, b.x, nloc, nx); b.st[0] = nloc; b.st[1] = nx; }
        const unsigned old = xb_add(&bar[XB_XSUB(b.x)], 1u);
        const unsigned gen = old / nloc;
        if (old + 1u == (gen + 1u) * nloc) {
            __builtin_amdgcn_fence(__ATOMIC_RELEASE, "agent");
            asm volatile("s_waitcnt vmcnt(0)" ::: "memory");
            const unsigned og = xb_add(&bar[XB_TOP], 1u);
            const unsigned tg = og / nx;
            if (og + 1u == (tg + 1u) * nx) xb_add(&bar[XB_TOPGEN], 1u);
            else XB_SPIN(xb_ld(&bar[XB_TOPGEN]) == tg, bar);
            __builtin_amdgcn_fence(__ATOMIC_ACQUIRE, "agent");
            xb_add(&bar[XB_XGEN(b.x)], 1u);
            asm volatile("s_waitcnt vmcnt(0)" ::: "memory");
        } else {
            XB_SPIN(xb_ld(&bar[XB_XGEN(b.x)]) == gen, bar);
            __builtin_amdgcn_fence(__ATOMIC_ACQUIRE, "agent");
            asm volatile("s_waitcnt vmcnt(0)" ::: "memory");
        }
    }
    __syncthreads();
}

__global__ void __launch_bounds__(512, 2) mk_fwd(P pv) {
    extern __shared__ __attribute__((aligned(16))) unsigned char lds_raw[];
    LAS unsigned char* lds = (LAS unsigned char*)lds_raw;
    cg::grid_group grid = cg::this_grid();
    const int wv = __builtin_amdgcn_readfirstlane((int)(threadIdx.x >> 6));
    if (threadIdx.x < 2) ((LAS unsigned*)(lds + LDS_BARST))[threadIdx.x] = 0u;
    __syncthreads();
    (void)xcd_barrier_post((unsigned*)(pv.ws + WS_BAR), (volatile LAS unsigned*)(lds + LDS_BARST), (int)threadIdx.x);
#define GRID_BAR() do { KP pb_ = (KP)__builtin_amdgcn_kernarg_segment_ptr(); asm volatile("" : "+s"(pb_)); XcdBarrier xb_; xb_.bar = (unsigned*)(pb_->ws + WS_BAR); xb_.x = xb_xcc_id(); xb_.st = (volatile LAS unsigned*)(lds + LDS_BARST); xcd_barrier(xb_, mk_tid(wv)); } while (0)
    for (int ph = pv.ph_lo; ph < pv.ph_hi; ++ph) {
        if (ph > pv.ph_lo) { if (ph == 1) grid.sync(); else GRID_BAR(); }
        KP p = (KP)__builtin_amdgcn_kernarg_segment_ptr();
        asm volatile("" : "+s"(p));
        unsigned char* ws = p->ws;
        float* X = (float*)(ws + WS_X); float* SS = (float*)(ws + WS_SSP);
        bf16_t* XG = (bf16_t*)(ws + WS_XG); bf16_t* XGB = (bf16_t*)(ws + WS_XGB);
        bf16_t* Z = (bf16_t*)(ws + WS_Z); bf16_t* U = (bf16_t*)(ws + WS_U); bf16_t* PP = (bf16_t*)(ws + WS_PP); bf16_t* MERGED = (bf16_t*)(ws + WS_MERGED);
        const float* BIAS = (const float*)(ws + WS_BIAS);
#if defined(PROBE_SYNC)
        if (ph == 1) { for (int i_ = 0; i_ < 50; ++i_) GRID_BAR(); }
#endif
        if (ph == 0) { prologue_phase(p, lds, wv);
#if defined(PROBE_PRO2)
            prologue_phase(p, lds, wv);
#endif
            continue; }
        if (ph == NPH - 1) {
            const float* ssf = SS + (size_t)16 * T * 16; const float* gf = p->in[25];
            for (int o = mk_bid() * 512 + mk_tid(wv); o < T * D / 4; o += mk_grid() * 512) {
                const int r = o >> 8, c = (o & 255) * 4; const float rs = row_rs(ssf, r);
                const f32x4 v = *(const f32x4*)(X + (size_t)o * 4), g = *(const f32x4*)(gf + c);
                *(f32x4*)(p->out + (size_t)o * 4) = v * rs * g;
            }
            continue;
        }
        const int L = (ph - 1) / 12, j = (ph - 1) % 12;
        const bf16_t* WB = (const bf16_t*)(ws + ((L & 1) ? WS_WB1 : WS_WB0));
        switch (j) {
        case 0: {
            EpiSwiglu E{U, SS + (size_t)(4 * L + 0) * T * 16};
            run_gemm(lds, L == 0 ? XG : XGB, D, WB + WO_13A, T, 2 * FF, D, 0, E, wv);
#if defined(PROBE_GEMM2)
            run_gemm(lds, L == 0 ? XG : XGB, D, WB + WO_13A, T, 2 * FF, D, 0, E, wv);
#endif
        } break;
        case 1: {
            EpiResid<0> E{L == 0 ? p->in[0] : X, X, XG, p->in[6] + L * D, SS + (size_t)(4 * L + 1) * T * 16, 0.5f, nullptr, nullptr};
            run_gemm(lds, U, FF, WB + WO_2A, T, D, FF, 0, E, wv);
        } break;
        case 2: {
            EpiRow<0> E{Z, NZ, SS + (size_t)(4 * L + 1) * T * 16, nullptr, nullptr, 0};
            run_gemm(lds, XG, D, WB + WO_IN, T, NZ, D, 0, E, wv);
#if defined(PROBE_G_IN)
            run_gemm(lds, XG, D, WB + WO_IN, T, NZ, D, 0, E, wv);
#endif
        } break;
        case 3: post_phase(p, lds, wv);
#if defined(PROBE_MISC2)
            post_phase(p, lds, wv);
#endif
            break;
        case 4: {
            EpiRow<1> Ek{(bf16_t*)(ws + WS_HIDK), 256, nullptr, BIAS, nullptr, 0};
            run_gemm(lds, (const bf16_t*)(ws + WS_KCMP), 1024, WB + WO_CK, 2048, 256, 2048, 0, Ek, wv);
            EpiRow<1> Ev{(bf16_t*)(ws + WS_HIDV), 256, nullptr, BIAS + 256, nullptr, 0};
            run_gemm(lds, (const bf16_t*)(ws + WS_VCMP), 1024, WB + WO_CV, 2048, 256, 2048, 8, Ev, wv);
            indexer_phase(p, lds, L, wv, 0);
#if defined(PROBE_IDX2)
            indexer_phase(p, lds, L, wv, 32);
#endif
#if defined(PROBE_IDXSCORE)
            indexer_phase(p, lds, L, wv, 32, true);
#endif
        } break;
        case 5: {
            cmp2_phase(p, L, wv);
            if (L + 1 < DEPTH) convert_layer(p, L + 1, (bf16_t*)(ws + (((L + 1) & 1) ? WS_WB1 : WS_WB0)), lds, wv);
#if defined(PROBE_MISC2)
            cmp2_phase(p, L, wv);
            if (L + 1 < DEPTH) convert_layer(p, L + 1, (bf16_t*)(ws + (((L + 1) & 1) ? WS_WB1 : WS_WB0)), lds, wv);
#endif
        } break;
        case 6: attn_phase(p, lds, wv);
#if defined(PROBE_ATTNA2)
            attn_phase(p, lds, wv);
#endif
            GRID_BAR();
            attn_sel_phase(p, lds, wv, false);
#if defined(PROBE_SELDUMMY)
            attn_sel_phase(p, lds, wv, true);
#endif
#if defined(PROBE_SEL2)
            attn_sel_phase(p, lds, wv, false, true);
#endif
            break;
        case 7: {
            EpiMerge E{MERGED, Z};
            run_gemm(lds, (const bf16_t*)(ws + WS_OA), 1024, WB + WO_PA, T, 2048, 1024, 0, E, wv);
        } break;
        case 8: {
            EpiResid<0> E{X, X, XG, p->in[18] + L * D, SS + (size_t)(4 * L + 2) * T * 16, 1.0f, nullptr, nullptr};
            run_gemm(lds, MERGED, D, WB + WO_WO, T, D, D, 0, E, wv);
        } break;
        case 9: {
            EpiSwiglu E{U, SS + (size_t)(4 * L + 2) * T * 16};
            run_gemm(lds, XG, D, WB + WO_13B, T, 2 * FF, D, 0, E, wv);
            EpiRow<2> Ep{PP, D, nullptr, nullptr, nullptr, 0};
            run_gemm(lds, (const bf16_t*)(ws + WS_PBF) + (size_t)(L & 1) * T * PLE, PLE, WB + WO_PP, T, D, PLE, 0, Ep, wv);
        } break;
        case 10: {
            EpiResid<0> E{X, X, XG, p->in[22] + L * D, SS + (size_t)(4 * L + 3) * T * 16, 0.5f, nullptr, nullptr};
            run_gemm(lds, U, FF, WB + WO_2B, T, D, FF, 0, E, wv);
        } break;
        case 11: {
            EpiResid<1> E{X, X, XGB, L + 1 < DEPTH ? p->in[2] + (L + 1) * D : p->in[25], SS + (size_t)(4 * L + 4) * T * 16, 1.0f, SS + (size_t)(4 * L + 3) * T * 16, PP};
            run_gemm(lds, XG, D, WB + WO_PG, T, D, D, 0, E, wv);
        } break;
        }
    }
}

extern "C" void kernel_launch(void* const* d_in, const int* in_sizes, int n_in, void* d_out, int out_size, void* d_ws, size_t ws_size, hipStream_t stream) {
    static int grid = 0;
    if (grid == 0) {
        if (n_in != 26 || ws_size < WS_END) { fprintf(stderr, "kernel_launch: unexpected n_in %d / ws %zu\n", n_in, ws_size); grid = -1; return; }
        int dev = 0, cus = 0, per_cu = 0;
        hipGetDevice(&dev); hipDeviceGetAttribute(&cus, hipDeviceAttributeMultiprocessorCount, dev);
        if (hipFuncSetAttribute((const void*)mk_fwd, hipFuncAttributeMaxDynamicSharedMemorySize, LDS_BYTES) != hipSuccess) { fprintf(stderr, "hipFuncSetAttribute failed\n"); grid = -1; return; }
        if (hipOccupancyMaxActiveBlocksPerMultiprocessor(&per_cu, (const void*)mk_fwd, 512, LDS_BYTES) != hipSuccess || per_cu < 1) { fprintf(stderr, "occupancy query: %d\n", per_cu); per_cu = 1; }
        (void)hipGetLastError();
        grid = cus * 1;
    }
    if (grid < 0) return;
    hipMemsetAsync((char*)d_ws + WS_CTL, 0, CTL_BYTES, stream);
    P a{};
    for (int i = 0; i < 26; ++i) a.in[i] = (const float*)d_in[i];
    a.out = (float*)d_out; a.ws = (unsigned char*)d_ws;
#if MK_MULTI
    for (int ph = 0; ph < NPH; ++ph) { a.ph_lo = ph; a.ph_hi = ph + 1; hipLaunchKernelGGL(mk_fwd, dim3(grid), dim3(512), LDS_BYTES, stream, a); }
#else
    a.ph_lo = 0; a.ph_hi = NPH;
    void* args[] = {&a};
    hipError_t e = hipLaunchCooperativeKernel((const void*)mk_fwd, dim3(grid), dim3(512), args, LDS_BYTES, stream);
    if (e != hipSuccess) fprintf(stderr, "cooperative launch failed: %s (grid %d)\n", hipGetErrorString(e), grid);
#endif
}
```
